# Optimizing an MI355X kernel written in HIP

```python
import math
import jax, jax.numpy as jnp
from jax import lax
import numpy as np

D_MODEL = 1024
BATCH = 8
SEQ = 8192
DEPTH = 1

CTX_LEN = 256
GRID_W = 64
ROPE_THETA = 10000.0
Q_BLOCK = 128
LN_EPS = 1e-5
RMS_EPS = 1e-6
SUBLN_EPS = 1e-5

MLA_HEADS = 8
MLA_NOPE = 64
MLA_ROPE = 32
MLA_V = 64
MLA_Q_LORA = 384
MLA_KV_LORA = 256
MLA_WIDTH = MLA_HEADS * MLA_V
MLA_SCALE = (MLA_NOPE + MLA_ROPE) ** -0.5

DIFF_HEADS = 4
DIFF_HD = 64
DIFF_WIDTH = DIFF_HEADS * 2 * DIFF_HD
DIFF_SCALE = DIFF_HD ** -0.5

IN_SPLITS = (
    MLA_Q_LORA,
    MLA_KV_LORA,
    MLA_ROPE,
    MLA_WIDTH,
    DIFF_WIDTH,
    DIFF_WIDTH,
    DIFF_WIDTH,
    DIFF_WIDTH,
    2 * D_MODEL,
)
N_IN = sum(IN_SPLITS)
IN_OFFSETS = tuple(int(o) for o in np.cumsum(IN_SPLITS)[:-1])

ALPHA = (2 * DEPTH) ** 0.25
BETA = (8 * DEPTH) ** -0.25

kernel_name = "hybrid_mla_diffattn_dit_layer"


def _rms_norm(x, w, eps):
    x32 = x.astype(jnp.float32)
    y = x32 * lax.rsqrt(jnp.mean(x32 * x32, axis=-1, keepdims=True) + eps)
    return y.astype(x.dtype) * w


def _layer_norm(x, g, b):
    x32 = x.astype(jnp.float32)
    mu = jnp.mean(x32, axis=-1, keepdims=True)
    var = jnp.mean(jnp.square(x32 - mu), axis=-1, keepdims=True)
    return ((x32 - mu) * lax.rsqrt(var + LN_EPS)).astype(x.dtype) * g + b


def _rope_1d(x, pos):
    half = x.shape[-1] // 2
    inv = ROPE_THETA ** (-jnp.arange(half, dtype=jnp.float32) / half)
    ang = pos[:, None] * inv[None, :]
    cos = jnp.cos(ang).astype(x.dtype)
    sin = jnp.sin(ang).astype(x.dtype)
    x1, x2 = x[..., :half], x[..., half:]
    return jnp.concatenate([x1 * cos - x2 * sin, x1 * sin + x2 * cos], axis=-1)


def _rope_2d(x, row, col):
    half = x.shape[-1] // 2
    return jnp.concatenate([_rope_1d(x[..., :half], row), _rope_1d(x[..., half:], col)], axis=-1)


def _blockwise(fn, qs):
    b, h, s, _ = qs[0].shape
    blocks = tuple(q.reshape(b, h, s // Q_BLOCK, Q_BLOCK, q.shape[-1]).transpose(2, 0, 1, 3, 4) for q in qs)
    out = lax.map(lambda qb: fn(*qb), blocks)
    n = out.shape[0]
    return out.transpose(1, 2, 0, 3, 4).reshape(b, h, n * Q_BLOCK, out.shape[-1])


def _softmax_attend(q, k, v, scale):
    s = jnp.einsum('bhqd,bhkd->bhqk', q, k).astype(jnp.float32) * scale
    p = jax.nn.softmax(s, axis=-1).astype(v.dtype)
    return jnp.einsum('bhqk,bhkd->bhqd', p, v)


def _diff_attend(q1, q2, k1, k2, v, lam, scale):
    s1 = jnp.einsum('bhqd,bhkd->bhqk', q1, k1).astype(jnp.float32) * scale
    s2 = jnp.einsum('bhqd,bhkd->bhqk', q2, k2).astype(jnp.float32) * scale
    p = jax.nn.softmax(s1, axis=-1) - lam * jax.nn.softmax(s2, axis=-1)
    return jnp.einsum('bhqk,bhkd->bhqd', p.astype(v.dtype), v)


def _branch_inputs(p, q_norm, kv_norm, w_uq, w_ukv, row, col):
    c_q, c_kv, k_r, gate_a, dq, dk, dv, gate_d, merge = jnp.split(p, IN_OFFSETS, axis=-1)
    b, s, _ = p.shape
    q = jnp.einsum('bsr,rhd->bhsd', _rms_norm(c_q, q_norm, RMS_EPS),
                   w_uq.reshape(MLA_Q_LORA, MLA_HEADS, MLA_NOPE + MLA_ROPE))
    kv = jnp.einsum('bsr,rhd->bhsd', _rms_norm(c_kv, kv_norm, RMS_EPS),
                    w_ukv.reshape(MLA_KV_LORA, MLA_HEADS, MLA_NOPE + MLA_V))
    q_nope, q_rope = q[..., :MLA_NOPE], q[..., MLA_NOPE:]
    k_nope, v_mla = kv[..., :MLA_NOPE], kv[..., MLA_NOPE:]
    k_r = k_r[:, None]
    dq = dq.reshape(b, s, DIFF_HEADS, 2, DIFF_HD).transpose(0, 2, 3, 1, 4)
    dk = dk.reshape(b, s, DIFF_HEADS, 2, DIFF_HD).transpose(0, 2, 3, 1, 4)
    dv = dv.reshape(b, s, DIFF_HEADS, 2 * DIFF_HD).transpose(0, 2, 1, 3)
    if row is not None:
        q_rope = _rope_2d(q_rope, row, col)
        k_r = _rope_2d(k_r, row, col)
        dq = _rope_2d(dq, row, col)
        dk = _rope_2d(dk, row, col)
    q_mla = jnp.concatenate([q_nope, q_rope], axis=-1)
    k_mla = jnp.concatenate([k_nope, jnp.broadcast_to(k_r, k_nope.shape[:-1] + (MLA_ROPE,))], axis=-1)
    return (q_mla, k_mla, v_mla, dq, dk, dv), (gate_a, gate_d, merge)


def _mix(q_mla, k_mla, v_mla, dq, dk, dv, gates, lam, lam_init, diff_subln, w_oa, w_ob, w_out):
    gate_a, gate_d, merge = gates
    b, s = gate_a.shape[0], gate_a.shape[1]
    o_a = _blockwise(lambda q: _softmax_attend(q, k_mla, v_mla, MLA_SCALE), (q_mla,))
    k1, k2 = dk[:, :, 0], dk[:, :, 1]
    o_d = _blockwise(lambda q1, q2: _diff_attend(q1, q2, k1, k2, dv, lam, DIFF_SCALE),
                     (dq[:, :, 0], dq[:, :, 1]))
    o_d = _rms_norm(o_d, diff_subln, SUBLN_EPS) * (1.0 - lam_init)
    o_a = o_a.transpose(0, 2, 1, 3).reshape(b, s, MLA_WIDTH)
    o_d = o_d.transpose(0, 2, 1, 3).reshape(b, s, DIFF_WIDTH)
    y_a = (o_a * jax.nn.silu(gate_a)) @ w_oa
    y_d = (o_d * jax.nn.silu(gate_d)) @ w_ob
    m_a, m_d = merge[..., :D_MODEL], merge[..., D_MODEL:]
    return (jax.nn.sigmoid(m_a) * y_a + jax.nn.sigmoid(m_d) * y_d) @ w_out


def setup_inputs(seed: int = 0) -> dict:
    key = jax.random.key(seed)
    ks = jax.random.split(key, 20)
    nrm = lambda k, shape, s: jax.random.normal(k, shape, jnp.float32) * s
    L, D = DEPTH, D_MODEL
    return {
        "x": nrm(ks[0], (BATCH, SEQ, D), 1.0),
        "c": nrm(ks[1], (BATCH, D), 1.0),
        "ctx": nrm(ks[2], (BATCH, CTX_LEN, D), 1.0),
        "c_ctx": nrm(ks[3], (D,), 1.0),
        "w_mod": nrm(ks[4], (L, D, 3 * D), 0.5 * D ** -0.5),
        "b_mod": nrm(ks[5], (L, 3 * D), 0.01),
        "w_in": nrm(ks[6], (L, D, N_IN), D ** -0.5),
        "mla_q_norm": 1.0 + nrm(ks[7], (L, MLA_Q_LORA), 0.01),
        "mla_kv_norm": 1.0 + nrm(ks[8], (L, MLA_KV_LORA), 0.01),
        "w_uq": nrm(ks[9], (L, MLA_Q_LORA, MLA_HEADS * (MLA_NOPE + MLA_ROPE)), MLA_Q_LORA ** -0.5),
        "w_ukv": nrm(ks[10], (L, MLA_KV_LORA, MLA_HEADS * (MLA_NOPE + MLA_V)), MLA_KV_LORA ** -0.5),
        "diff_lambda": nrm(ks[11], (L, 4, DIFF_HD), 0.1),
        "diff_subln": 1.0 + nrm(ks[12], (L, 2 * DIFF_HD), 0.01),
        "w_oa": nrm(ks[13], (L, MLA_WIDTH, D), BETA * MLA_WIDTH ** -0.5),
        "w_ob": nrm(ks[14], (L, DIFF_WIDTH, D), BETA * DIFF_WIDTH ** -0.5),
        "w_out": nrm(ks[15], (L, D, D), BETA * D ** -0.5),
        "ln_g": 1.0 + nrm(ks[16], (L, D), 0.01),
        "ln_b": nrm(ks[17], (L, D), 0.01),
    }


def reference(x, c, ctx, c_ctx, w_mod, b_mod, w_in, mla_q_norm, mla_kv_norm, w_uq, w_ukv,
              diff_lambda, diff_subln, w_oa, w_ob, w_out, ln_g, ln_b):
    n = x.shape[1]
    ROWS = n // GRID_W
    row = jnp.broadcast_to(jnp.arange(ROWS, dtype=jnp.float32)[:, None], (ROWS, GRID_W)).reshape(-1)
    col = jnp.broadcast_to(jnp.arange(GRID_W, dtype=jnp.float32)[None, :], (ROWS, GRID_W)).reshape(-1)
    for l in range(DEPTH):
        shift, scale, gate = jnp.split(jax.nn.silu(c) @ w_mod[l] + b_mod[l], 3, axis=-1)
        shift_c, scale_c, gate_c = jnp.split(jax.nn.silu(c_ctx) @ w_mod[l] + b_mod[l], 3, axis=-1)
        h = x * (1.0 + scale[:, None]) + shift[:, None]
        h_c = ctx * (1.0 + scale_c) + shift_c
        lat_t, lat_g = _branch_inputs(h @ w_in[l], mla_q_norm[l], mla_kv_norm[l], w_uq[l], w_ukv[l], row, col)
        ctx_t, ctx_g = _branch_inputs(h_c @ w_in[l], mla_q_norm[l], mla_kv_norm[l], w_uq[l], w_ukv[l], None, None)
        lam_init = 0.8 - 0.6 * math.exp(-0.3 * l)
        lq1, lk1, lq2, lk2 = diff_lambda[l, 0], diff_lambda[l, 1], diff_lambda[l, 2], diff_lambda[l, 3]
        lam = (jnp.exp(jnp.sum(lq1 * lk1).astype(jnp.float32))
               - jnp.exp(jnp.sum(lq2 * lk2).astype(jnp.float32)) + lam_init)
        q_mla, k_mla, v_mla, dq, dk, dv = lat_t
        q_mla_c, k_mla_c, v_mla_c, dq_c, dk_c, dv_c = ctx_t
        k_all = jnp.concatenate([k_mla_c, k_mla], axis=2)
        v_all = jnp.concatenate([v_mla_c, v_mla], axis=2)
        dk_all = jnp.concatenate([dk_c, dk], axis=3)
        dv_all = jnp.concatenate([dv_c, dv], axis=2)
        y = _mix(q_mla, k_all, v_all, dq, dk_all, dv_all, lat_g, lam, lam_init,
                 diff_subln[l], w_oa[l], w_ob[l], w_out[l])
        if l + 1 < DEPTH:
            y_c = _mix(q_mla_c, k_mla_c, v_mla_c, dq_c, dk_c, dv_c, ctx_g, lam, lam_init,
                       diff_subln[l], w_oa[l], w_ob[l], w_out[l])
            ctx = _layer_norm(ALPHA * ctx + gate_c * y_c, ln_g[l], ln_b[l])
        x = _layer_norm(ALPHA * x + gate[:, None] * y, ln_g[l], ln_b[l])
    return x
```

```cpp
#include <hip/hip_runtime.h>
#include <hip/hip_cooperative_groups.h>
#include <cstdio>
#include <cstdint>
namespace cg = cooperative_groups;
__device__ __forceinline__ int opq(int v) { asm volatile("" : "+v"(v)); return v; }
__device__ __forceinline__ int lane_id_v() { int l; asm volatile("v_mbcnt_lo_u32_b32 %0, -1, 0\n\tv_mbcnt_hi_u32_b32 %0, -1, %0" : "=v"(l)); return l; }
namespace pg8 {
#define PG8_LAS __attribute__((address_space(3)))
typedef unsigned short bf16_t;
typedef short bf16x8 __attribute__((ext_vector_type(8)));
typedef float f32x4 __attribute__((ext_vector_type(4)));
typedef unsigned u32x4 __attribute__((ext_vector_type(4)));
constexpr int BM = 256, BK = 64, HALF = 128, HTB = HALF * BK * 2  , STAGE_BYTES = 8 * HTB, NXCD = 8, WGM = 8;

__host__ __device__ __forceinline__ int lds_byte(int r, int c) { const int st = (r >> 4) * 2 + (c >> 5), rr = r & 15, cc = c & 31, ob = rr * 64 + cc * 2; return st * 1024 + (ob ^ (((ob >> 9) & 1) << 5)); }
__host__ __device__ __forceinline__ void stage_rc(int b, int& R, int& C) { const int st = b / 1024, sb = b % 1024, swz = sb ^ (((sb >> 9) & 1) << 5); R = (st >> 1) * 16 + swz / 64; C = (st & 1) * 32 + (swz % 64) / 2; }
__host__ __device__ __forceinline__ int perm32(int rho) { const int n = rho >> 4, i = rho & 15; return 8 * (i >> 2) + 4 * n + (i & 3); }

struct Unit { int pm, pn; };
struct Gemm { const bf16_t* A; const bf16_t* Bt; int M, N, K; };

struct StaticOrder {
    int nM, nN, nwg, G, c;
    __host__ __device__ void init(int M, int N, int G_, int c_) { nM = M / BM; nN = N / BM; nwg = nM * nN; G = G_; c = c_; }
    __host__ __device__ bool next(int i, Unit& u) const {
        const long L = (long)i * G + c; if (L >= nwg) return false;
        int wgid = (int)L; { const int q = nwg / NXCD, r = nwg % NXCD, xcd = wgid % NXCD, off = wgid / NXCD; wgid = (xcd < r ? xcd * (q + 1) : r * (q + 1) + (xcd - r) * q) + off; }
        const int nig = WGM * nN, gid = wgid / nig, fm = gid * WGM, gsz = (nM - fm) < WGM ? (nM - fm) : WGM;
        u.pm = fm + ((wgid % nig) % gsz); u.pn = (wgid % nig) / gsz; return true;
    }
    __device__ __forceinline__ void a_ready(const Unit&) const {}
    __device__ __forceinline__ void done(const Unit&) const {}
};

template <class Epi, class Sched, bool ALIGN_EPI = false, bool SP2 = false>
__device__ __forceinline__ void gemm_phase(PG8_LAS unsigned char* lds, const Gemm g, const Sched& S, const Epi& E, const int wid  ) {
    const int lane = lane_id_v(), tid = wid * 64 + lane, wr = wid >> 2, wc = wid & 3, fr = lane & 15, fq = lane >> 4;
    const int K = g.K, nt = K / BK;
    unsigned voffA[2], voffB[2];
#pragma unroll
    for (int i = 0; i < 2; ++i) { int R, C; stage_rc(tid * 16 + i * 8192, R, C); const int Rb = Epi::PERM ? ((R & ~31) + perm32(R & 31)) : R;
        voffA[i] = (unsigned)(R * K + C) * 2u; voffB[i] = (unsigned)(Rb * K + C) * 2u; }
    const size_t kstep = (size_t)(BK * 2);
    const size_t hstep = (size_t)HALF * K * 2;
    const size_t tstep = 2 * hstep;
    const unsigned ldsw = (unsigned)wid * 1024u;
    const int aoff = lds_byte(wr * 64 + fr, fq * 8), boff = lds_byte(wc * 32 + fr, fq * 8);
#define PG8_SA(b, h) (((b) * 2 + (h)) * HTB)
#define PG8_SB(b, h) ((4 + (b) * 2 + (h)) * HTB)
#define PG8_STAGE(bufoff, gbase, voff) do { _Pragma("unroll") for (int _i = 0; _i < 2; ++_i) \
        __builtin_amdgcn_global_load_lds((const unsigned*)((const char*)(gbase) + (voff)[_i]), (PG8_LAS unsigned*)(lds + (bufoff) + ldsw + _i * 8192), 16, 0, 0); } while (0)
#define PG8_LDA(dst, b, h) do { _Pragma("unroll") for (int m = 0; m < 4; ++m) _Pragma("unroll") for (int k = 0; k < 2; ++k) dst[m][k] = *(const PG8_LAS bf16x8*)(lds + PG8_SA(b, h) + aoff + m * 2048 + k * 1024); } while (0)
#define PG8_LDB(dst, b, h) do { _Pragma("unroll") for (int n = 0; n < 2; ++n) _Pragma("unroll") for (int k = 0; k < 2; ++k) dst[n][k] = *(const PG8_LAS bf16x8*)(lds + PG8_SB(b, h) + boff + n * 2048 + k * 1024); } while (0)
#define PG8_MMA(ai, bj, At, Bt) do { __builtin_amdgcn_s_setprio(1); _Pragma("unroll") for (int m = 0; m < 4; ++m) _Pragma("unroll") for (int n = 0; n < 2; ++n) _Pragma("unroll") for (int k = 0; k < 2; ++k) \
        acc[ai][bj][m][n] = __builtin_amdgcn_mfma_f32_16x16x32_bf16(Bt[n][k], At[m][k], acc[ai][bj][m][n], 0, 0, 0); __builtin_amdgcn_s_setprio(0); } while (0)
#define PG8_WAIT_V(n) asm volatile("s_waitcnt vmcnt(" #n ")" ::: "memory")
#define PG8_WAIT_L(n) asm volatile("s_waitcnt lgkmcnt(" #n ")" ::: "memory")
#define PG8_BAR __builtin_amdgcn_s_barrier()
#define PG8_SCHED __builtin_amdgcn_sched_barrier(0)
    Unit cur, nxt; int ui = 0;
    if (!S.next(0, cur)) return;
    f32x4 acc[2][2][4][2];
#pragma unroll
    for (int a = 0; a < 2; ++a)
#pragma unroll
        for (int b = 0; b < 2; ++b)
#pragma unroll
            for (int m = 0; m < 4; ++m)
#pragma unroll
                for (int n = 0; n < 2; ++n) acc[a][b][m][n] = (f32x4){0.f, 0.f, 0.f, 0.f};
    bf16x8 At[4][2], B0[2][2], B1[2][2];
    const char* cA = (const char*)g.A + (size_t)cur.pm * tstep; const char* cB = (const char*)g.Bt + (size_t)cur.pn * tstep;
    S.a_ready(cur);
    if constexpr (SP2) {
        PG8_STAGE(PG8_SB(0, 0), cB, voffB); PG8_STAGE(PG8_SB(0, 1), cB + hstep, voffB); PG8_STAGE(PG8_SA(0, 0), cA, voffA); PG8_STAGE(PG8_SA(0, 1), cA + hstep, voffA);
        if (wr == 1) PG8_BAR;
        PG8_WAIT_V(2); PG8_BAR;
        PG8_STAGE(PG8_SB(1, 0), cB + kstep, voffB); PG8_STAGE(PG8_SA(1, 0), cA + kstep, voffA); PG8_STAGE(PG8_SB(1, 1), cB + hstep + kstep, voffB);
        PG8_WAIT_V(6); PG8_BAR;
    } else {
        PG8_STAGE(PG8_SB(0, 0), cB, voffB); PG8_STAGE(PG8_SA(0, 0), cA, voffA); PG8_STAGE(PG8_SB(0, 1), cB + hstep, voffB); PG8_STAGE(PG8_SA(0, 1), cA + hstep, voffA);
        if (wr == 1) PG8_BAR;
        PG8_WAIT_V(4); PG8_BAR;
        PG8_STAGE(PG8_SB(1, 0), cB + kstep, voffB); PG8_STAGE(PG8_SA(1, 0), cA + kstep, voffA); PG8_STAGE(PG8_SB(1, 1), cB + hstep + kstep, voffB);
        PG8_WAIT_V(6); PG8_BAR;
    }
    for (;;) {
        const bool has_next = S.next(ui + 1, nxt);
        const char* nA = has_next ? (const char*)g.A + (size_t)nxt.pm * tstep : cA; const char* nB = has_next ? (const char*)g.Bt + (size_t)nxt.pn * tstep : cB;
        for (int t = 0; t < nt; t += 2) {
            const bool last = (t == nt - 2);
            const char* a1 = cA + (size_t)(t + 1) * kstep;
            const char* a2 = last ? nA : cA + (size_t)(t + 2) * kstep; const char* b2 = last ? nB : cB + (size_t)(t + 2) * kstep;
            const char* a3 = a2 + kstep; const char* b3 = b2 + kstep;
            if (last && has_next) S.a_ready(nxt);
            if constexpr (SP2) {
            PG8_LDB(B0, 0, 0); PG8_LDB(B1, 0, 1); PG8_SCHED; PG8_LDA(At, 0, 0); PG8_STAGE(PG8_SA(1, 1), a1 + hstep, voffA);
            PG8_WAIT_V(8); PG8_WAIT_L(0); PG8_BAR; PG8_MMA(0, 0, At, B0); PG8_MMA(0, 1, At, B1); PG8_BAR; PG8_SCHED;
            PG8_LDA(At, 0, 1); PG8_STAGE(PG8_SB(0, 0), b2, voffB); PG8_STAGE(PG8_SB(0, 1), b2 + hstep, voffB); PG8_STAGE(PG8_SA(0, 0), a2, voffA);
            PG8_WAIT_V(8); PG8_WAIT_L(0); PG8_BAR; PG8_MMA(1, 0, At, B0); PG8_MMA(1, 1, At, B1); PG8_BAR; PG8_SCHED;
            PG8_LDB(B0, 1, 0); PG8_LDB(B1, 1, 1); PG8_SCHED; PG8_LDA(At, 1, 0); PG8_STAGE(PG8_SA(0, 1), a2 + hstep, voffA);
            PG8_WAIT_V(8); PG8_WAIT_L(0); PG8_BAR; PG8_MMA(0, 0, At, B0); PG8_MMA(0, 1, At, B1); PG8_BAR; PG8_SCHED;
            PG8_LDA(At, 1, 1); PG8_STAGE(PG8_SB(1, 0), b3, voffB); PG8_STAGE(PG8_SB(1, 1), b3 + hstep, voffB); PG8_STAGE(PG8_SA(1, 0), a3, voffA);
            PG8_WAIT_V(8); PG8_WAIT_L(0); PG8_BAR; PG8_MMA(1, 0, At, B0); PG8_MMA(1, 1, At, B1); PG8_BAR; PG8_SCHED;
            } else {
            PG8_LDB(B0, 0, 0); PG8_SCHED; PG8_LDA(At, 0, 0); PG8_STAGE(PG8_SA(1, 1), a1 + hstep, voffA);
            PG8_WAIT_L(8); PG8_BAR; PG8_WAIT_L(0); PG8_MMA(0, 0, At, B0); PG8_BAR; PG8_SCHED;
            PG8_LDB(B1, 0, 1); PG8_STAGE(PG8_SB(0, 0), b2, voffB);
            PG8_BAR; PG8_WAIT_L(0); PG8_MMA(0, 1, At, B1); PG8_BAR;
            PG8_LDA(At, 0, 1); PG8_STAGE(PG8_SA(0, 0), a2, voffA);
            PG8_BAR; PG8_WAIT_L(0); PG8_MMA(1, 0, At, B0); PG8_BAR; PG8_SCHED;
            PG8_STAGE(PG8_SB(0, 1), b2 + hstep, voffB);
            PG8_WAIT_V(6); PG8_BAR; PG8_MMA(1, 1, At, B1); PG8_BAR;
            PG8_LDB(B0, 1, 0); PG8_SCHED; PG8_LDA(At, 1, 0); PG8_STAGE(PG8_SA(0, 1), a2 + hstep, voffA);
            PG8_WAIT_L(8); PG8_BAR; PG8_WAIT_L(0); PG8_MMA(0, 0, At, B0); PG8_BAR; PG8_SCHED;
            PG8_LDB(B1, 1, 1); PG8_STAGE(PG8_SB(1, 0), b3, voffB);
            PG8_BAR; PG8_WAIT_L(0); PG8_MMA(0, 1, At, B1); PG8_BAR;
            PG8_LDA(At, 1, 1); PG8_STAGE(PG8_SA(1, 0), a3, voffA);
            PG8_BAR; PG8_WAIT_L(0); PG8_MMA(1, 0, At, B0); PG8_BAR; PG8_SCHED;
            PG8_STAGE(PG8_SB(1, 1), b3 + hstep, voffB);
            PG8_WAIT_V(6); PG8_BAR; PG8_MMA(1, 1, At, B1); PG8_BAR;
            }
        }
        if constexpr (ALIGN_EPI) { if (wr == 0) PG8_BAR; }
        if constexpr (!Epi::AFTER_DRAIN) { E(acc, cur, wr, wc, fr, fq); S.done(cur); }
        if (!has_next) break;
#pragma unroll
        for (int a = 0; a < 2; ++a)
#pragma unroll
            for (int b = 0; b < 2; ++b)
#pragma unroll
                for (int m = 0; m < 4; ++m)
#pragma unroll
                    for (int n = 0; n < 2; ++n) acc[a][b][m][n] = (f32x4){0.f, 0.f, 0.f, 0.f};
        cur = nxt; cA = nA; cB = nB; ++ui;
        if constexpr (ALIGN_EPI) { if (wr == 1) PG8_BAR; }
    }
    PG8_WAIT_V(0);
    if constexpr (!ALIGN_EPI) { if (wr == 0) PG8_BAR; }
    PG8_BAR;
    if constexpr (Epi::AFTER_DRAIN) { E.fused(acc, cur, wr, wc, fr, fq, lds, wid, lane); S.done(cur); }
#undef PG8_SA
#undef PG8_SB
#undef PG8_STAGE
#undef PG8_LDA
#undef PG8_LDB
#undef PG8_MMA
#undef PG8_WAIT_V
#undef PG8_WAIT_L
#undef PG8_BAR
#undef PG8_SCHED
}
}
constexpr int DM = 1024, NB = 8, SEQ = 8192, CTX = 256, SKV = SEQ + CTX;
constexpr int MLAT = NB * SEQ, MALL = MLAT + NB * CTX;
constexpr int NINP = 5376;
typedef unsigned short bf16_t;
typedef short bf16x8 __attribute__((ext_vector_type(8)));
typedef short s16x4 __attribute__((ext_vector_type(4)));
typedef float f32x16 __attribute__((ext_vector_type(16)));
typedef float f32x4 __attribute__((ext_vector_type(4)));
typedef unsigned u32x4 __attribute__((ext_vector_type(4)));
typedef unsigned u32x2 __attribute__((ext_vector_type(2)));
#define LAS __attribute__((address_space(3)))
#define SBAR() __builtin_amdgcn_sched_barrier(0)
__device__ __forceinline__ unsigned cvtpk(float lo, float hi) { unsigned r; asm volatile("v_cvt_pk_bf16_f32 %0, %1, %2" : "=v"(r) : "v"(lo), "v"(hi)); return r; }
__device__ __forceinline__ unsigned f2bf(float f) { unsigned u = __builtin_bit_cast(unsigned, f); return (u + 0x7fffu + ((u >> 16) & 1u)) >> 16; }
__device__ __forceinline__ float bf2f(unsigned short b) { return __builtin_bit_cast(float, (unsigned)b << 16); }
__device__ __forceinline__ float bflo(unsigned w) { return __builtin_bit_cast(float, w << 16); }
__device__ __forceinline__ float bfhi(unsigned w) { return __builtin_bit_cast(float, w & 0xffff0000u); }
__device__ __forceinline__ float sigmoidf_(float v) { return 1.f / (1.f + __expf(-v)); }
__device__ __forceinline__ float wave_sum(float v) {
#pragma unroll
    for (int o = 1; o < 64; o <<= 1) v += __shfl_xor(v, o);
    return v;
}

namespace att {
template <bool MLA> struct Cfg {
    static constexpr int DQK = MLA ? 96 : 64, DV = MLA ? 64 : 128, NQ = DQK / 16, NCB = DV / 32;
    static constexpr int KROWB = MLA ? 256 : 128;
    static constexpr int LDQ = MLA ? 768 : 512, LDK = MLA ? 768 : 512, LDV = 512;
    static constexpr int SHM_V = 64 * DV * 2, SHM_K = 64 * KROWB;
};
constexpr float THR = 8.f;
__device__ __forceinline__ int crow(int r, int hi) { return (r & 3) + 8 * (r >> 2) + 4 * hi; }
template <bool MLA> __device__ __forceinline__ int kswz(int row, int colB) {
    if constexpr (MLA) return row * 256 + (colB ^ ((row & 15) << 4));
    else return row * 128 + (colB ^ (((row >> 1) & 7) << 4));
}
__device__ __forceinline__ void partialSM(f32x16& p0, f32x16& p1, float& m_reg, float& mn, float& alpha, const float C, const float THRS) {
    float pmax = p0[0];
#pragma unroll
    for (int r = 1; r < 16; ++r) pmax = fmaxf(pmax, p0[r]);
#pragma unroll
    for (int r = 0; r < 16; ++r) pmax = fmaxf(pmax, p1[r]);
    { auto rr = __builtin_amdgcn_permlane32_swap(__float_as_uint(pmax), __float_as_uint(pmax), false, false);
      pmax = fmaxf(__uint_as_float(rr[0]), __uint_as_float(rr[1])); }
    if (__builtin_expect(__all(pmax - m_reg <= THRS), 1)) { mn = m_reg; alpha = 1.f; }
    else { mn = fmaxf(m_reg, pmax); alpha = __builtin_amdgcn_exp2f((m_reg - mn) * C); m_reg = mn; }
    float mnC = -mn * C;
#pragma unroll
    for (int r = 0; r < 16; ++r) p0[r] = fmaf(p0[r], C, mnC);
#pragma unroll
    for (int r = 0; r < 16; ++r) p1[r] = fmaf(p1[r], C, mnC);
#pragma unroll
    for (int r = 0; r < 16; ++r) p0[r] = __builtin_amdgcn_exp2f(p0[r]);
}
__device__ __forceinline__ void finishSM(f32x16& p0, f32x16& p1, float alpha, float& l_reg, bf16x8& pa0, bf16x8& pa1, bf16x8& pa2, bf16x8& pa3) {
#pragma unroll
    for (int r = 0; r < 16; ++r) p1[r] = __builtin_amdgcn_exp2f(p1[r]);
    float ps = 0;
#pragma unroll
    for (int r = 0; r < 16; ++r) ps += p0[r];
#pragma unroll
    for (int r = 0; r < 16; ++r) ps += p1[r];
    { auto rr = __builtin_amdgcn_permlane32_swap(__float_as_uint(ps), __float_as_uint(ps), false, false);
      ps = __uint_as_float(rr[0]) + __uint_as_float(rr[1]); }
    l_reg = l_reg * alpha + ps;
#define PK4(P, BASE, OUT) do { unsigned a0 = cvtpk(P[BASE + 0], P[BASE + 1]), a1 = cvtpk(P[BASE + 2], P[BASE + 3]);   \
    unsigned b0 = cvtpk(P[BASE + 4], P[BASE + 5]), b1 = cvtpk(P[BASE + 6], P[BASE + 7]);                              \
    auto r0 = __builtin_amdgcn_permlane32_swap(a0, b0, false, false); auto r1 = __builtin_amdgcn_permlane32_swap(a1, b1, false, false); \
    u32x4 w = {r0[0], r1[0], r0[1], r1[1]}; OUT = *reinterpret_cast<bf16x8*>(&w); } while (0)
    PK4(p0, 0, pa0); PK4(p0, 8, pa1); PK4(p1, 0, pa2); PK4(p1, 8, pa3);
#undef PK4
}
template <bool MLA> __device__ __forceinline__ void qkt(f32x16& p0, f32x16& p1, const char* Ks, const bf16x8* qr, int r32, int hi) {
    p0 = f32x16{}; p1 = f32x16{};
#pragma unroll
    for (int d0 = 0; d0 < Cfg<MLA>::NQ; ++d0) { int cb = (d0 * 16 + hi * 8) * 2;
        bf16x8 b0 = *reinterpret_cast<const bf16x8*>(Ks + kswz<MLA>(r32, cb));
        bf16x8 b1 = *reinterpret_cast<const bf16x8*>(Ks + kswz<MLA>(32 + r32, cb));
        p0 = __builtin_amdgcn_mfma_f32_32x32x16_bf16(b0, qr[d0], p0, 0, 0, 0);
        p1 = __builtin_amdgcn_mfma_f32_32x32x16_bf16(b1, qr[d0], p1, 0, 0, 0); }
}
template <int NCB> __device__ __forceinline__ int v_st(int k, int c) { const int kk = (k & ~0xC) | ((k & 4) << 1) | ((k & 8) >> 1); return ((kk >> 3) * NCB + (c >> 5)) * 512 + ((kk & 7) * 32 + (c & 31)) * 2; }
__device__ __forceinline__ int v_rd_base(int lane) { return ((lane & 3) << 3) | (((lane >> 2) & 3) << 6) | (((lane >> 4) & 1) << 5) | (((lane >> 5) & 1) << 8); }
template <int NCB> constexpr int v_rd_off(int d0, int ks, int half) { return d0 * 512 + (ks * 2 + half) * NCB * 512; }
template <int OFF> __device__ __forceinline__ s16x4 tr_read(int vb) {
    s16x4 r; asm volatile("ds_read_b64_tr_b16 %0, %1 offset:%2" : "=&v"(r) : "v"(vb), "i"(OFF) : "memory"); return r;
}
template <int NCB, int D0> __device__ __forceinline__ void pv_one(f32x16& od, int vb, bf16x8 pa0, bf16x8 pa1, bf16x8 pa2, bf16x8 pa3) {
    const s16x4 l0 = tr_read<v_rd_off<NCB>(D0, 0, 0)>(vb), h0 = tr_read<v_rd_off<NCB>(D0, 0, 1)>(vb), l1 = tr_read<v_rd_off<NCB>(D0, 1, 0)>(vb), h1 = tr_read<v_rd_off<NCB>(D0, 1, 1)>(vb);
    const s16x4 l2 = tr_read<v_rd_off<NCB>(D0, 2, 0)>(vb), h2 = tr_read<v_rd_off<NCB>(D0, 2, 1)>(vb), l3 = tr_read<v_rd_off<NCB>(D0, 3, 0)>(vb), h3 = tr_read<v_rd_off<NCB>(D0, 3, 1)>(vb);
    asm volatile("s_waitcnt lgkmcnt(0)" ::: "memory"); SBAR();
#define PK(L, H) (bf16x8){L[0], L[1], L[2], L[3], H[0], H[1], H[2], H[3]}
    od = __builtin_amdgcn_mfma_f32_32x32x16_bf16(pa0, PK(l0, h0), od, 0, 0, 0);
    od = __builtin_amdgcn_mfma_f32_32x32x16_bf16(pa1, PK(l1, h1), od, 0, 0, 0);
    od = __builtin_amdgcn_mfma_f32_32x32x16_bf16(pa2, PK(l2, h2), od, 0, 0, 0);
    od = __builtin_amdgcn_mfma_f32_32x32x16_bf16(pa3, PK(l3, h3), od, 0, 0, 0);
#undef PK
}
template <int NCB> __device__ __forceinline__ void pv_all(f32x16* o, int vb, bf16x8 pa0, bf16x8 pa1, bf16x8 pa2, bf16x8 pa3) {
    pv_one<NCB, 0>(o[0], vb, pa0, pa1, pa2, pa3); pv_one<NCB, 1>(o[1], vb, pa0, pa1, pa2, pa3);
    if constexpr (NCB == 4) { pv_one<NCB, 2>(o[2], vb, pa0, pa1, pa2, pa3); pv_one<NCB, 3>(o[3], vb, pa0, pa1, pa2, pa3); }
}

template <bool MLA>
__device__ __forceinline__ void attn_core(const bf16_t* __restrict__ Qb, const bf16_t* __restrict__ Kh, const bf16_t* __restrict__ Vh, int seq, char* lds,
                                          f32x16 (&o)[Cfg<MLA>::NCB], const int wid  ) {
    using CF = Cfg<MLA>;
    constexpr int NQ = CF::NQ, NCB = CF::NCB, SHM_V = CF::SHM_V, SHM_K = CF::SHM_K, LDQ = CF::LDQ, LDK = CF::LDK, LDV = CF::LDV;
    constexpr float SCALE = MLA ? 0.10206207261596575f : 0.125f;
    constexpr float C = SCALE * 1.4426950408889634f, THRS = THR / SCALE;
    const int lane = lane_id_v(), tid = wid * 64 + lane, r32 = lane & 31, hi = lane >> 5;
    char* V_lds = lds; char* K_lds = lds + 2 * SHM_V;
    float* wsp = (float*)(lds + 2 * SHM_V + 2 * SHM_K) + wid * 64; float* li_l = wsp; float* al_l = wsp + 32;
    float m_reg = -1e30f, l_reg = 0; bf16x8 qr[NQ];
#pragma unroll
    for (int d = 0; d < NCB; ++d) o[d] = f32x16{};
    const bf16_t* Qw = Qb + (long)(wid * 32 + r32) * LDQ + hi * 8;
#pragma unroll
    for (int d0 = 0; d0 < NQ; ++d0) qr[d0] = *reinterpret_cast<const bf16x8*>(Qw + d0 * 16);
    const int vr0 = MLA ? (tid >> 3) : (tid >> 4), vc0 = MLA ? (tid & 7) * 8 : (tid & 15) * 8;
    const int vst0 = v_st<NCB>(vr0, vc0), vst1 = v_st<NCB>(32 + vr0, vc0);
    const int kcA = MLA ? tid : tid, krA = MLA ? (kcA / 12) : (tid >> 3), kcolA = MLA ? (kcA % 12) * 8 : (tid & 7) * 8;
    const int kcB = 512 + (tid & 255), krB = kcB / 12, kcolB = (kcB % 12) * 8;
    const int kstA = kswz<MLA>(krA, kcolA * 2), kstB = kswz<MLA>(krB, kcolB * 2);
    const int vb0 = (int)(uintptr_t)V_lds + v_rd_base(lane);
    struct { bf16x8 a, b, c; } sr_[2];
#define SLOAD(i, k0) do { if constexpr (MLA) { \
        sr_[i].a = *reinterpret_cast<const bf16x8*>(&Vh[(long)((k0) + vr0) * LDV + vc0]); \
        sr_[i].b = *reinterpret_cast<const bf16x8*>(&Kh[(long)((k0) + krA) * LDK + kcolA]); \
        sr_[i].c = *reinterpret_cast<const bf16x8*>(&Kh[(long)((k0) + krB) * LDK + kcolB]); \
    } else { \
        sr_[i].a = *reinterpret_cast<const bf16x8*>(&Vh[(long)((k0) + vr0) * LDV + vc0]); \
        sr_[i].b = *reinterpret_cast<const bf16x8*>(&Vh[(long)((k0) + 32 + vr0) * LDV + vc0]); \
        sr_[i].c = *reinterpret_cast<const bf16x8*>(&Kh[(long)((k0) + krA) * LDK + kcolA]); } } while (0)
#define SWRITE(bf, i) do { if constexpr (MLA) { \
        *(bf16x8*)(V_lds + (bf) * SHM_V + vst0) = sr_[i].a; \
        *(bf16x8*)(K_lds + (bf) * SHM_K + kstA) = sr_[i].b; \
        if (tid < 256) *(bf16x8*)(K_lds + (bf) * SHM_K + kstB) = sr_[i].c; \
    } else { \
        *(bf16x8*)(V_lds + (bf) * SHM_V + vst0) = sr_[i].a; \
        *(bf16x8*)(V_lds + (bf) * SHM_V + vst1) = sr_[i].b; \
        *(bf16x8*)(K_lds + (bf) * SHM_K + kstA) = sr_[i].c; } } while (0)
#define SWAIT() asm volatile("s_waitcnt vmcnt(3)" ::: "memory")
#define RESC(a) do { if (__any((a) < 1.f)) { if (hi == 0) al_l[r32] = (a); asm volatile("s_waitcnt lgkmcnt(0)" ::: "memory"); \
    _Pragma("unroll") for (int d = 0; d < NCB; ++d) _Pragma("unroll") for (int r = 0; r < 16; ++r) o[d][r] *= al_l[crow(r, hi)]; } } while (0)
    f32x16 pA0, pA1, pB0, pB1; float mnA, mnB, alA, alB; bf16x8 pa0, pa1, pa2, pa3; const int NT = seq / 64;
    constexpr int SE = 0, SO = 1;
    SLOAD(SE, 0); asm volatile("s_waitcnt vmcnt(0)" ::: "memory"); SWRITE(0, SE); __syncthreads();
    qkt<MLA>(pA0, pA1, K_lds, qr, r32, hi); partialSM(pA0, pA1, m_reg, mnA, alA, C, THRS);
    SLOAD(SO, 64); if (2 < NT) SLOAD(SE, 2 * 64);
    SWAIT(); SWRITE(1, SO); __syncthreads();
    for (int j = 1; j + 1 < NT; j += 2) {
        SBAR(); qkt<MLA>(pB0, pB1, K_lds + SHM_K, qr, r32, hi);
        finishSM(pA0, pA1, alA, l_reg, pa0, pa1, pa2, pa3); SBAR();
        SLOAD(SO, (j + 2) * 64); SBAR();
        pv_all<NCB>(o, vb0, pa0, pa1, pa2, pa3); partialSM(pB0, pB1, m_reg, mnB, alB, C, THRS);
        __syncthreads(); SWAIT(); SWRITE(0, SE);
        RESC(alB); __syncthreads();
        SBAR(); qkt<MLA>(pA0, pA1, K_lds, qr, r32, hi);
        finishSM(pB0, pB1, alB, l_reg, pa0, pa1, pa2, pa3); SBAR();
        if (j + 3 < NT) SLOAD(SE, (j + 3) * 64); SBAR();
        pv_all<NCB>(o, vb0 + SHM_V, pa0, pa1, pa2, pa3); partialSM(pA0, pA1, m_reg, mnA, alA, C, THRS);
        __syncthreads(); SWAIT(); SWRITE(1, SO);
        RESC(alA); __syncthreads();
    }
    SBAR(); qkt<MLA>(pB0, pB1, K_lds + SHM_K, qr, r32, hi);
    finishSM(pA0, pA1, alA, l_reg, pa0, pa1, pa2, pa3); SBAR();
    pv_all<NCB>(o, vb0, pa0, pa1, pa2, pa3); partialSM(pB0, pB1, m_reg, mnB, alB, C, THRS);
    __syncthreads(); RESC(alB);
    finishSM(pB0, pB1, alB, l_reg, pa0, pa1, pa2, pa3); SBAR();
    pv_all<NCB>(o, vb0 + SHM_V, pa0, pa1, pa2, pa3);
    if (hi == 0) li_l[r32] = l_reg; asm volatile("s_waitcnt lgkmcnt(0)" ::: "memory");
#pragma unroll
    for (int r = 0; r < 16; ++r) { const float rl = __builtin_amdgcn_rcpf(li_l[crow(r, hi)]);
#pragma unroll
        for (int d = 0; d < NCB; ++d) o[d][r] *= rl; }
#undef SLOAD
#undef SWRITE
#undef SWAIT
#undef RESC
}
}
typedef float2 cs_t;
__device__ __forceinline__ void store8(bf16_t* p, f32x4 v0, f32x4 v1) {
    u32x4 w; w.x = cvtpk(v0[0], v0[1]); w.y = cvtpk(v0[2], v0[3]); w.z = cvtpk(v1[0], v1[1]); w.w = cvtpk(v1[2], v1[3]);
    *(u32x4*)p = w;
}
__device__ __forceinline__ float dot8(f32x4 v0, f32x4 v1) { return (v0[0] * v0[0] + v0[1] * v0[1]) + (v0[2] * v0[2] + v0[3] * v0[3]) + (v1[0] * v1[0] + v1[1] * v1[1]) + (v1[2] * v1[2] + v1[3] * v1[3]); }
__device__ __forceinline__ void rope64(f32x4& v0, f32x4& v1, const cs_t* __restrict__ CS16, int gr, int gc, int wc, int fq, bool apply) {
    f32x4 p0, p1;
#pragma unroll
    for (int j = 0; j < 4; ++j) { p0[j] = __shfl_xor(v0[j], 32); p1[j] = __shfl_xor(v1[j], 32); }
    if (apply) {
        const int pos = (wc & 1) ? gc : gr; const cs_t* t = CS16 + pos * 16 + 8 * (fq & 1);
        const float sg = (fq < 2) ? -1.f : 1.f;
#pragma unroll
        for (int j = 0; j < 4; ++j) { const cs_t a = t[j], b = t[4 + j];
            v0[j] = v0[j] * a.x + sg * p0[j] * a.y; v1[j] = v1[j] * b.x + sg * p1[j] * b.y; }
    }
}
__device__ __forceinline__ void rope32(f32x4& v0, f32x4& v1, const cs_t* __restrict__ CS8, int gr, int gc, int g, bool apply) {
    f32x4 p0, p1;
#pragma unroll
    for (int j = 0; j < 4; ++j) { p0[j] = __shfl_xor(v0[j], 16); p1[j] = __shfl_xor(v1[j], 16); }
    if (apply) {
        const int pos = (g >= 2) ? gc : gr; const cs_t* t = CS8 + pos * 8;
        const float sg = (g & 1) ? 1.f : -1.f;
#pragma unroll
        for (int j = 0; j < 4; ++j) { const cs_t a = t[j], b = t[4 + j];
            v0[j] = v0[j] * a.x + sg * p0[j] * a.y; v1[j] = v1[j] * b.x + sg * p1[j] * b.y; }
    }
}
#define EPI_ARGS const pg8::f32x4 (&acc)[2][2][4][2], const pg8::Unit& u, int wr, int wc, int fr, int fq
#define EPI_RECOMPUTE { const int l_ = lane_id_v(); fr = l_ & 15; fq = l_ >> 4; }

struct EpiP1 {
    static constexpr bool PERM = true, AFTER_DRAIN = false;
    bf16_t *CKV, *CQ, *KMLA, *GA, *DQ, *DK, *DV, *GD, *MG; float *SSKV, *SSQ; const cs_t *CS16, *CS8;
    __device__ __forceinline__ void operator()(EPI_ARGS) const {
        EPI_RECOMPUTE
        const int pm = u.pm, pn = u.pn; const bool lat = pm < 256;
        if (!lat && !(pn == 0 || pn == 2 || (pn >= 7 && pn <= 10))) return;
        const int row0 = pm * 256 + wr * 64 + fr;
        const int kv0 = (lat ? (pm >> 5) * SKV + CTX + (pm & 31) * 256 : (pm - 256) * SKV) + wr * 64 + fr;
        const int lcw = wc * 32 + 8 * fq;
#pragma unroll
        for (int ai = 0; ai < 2; ++ai)
#pragma unroll
            for (int m = 0; m < 4; ++m) {
                __builtin_amdgcn_sched_barrier(0); const int row = opq(row0 + ai * 128 + m * 16), kvrow = kv0 + (row - row0);
                const int s = row & (SEQ - 1), gr = s >> 6, gc = s & 63;
                float ssq = 0.f;
#pragma unroll
                for (int bj = 0; bj < 2; ++bj) {
                    f32x4 v0 = acc[ai][bj][m][0], v1 = acc[ai][bj][m][1]; const int lc = bj * 128 + lcw;
                    if (pn == 0) { ssq += dot8(v0, v1); store8(CKV + (size_t)kvrow * 256 + lc, v0, v1); }
                    else if (pn == 1) { ssq += dot8(v0, v1); store8(CQ + (size_t)row * 384 + lc, v0, v1); }
                    else if (pn == 2) {
                        if (bj == 0) { if (lat) { ssq += dot8(v0, v1); store8(CQ + (size_t)row * 384 + 256 + lc, v0, v1); } }
                        else if (wc == 0) { rope32(v0, v1, CS8, gr, gc, fq, lat);
#pragma unroll
                            for (int h = 0; h < 8; ++h) store8(KMLA + (size_t)kvrow * 768 + h * 96 + 64 + 8 * fq, v0, v1); }
                    }
                    else if (pn <= 4 || pn == 11 || pn == 12) {
#pragma unroll
                        for (int j = 0; j < 4; ++j) { v0[j] = v0[j] * sigmoidf_(v0[j]); v1[j] = v1[j] * sigmoidf_(v1[j]); }
                        bf16_t* dst = (pn <= 4) ? GA + (size_t)row * 512 + (pn - 3) * 256 + lc : GD + (size_t)row * 512 + (pn - 11) * 256 + lc;
                        store8(dst, v0, v1);
                    }
                    else if (pn <= 6) { rope64(v0, v1, CS16, gr, gc, wc, fq, true); store8(DQ + (size_t)row * 512 + (pn - 5) * 256 + lc, v0, v1); }
                    else if (pn <= 8) { rope64(v0, v1, CS16, gr, gc, wc, fq, lat); store8(DK + (size_t)kvrow * 512 + (pn - 7) * 256 + lc, v0, v1); }
                    else if (pn <= 10) { store8(DV + (size_t)kvrow * 512 + (pn - 9) * 256 + lc, v0, v1); }
                    else {
#pragma unroll
                        for (int j = 0; j < 4; ++j) { v0[j] = sigmoidf_(v0[j]); v1[j] = sigmoidf_(v1[j]); }
                        store8(MG + (size_t)row * 2048 + (pn - 13) * 256 + lc, v0, v1);
                    }
                }
                if (pn <= 2) {
                    ssq += __shfl_xor(ssq, 16); ssq += __shfl_xor(ssq, 32);
                    if (fq == 0) { if (pn == 0) atomicAdd(SSKV + kvrow, ssq); else if (lat) atomicAdd(SSQ + row, ssq); }
                }
            }
    }
};
struct EpiQ {
    static constexpr bool PERM = true, AFTER_DRAIN = false;
    bf16_t* QMLA; const float* SSQ; const cs_t* CS8;
    __device__ __forceinline__ void operator()(EPI_ARGS) const {
        EPI_RECOMPUTE
        const int row0 = u.pm * 256 + wr * 64 + fr;
#pragma unroll
        for (int ai = 0; ai < 2; ++ai)
#pragma unroll
            for (int m = 0; m < 4; ++m) {
                __builtin_amdgcn_sched_barrier(0); const int row = opq(row0 + ai * 128 + m * 16); const int s = row & (SEQ - 1), gr = s >> 6, gc = s & 63;
                const float rs = 1.f / sqrtf(SSQ[row] * (1.f / 384.f) + 1e-6f);
#pragma unroll
                for (int bj = 0; bj < 2; ++bj) {
                    f32x4 v0 = acc[ai][bj][m][0] * rs, v1 = acc[ai][bj][m][1] * rs;
                    const int c0 = u.pn * 256 + bj * 128 + wc * 32 + 8 * fq, d = c0 % 96;
                    rope32(v0, v1, CS8, gr, gc, (d - 64) >> 3, d >= 64);
                    store8(QMLA + (size_t)row * 768 + c0, v0, v1);
                }
            }
    }
};
struct EpiKV {
    static constexpr bool PERM = true, AFTER_DRAIN = false;
    bf16_t *KMLA, *VMLA; const float* SSKV;
    __device__ __forceinline__ void operator()(EPI_ARGS) const {
        EPI_RECOMPUTE
        const int row0 = u.pm * 256 + wr * 64 + fr;
#pragma unroll
        for (int ai = 0; ai < 2; ++ai)
#pragma unroll
            for (int m = 0; m < 4; ++m) {
                __builtin_amdgcn_sched_barrier(0); const int row = opq(row0 + ai * 128 + m * 16);
                const float rs = 1.f / sqrtf(SSKV[row] * (1.f / 256.f) + 1e-6f);
#pragma unroll
                for (int bj = 0; bj < 2; ++bj) {
                    const f32x4 v0 = acc[ai][bj][m][0] * rs, v1 = acc[ai][bj][m][1] * rs;
                    const int h = u.pn * 2 + bj, d = wc * 32 + 8 * fq;
                    if (wc < 2) store8(KMLA + (size_t)row * 768 + h * 96 + d, v0, v1);
                    else store8(VMLA + (size_t)row * 512 + h * 64 + (d - 64), v0, v1);
                }
            }
    }
};
template <bool ACCUM> struct EpiZ {
    static constexpr bool PERM = true, AFTER_DRAIN = false;
    bf16_t* Z; const bf16_t* MG;
    __device__ __forceinline__ void operator()(EPI_ARGS) const {
        EPI_RECOMPUTE
        const int row0 = u.pm * 256 + wr * 64 + fr;
#pragma unroll
        for (int ai = 0; ai < 2; ++ai)
#pragma unroll
            for (int m = 0; m < 4; ++m) {
                __builtin_amdgcn_sched_barrier(0); const int row = opq(row0 + ai * 128 + m * 16);
#pragma unroll
                for (int bj = 0; bj < 2; ++bj) {
                    f32x4 v0 = acc[ai][bj][m][0], v1 = acc[ai][bj][m][1];
                    const int c0 = u.pn * 256 + bj * 128 + wc * 32 + 8 * fq;
                    const u32x4 g = *(const u32x4*)(MG + (size_t)row * 2048 + c0);
                    v0[0] *= bflo(g.x); v0[1] *= bfhi(g.x); v0[2] *= bflo(g.y); v0[3] *= bfhi(g.y);
                    v1[0] *= bflo(g.z); v1[1] *= bfhi(g.z); v1[2] *= bflo(g.w); v1[3] *= bfhi(g.w);
                    bf16_t* zp = Z + (size_t)row * 1024 + c0;
                    if (ACCUM) { const u32x4 z = *(const u32x4*)zp;
                        v0[0] += bflo(z.x); v0[1] += bfhi(z.x); v0[2] += bflo(z.y); v0[3] += bfhi(z.y);
                        v1[0] += bflo(z.z); v1[1] += bfhi(z.z); v1[2] += bflo(z.w); v1[3] += bfhi(z.w); }
                    store8(zp, v0, v1);
                }
            }
    }
};
struct EpiOut {
    static constexpr bool PERM = true, AFTER_DRAIN = false;
    float* OUT; const float* X; const float* MOD;
    __device__ __forceinline__ void operator()(EPI_ARGS) const {
        EPI_RECOMPUTE
        const int row0 = u.pm * 256 + wr * 64 + fr; const float ALPHA = 1.189207115002721f;
        const float* gate = MOD + (size_t)(u.pm >> 5) * 3072 + 2048;
#pragma unroll
        for (int ai = 0; ai < 2; ++ai)
#pragma unroll
            for (int m = 0; m < 4; ++m) {
                __builtin_amdgcn_sched_barrier(0); const int row = opq(row0 + ai * 128 + m * 16);
#pragma unroll
                for (int bj = 0; bj < 2; ++bj) {
                    const int c0 = u.pn * 256 + bj * 128 + wc * 32 + 8 * fq;
                    const f32x4 x0 = *(const f32x4*)(X + (size_t)row * 1024 + c0), x1 = *(const f32x4*)(X + (size_t)row * 1024 + c0 + 4);
                    const f32x4 g0 = *(const f32x4*)(gate + c0), g1 = *(const f32x4*)(gate + c0 + 4);
                    *(f32x4*)(OUT + (size_t)row * 1024 + c0) = x0 * ALPHA + g0 * acc[ai][bj][m][0];
                    *(f32x4*)(OUT + (size_t)row * 1024 + c0 + 4) = x1 * ALPHA + g1 * acc[ai][bj][m][1];
                }
            }
    }
};
constexpr size_t MiB = 1u << 20;
constexpr size_t WS_SSKV = 0, WS_SSQ = 512 * 1024, CTL_ZERO_BYTES = 1 * MiB;
constexpr size_t WS_MOD = 1 * MiB, WS_CS16 = 1 * MiB + 128 * 1024, WS_CS8 = 1 * MiB + 192 * 1024;
constexpr size_t WS_WIN = 2 * MiB, WS_WUQ = 13 * MiB, WS_WUKV = 14 * MiB, WS_WOA = 15 * MiB, WS_WOB = 16 * MiB, WS_WOUT = 17 * MiB;
constexpr size_t WS_HBF = 32 * MiB;
constexpr size_t WS_VMLA = WS_HBF, WS_Z = WS_HBF;
constexpr size_t WS_KMLA = 164 * MiB;
constexpr size_t WS_GA = 263 * MiB;
constexpr size_t WS_DQ = 327 * MiB;
constexpr size_t WS_DK = 391 * MiB;
constexpr size_t WS_DV = 457 * MiB;
constexpr size_t WS_GD = 523 * MiB;
constexpr size_t WS_MG = 587 * MiB;
constexpr size_t WS_QMLA = 843 * MiB;
constexpr size_t WS_END = 939 * MiB;
constexpr size_t OUT_CKV = 0, OUT_CQ = 33 * MiB;
constexpr int LDS_BYTES = 131072;

struct Args {
    const float *x, *c, *ctx, *c_ctx, *w_mod, *b_mod, *w_in, *q_norm, *kv_norm, *w_uq, *w_ukv, *dlam, *subln, *w_oa, *w_ob, *w_out, *ln_g, *ln_b;
    float* out; unsigned char* ws;
};

__device__ __forceinline__ void tr_item(const float* __restrict__ W, int K, int N, int srcn0, const float* __restrict__ ksc, bf16_t* WT, int dstn0, int k0, float* scr, int lane) {
#pragma unroll 8
    for (int i = 0; i < 32; ++i) { const int kk = 2 * i + (lane >> 5);
        float v = 0.f; if (srcn0 >= 0) { v = W[(size_t)(k0 + kk) * N + srcn0 + (lane & 31)]; if (ksc) v *= ksc[k0 + kk]; }
        scr[kk * 33 + (lane & 31)] = v; }
    asm volatile("s_waitcnt lgkmcnt(0)" ::: "memory");
    const int c = lane & 7;
#pragma unroll
    for (int j = 0; j < 4; ++j) { const int n = (lane >> 3) + 8 * j; const float* s = scr + (8 * c) * 33 + n;
        u32x4 o; o.x = cvtpk(s[0 * 33], s[1 * 33]); o.y = cvtpk(s[2 * 33], s[3 * 33]); o.z = cvtpk(s[4 * 33], s[5 * 33]); o.w = cvtpk(s[6 * 33], s[7 * 33]);
        *(u32x4*)(WT + (size_t)(dstn0 + n) * K + k0 + 8 * c) = o; }
    asm volatile("s_waitcnt lgkmcnt(0)" ::: "memory");
}

__global__ void __launch_bounds__(512, 2) fwd_mega(Args a) {
    extern __shared__ __attribute__((aligned(16))) unsigned char lds[];
    cg::grid_group grid = cg::this_grid();
    const int wave = __builtin_amdgcn_readfirstlane((int)threadIdx.x >> 6);
#define LANE_TID const int lane = lane_id_v(), tid = wave * 64 + lane; (void)tid; (void)lane;
    const int G = gridDim.x, bid = blockIdx.x;
    const int gw = bid * 8 + wave, NGW = G * 8;
    unsigned char* ws = a.ws; unsigned char* ob = (unsigned char*)a.out;
    float* SSKV = (float*)(ws + WS_SSKV); float* SSQ = (float*)(ws + WS_SSQ); float* MOD = (float*)(ws + WS_MOD);
    cs_t* CS16 = (cs_t*)(ws + WS_CS16); cs_t* CS8 = (cs_t*)(ws + WS_CS8);
    bf16_t* WIN = (bf16_t*)(ws + WS_WIN); bf16_t* WUQ = (bf16_t*)(ws + WS_WUQ); bf16_t* WUKV = (bf16_t*)(ws + WS_WUKV);
    bf16_t* WOA = (bf16_t*)(ws + WS_WOA); bf16_t* WOB = (bf16_t*)(ws + WS_WOB); bf16_t* WOUT = (bf16_t*)(ws + WS_WOUT);
    bf16_t* HBF = (bf16_t*)(ws + WS_HBF); bf16_t* VMLA = (bf16_t*)(ws + WS_VMLA); bf16_t* Z = (bf16_t*)(ws + WS_Z);
    bf16_t* KMLA = (bf16_t*)(ws + WS_KMLA); bf16_t* GA = (bf16_t*)(ws + WS_GA); bf16_t* DQ = (bf16_t*)(ws + WS_DQ); bf16_t* DK = (bf16_t*)(ws + WS_DK);
    bf16_t* DV = (bf16_t*)(ws + WS_DV); bf16_t* GD = (bf16_t*)(ws + WS_GD); bf16_t* MG = (bf16_t*)(ws + WS_MG); bf16_t* QMLA = (bf16_t*)(ws + WS_QMLA);
    bf16_t* CKV = (bf16_t*)(ob + OUT_CKV); bf16_t* CQ = (bf16_t*)(ob + OUT_CQ);
    PG8_LAS unsigned char* ldsp = (PG8_LAS unsigned char*)lds;

#ifndef PHMASK
#define PHMASK 0xfff
#endif
    if (PHMASK & (1 << 0)) {
        LANE_TID
        float* A = (float*)lds; float* red = (float*)(lds + 36864);
        for (int cb = bid; cb < 96; cb += G) {
            __syncthreads();
            for (int i = tid; i < 9 * 1024; i += 512) { const int r = i >> 10, k = i & 1023; const float v = r < 8 ? a.c[r * 1024 + k] : a.c_ctx[k]; A[i] = v * sigmoidf_(v); }
            __syncthreads();
            const int cl = tid & 31, col = cb * 32 + cl, kq = tid >> 5;
            float acc[9];
#pragma unroll
            for (int r = 0; r < 9; ++r) acc[r] = 0.f;
#pragma unroll 4
            for (int kk = 0; kk < 64; ++kk) { const int k = kq * 64 + kk; const float w = a.w_mod[(size_t)k * 3072 + col];
#pragma unroll
                for (int r = 0; r < 9; ++r) acc[r] += A[r * 1024 + k] * w; }
#pragma unroll
            for (int r = 0; r < 9; ++r) red[(kq * 9 + r) * 32 + cl] = acc[r];
            __syncthreads();
            if (tid < 288) { const int r = tid >> 5; float s = 0.f;
                for (int q = 0; q < 16; ++q) s += red[(q * 9 + r) * 32 + cl];
                MOD[r * 3072 + col] = s + a.b_mod[col]; }
        }
        __syncthreads();
        float* scr = (float*)lds + wave * (64 * 33);
        constexpr int I_IN = 16 * 168, I_UQ = 6 * 24, I_UKV = 4 * 32, I_OA = 8 * 32, I_OB = 8 * 32, I_OUT = 16 * 32;
        constexpr int NITEMS = I_IN + I_UQ + I_UKV + I_OA + I_OB + I_OUT;
        for (int it = gw; it < NITEMS; it += NGW) {
            int r = it;
            if (r < I_IN) { const int kb = r / 168, nb = r % 168, d0 = nb * 32;
                const int s0 = d0 < 256 ? 384 + d0 : d0 < 640 ? d0 - 256 : d0 < 672 ? d0 : d0 < 768 ? -1 : d0 - 96;
                tr_item(a.w_in, 1024, 5280, s0, nullptr, WIN, d0, kb * 64, scr, lane); continue; } r -= I_IN;
            if (r < I_UQ) { tr_item(a.w_uq, 384, 768, (r % 24) * 32, a.q_norm, WUQ, (r % 24) * 32, (r / 24) * 64, scr, lane); continue; } r -= I_UQ;
            if (r < I_UKV) { tr_item(a.w_ukv, 256, 1024, (r % 32) * 32, a.kv_norm, WUKV, (r % 32) * 32, (r / 32) * 64, scr, lane); continue; } r -= I_UKV;
            if (r < I_OA) { tr_item(a.w_oa, 512, 1024, (r % 32) * 32, nullptr, WOA, (r % 32) * 32, (r / 32) * 64, scr, lane); continue; } r -= I_OA;
            if (r < I_OB) { tr_item(a.w_ob, 512, 1024, (r % 32) * 32, nullptr, WOB, (r % 32) * 32, (r / 32) * 64, scr, lane); continue; } r -= I_OB;
            tr_item(a.w_out, 1024, 1024, (r % 32) * 32, nullptr, WOUT, (r % 32) * 32, (r / 32) * 64, scr, lane);
        }
        if (bid == G - 1) {
            for (int i = tid; i < 128 * 16; i += 512) { const int pos = i >> 4, f = i & 15; const float inv = powf(10000.f, -(float)f / 16.f), ang = (float)pos * inv; CS16[i] = make_float2(cosf(ang), sinf(ang)); }
            for (int i = tid; i < 128 * 8; i += 512) { const int pos = i >> 3, f = i & 7; const float inv = powf(10000.f, -(float)f / 8.f), ang = (float)pos * inv; CS8[i] = make_float2(cosf(ang), sinf(ang)); }
        }
    }
    grid.sync();

    if (PHMASK & (1 << 1)) for (int m = gw; m < MALL; m += NGW) {
        LANE_TID
        const float* src; const float* mod;
        if (m < MLAT) { src = a.x + (size_t)m * 1024; mod = MOD + (size_t)(m >> 13) * 3072; } else { src = a.ctx + (size_t)(m - MLAT) * 1024; mod = MOD + 8 * 3072; }
#pragma unroll
        for (int j = 0; j < 4; ++j) { const int c4 = lane + 64 * j;
            const f32x4 v = ((const f32x4*)src)[c4], sh = ((const f32x4*)mod)[c4], sc = ((const f32x4*)(mod + 1024))[c4];
            const f32x4 h = v * (sc + 1.f) + sh; u32x2 w; w.x = cvtpk(h[0], h[1]); w.y = cvtpk(h[2], h[3]);
            *(u32x2*)(HBF + (size_t)m * 1024 + c4 * 4) = w; }
    }
    grid.sync();

    if (PHMASK & (1 << 2)) {
        pg8::Gemm g{HBF, WIN, MALL, NINP, 1024}; pg8::StaticOrder S; S.init(MALL, NINP, G, bid);
        EpiP1 E{CKV, CQ, KMLA, GA, DQ, DK, DV, GD, MG, SSKV, SSQ, CS16, CS8};
        pg8::gemm_phase<EpiP1, pg8::StaticOrder, true, true>(ldsp, g, S, E, wave);
    }
    grid.sync();

    if (PHMASK & (1 << 3)) {
        pg8::Gemm g{CQ, WUQ, MLAT, 768, 384}; pg8::StaticOrder S; S.init(MLAT, 768, G, bid);
        EpiQ E{QMLA, SSQ, CS8};
        pg8::gemm_phase<EpiQ, pg8::StaticOrder, true, true>(ldsp, g, S, E, wave);
    }
    if (PHMASK & (1 << 4)) {
        pg8::Gemm g{CKV, WUKV, MALL, 1024, 256}; pg8::StaticOrder S; S.init(MALL, 1024, G, bid);
        EpiKV E{KMLA, VMLA, SSKV};
        pg8::gemm_phase<EpiKV, pg8::StaticOrder, true, true>(ldsp, g, S, E, wave);
    }
    grid.sync();

    if (PHMASK & (1 << 5)) {
        float lam;
        { LANE_TID
        { const float s1 = wave_sum(a.dlam[lane] * a.dlam[64 + lane]), s2 = wave_sum(a.dlam[128 + lane] * a.dlam[192 + lane]); lam = __expf(s1) - __expf(s2) + 0.2f; } }
        const bool xcd_order = (G == 256);
        const int nrounds = xcd_order ? 12 : (NB * 12 * 32 + G - 1) / G;
        for (int rd = 0; rd < nrounds; ++rd) {
            int b, hs, qb;
            if (xcd_order) { b = bid & 7; qb = bid >> 3; hs = rd; }
            else { const int idx = rd * G + bid; if (idx >= NB * 12 * 32) break; b = idx / (12 * 32); hs = (idx / 32) % 12; qb = idx % 32; }
            const size_t qrow0 = (size_t)b * SEQ + qb * 256, krow0 = (size_t)b * SKV;
            __syncthreads();
            LANE_TID
            const int r32 = lane & 31, hi = lane >> 5;
            if (hs < 8) { if (PHMASK & (1 << 5)) {
                f32x16 o[2];
                att::attn_core<true>(QMLA + qrow0 * 768 + hs * 96, KMLA + krow0 * 768 + hs * 96, VMLA + krow0 * 512 + hs * 64, SKV, (char*)lds, o, wave);
                char* T = (char*)lds + 51200 + wave * 8192; char* tw = T + hi * 512 + r32 * 2;
#pragma unroll
                for (int r = 0; r < 16; ++r)
#pragma unroll
                    for (int d0 = 0; d0 < 2; ++d0) *(bf16_t*)(tw + ((r & 3) + 8 * (r >> 2)) * 128 + d0 * 64) = (bf16_t)cvtpk(o[d0][r], o[d0][r]);
#pragma unroll
                for (int j = 0; j < 4; ++j) { const int id = j * 64 + lane, row = id >> 3, c8 = id & 7;
                    const u32x4 t = *(const u32x4*)(T + id * 16);
                    bf16_t* gp = GA + (qrow0 + wave * 32 + row) * 512 + hs * 64 + c8 * 8; const u32x4 g = *(const u32x4*)gp;
                    u32x4 w; w.x = cvtpk(bflo(t.x) * bflo(g.x), bfhi(t.x) * bfhi(g.x)); w.y = cvtpk(bflo(t.y) * bflo(g.y), bfhi(t.y) * bfhi(g.y));
                    w.z = cvtpk(bflo(t.z) * bflo(g.z), bfhi(t.z) * bfhi(g.z)); w.w = cvtpk(bflo(t.w) * bflo(g.w), bfhi(t.w) * bfhi(g.w));
                    *(u32x4*)gp = w; }
            } } else if (PHMASK & (1 << 6)) {
                const int h = hs - 8;
                unsigned* stash = (unsigned*)(lds + 51200 + wave * 8192) + lane;
                f32x16 o[4];
                att::attn_core<false>(DQ + qrow0 * 512 + h * 128, DK + krow0 * 512 + h * 128, DV + krow0 * 512 + h * 128, SKV, (char*)lds, o, wave);
#pragma unroll
                for (int d0 = 0; d0 < 4; ++d0)
#pragma unroll
                    for (int r = 0; r < 16; r += 2) stash[(d0 * 8 + (r >> 1)) * 64] = cvtpk(o[d0][r], o[d0][r + 1]);
                att::attn_core<false>(DQ + qrow0 * 512 + h * 128 + 64, DK + krow0 * 512 + h * 128 + 64, DV + krow0 * 512 + h * 128, SKV, (char*)lds, o, wave);
#pragma unroll
                for (int d0 = 0; d0 < 4; ++d0)
#pragma unroll
                    for (int r = 0; r < 16; r += 2) { const unsigned w = stash[(d0 * 8 + (r >> 1)) * 64];
                        o[d0][r] = bflo(w) - lam * o[d0][r]; o[d0][r + 1] = bfhi(w) - lam * o[d0][r + 1]; }
                asm volatile("s_waitcnt lgkmcnt(0)" ::: "memory"); SBAR();
                char* T = (char*)lds + 51200 + wave * 8192; char* tw = T + hi * 1024 + r32 * 2;
#pragma unroll
                for (int r = 0; r < 16; ++r)
#pragma unroll
                    for (int d0 = 0; d0 < 4; ++d0) *(bf16_t*)(tw + ((r & 3) + 8 * (r >> 2)) * 256 + d0 * 64) = (bf16_t)cvtpk(o[d0][r], o[d0][r]);
                const int c16 = lane & 15;
                const f32x4 sw0 = *(const f32x4*)(a.subln + c16 * 8), sw1 = *(const f32x4*)(a.subln + c16 * 8 + 4);
#pragma unroll
                for (int j = 0; j < 8; ++j) { const int id = j * 64 + lane, row = id >> 4;
                    const u32x4 t = *(const u32x4*)(T + id * 16);
                    float e[8] = {bflo(t.x), bfhi(t.x), bflo(t.y), bfhi(t.y), bflo(t.z), bfhi(t.z), bflo(t.w), bfhi(t.w)};
                    float ss = 0.f;
#pragma unroll
                    for (int k = 0; k < 8; ++k) ss += e[k] * e[k];
                    ss += __shfl_xor(ss, 1); ss += __shfl_xor(ss, 2); ss += __shfl_xor(ss, 4); ss += __shfl_xor(ss, 8);
                    const float rs = 0.8f / sqrtf(ss * (1.f / 128.f) + 1e-5f);
                    bf16_t* gp = GD + (qrow0 + wave * 32 + row) * 512 + h * 128 + c16 * 8; const u32x4 g = *(const u32x4*)gp;
                    u32x4 w; w.x = cvtpk(e[0] * rs * sw0[0] * bflo(g.x), e[1] * rs * sw0[1] * bfhi(g.x)); w.y = cvtpk(e[2] * rs * sw0[2] * bflo(g.y), e[3] * rs * sw0[3] * bfhi(g.y));
                    w.z = cvtpk(e[4] * rs * sw1[0] * bflo(g.z), e[5] * rs * sw1[1] * bfhi(g.z)); w.w = cvtpk(e[6] * rs * sw1[2] * bflo(g.w), e[7] * rs * sw1[3] * bfhi(g.w));
                    *(u32x4*)gp = w; }
            }
        }
    }
    grid.sync();

    if (PHMASK & (1 << 7)) {
        pg8::Gemm g{GA, WOA, MLAT, 1024, 512}; pg8::StaticOrder S; S.init(MLAT, 1024, G, bid);
        EpiZ<false> E{Z, MG};
        pg8::gemm_phase<EpiZ<false>, pg8::StaticOrder, true, true>(ldsp, g, S, E, wave);
    }
    if (PHMASK & (1 << 8)) {
        pg8::Gemm g{GD, WOB, MLAT, 1024, 512}; pg8::StaticOrder S; S.init(MLAT, 1024, G, bid);
        EpiZ<true> E{Z, MG + 1024};
        pg8::gemm_phase<EpiZ<true>, pg8::StaticOrder, true, true>(ldsp, g, S, E, wave);
    }
    grid.sync();

    if (PHMASK & (1 << 9)) {
        pg8::Gemm g{Z, WOUT, MLAT, 1024, 1024}; pg8::StaticOrder S; S.init(MLAT, 1024, G, bid);
        EpiOut E{a.out, a.x, MOD};
        pg8::gemm_phase<EpiOut, pg8::StaticOrder, true, true>(ldsp, g, S, E, wave);
    }
    grid.sync();

    if (PHMASK & (1 << 10)) for (int m = gw; m < MLAT; m += NGW) {
        LANE_TID
        f32x4* rowp = (f32x4*)(a.out + (size_t)m * 1024) + lane;
        f32x4 v[4]; float s = 0.f;
#pragma unroll
        for (int j = 0; j < 4; ++j) { v[j] = rowp[64 * j]; s += (v[j][0] + v[j][1]) + (v[j][2] + v[j][3]); }
        const float mean = wave_sum(s) * (1.f / 1024.f); float s2 = 0.f;
#pragma unroll
        for (int j = 0; j < 4; ++j) { v[j] = v[j] - mean; s2 += (v[j][0] * v[j][0] + v[j][1] * v[j][1]) + (v[j][2] * v[j][2] + v[j][3] * v[j][3]); }
        const float rstd = 1.f / sqrtf(wave_sum(s2) * (1.f / 1024.f) + 1e-5f);
#pragma unroll
        for (int j = 0; j < 4; ++j) { const f32x4 g = ((const f32x4*)a.ln_g)[lane + 64 * j], bb = ((const f32x4*)a.ln_b)[lane + 64 * j]; rowp[64 * j] = v[j] * rstd * g + bb; }
    }
}

extern "C" void kernel_launch(void* const* d_in, const int* in_sizes, int n_in, void* d_out, int out_size, void* d_ws, size_t ws_size, hipStream_t stream) {
    static int grid = 0;
    if (grid == 0) {
        if (n_in != 18 || in_sizes[0] != MLAT * DM || out_size != MLAT * DM || ws_size < WS_END) {
            fprintf(stderr, "kernel_launch: shape/workspace mismatch: n_in %d in0 %d out %d ws %zu (need %zu)\n", n_in, n_in > 0 ? in_sizes[0] : -1, out_size, ws_size, (size_t)WS_END); grid = -1; return; }
        int dev = 0, cus = 0, per_cu = 0;
        hipGetDevice(&dev); hipDeviceGetAttribute(&cus, hipDeviceAttributeMultiprocessorCount, dev);
        if (hipFuncSetAttribute((const void*)fwd_mega, hipFuncAttributeMaxDynamicSharedMemorySize, LDS_BYTES) != hipSuccess) { fprintf(stderr, "kernel_launch: hipFuncSetAttribute failed\n"); grid = -1; return; }
        if (hipOccupancyMaxActiveBlocksPerMultiprocessor(&per_cu, (const void*)fwd_mega, 512, LDS_BYTES) != hipSuccess || per_cu < 1) { fprintf(stderr, "kernel_launch: occupancy query gave %d\n", per_cu); per_cu = 1; }
        (void)hipGetLastError();
        grid = cus * 1;
    }
    if (grid < 0) return;
    hipMemsetAsync((char*)d_ws, 0, CTL_ZERO_BYTES, stream);
    Args a{};
    a.x = (const float*)d_in[0]; a.c = (const float*)d_in[1]; a.ctx = (const float*)d_in[2]; a.c_ctx = (const float*)d_in[3]; a.w_mod = (const float*)d_in[4]; a.b_mod = (const float*)d_in[5];
    a.w_in = (const float*)d_in[6]; a.q_norm = (const float*)d_in[7]; a.kv_norm = (const float*)d_in[8]; a.w_uq = (const float*)d_in[9]; a.w_ukv = (const float*)d_in[10];
    a.dlam = (const float*)d_in[11]; a.subln = (const float*)d_in[12]; a.w_oa = (const float*)d_in[13]; a.w_ob = (const float*)d_in[14]; a.w_out = (const float*)d_in[15];
    a.ln_g = (const float*)d_in[16]; a.ln_b = (const float*)d_in[17]; a.out = (float*)d_out; a.ws = (unsigned char*)d_ws;
    void* args[] = {&a};
    hipError_t e = hipLaunchCooperativeKernel((const void*)fwd_mega, dim3(grid), dim3(512), args, LDS_BYTES, stream);
    if (e != hipSuccess) fprintf(stderr, "kernel_launch: cooperative launch failed: %s (grid %d)\n", hipGetErrorString(e), grid);
}
```

```cpp
#include <hip/hip_runtime.h>
#include <hip/hip_cooperative_groups.h>
#include <cstdio>
#include <cstdint>
namespace cg = cooperative_groups;
__device__ __forceinline__ int opq(int v) { asm volatile("" : "+v"(v)); return v; }
__device__ __forceinline__ int lane_id_v() { int l; asm volatile("v_mbcnt_lo_u32_b32 %0, -1, 0\n\tv_mbcnt_hi_u32_b32 %0, -1, %0" : "=v"(l)); return l; }
__device__ __forceinline__ float shflx(float v, int mask) { return __builtin_bit_cast(float, __builtin_amdgcn_ds_bpermute((lane_id_v() ^ mask) << 2, __builtin_bit_cast(int, v))); }
__device__ __forceinline__ float shfli(float v, int idx4) { return __builtin_bit_cast(float, __builtin_amdgcn_ds_bpermute(idx4, __builtin_bit_cast(int, v))); }
namespace pg8 {
#define PG8_LAS __attribute__((address_space(3)))
typedef unsigned short bf16_t;
typedef short bf16x8 __attribute__((ext_vector_type(8)));
typedef float f32x4 __attribute__((ext_vector_type(4)));
typedef unsigned u32x4 __attribute__((ext_vector_type(4)));
constexpr int BM = 256, BK = 64, HALF = 128, HTB = HALF * BK * 2  , STAGE_BYTES = 8 * HTB, NXCD = 8, WGM = 8;

__host__ __device__ __forceinline__ int lds_byte(int r, int c) { const int st = (r >> 4) * 2 + (c >> 5), rr = r & 15, cc = c & 31, ob = rr * 64 + cc * 2; return st * 1024 + (ob ^ (((ob >> 9) & 1) << 5)); }
__host__ __device__ __forceinline__ void stage_rc(int b, int& R, int& C) { const int st = b / 1024, sb = b % 1024, swz = sb ^ (((sb >> 9) & 1) << 5); R = (st >> 1) * 16 + swz / 64; C = (st & 1) * 32 + (swz % 64) / 2; }
__host__ __device__ __forceinline__ int perm32(int rho) { const int n = rho >> 4, i = rho & 15; return 8 * (i >> 2) + 4 * n + (i & 3); }

struct Unit { int pm, pn; };
struct Gemm { const bf16_t* A; const bf16_t* Bt; int M, N, K; };

struct StaticOrder {
    int nM, nN, nwg, G, c;
    __host__ __device__ void init(int M, int N, int G_, int c_) { nM = M / BM; nN = N / BM; nwg = nM * nN; G = G_; c = c_; }
    __host__ __device__ bool next(int i, Unit& u) const {
        const long L = (long)i * G + c; if (L >= nwg) return false;
        int wgid = (int)L; { const int q = nwg / NXCD, r = nwg % NXCD, xcd = wgid % NXCD, off = wgid / NXCD; wgid = (xcd < r ? xcd * (q + 1) : r * (q + 1) + (xcd - r) * q) + off; }
        const int nig = WGM * nN, gid = wgid / nig, fm = gid * WGM, gsz = (nM - fm) < WGM ? (nM - fm) : WGM;
        u.pm = fm + ((wgid % nig) % gsz); u.pn = (wgid % nig) / gsz; return true;
    }
    __device__ __forceinline__ void a_ready(const Unit&) const {}
    __device__ __forceinline__ void done(const Unit&) const {}
};

template <class Epi, class Sched, bool ALIGN_EPI = false, bool SP2 = false>
__device__ __forceinline__ void gemm_phase(PG8_LAS unsigned char* lds, const Gemm g, const Sched& S, const Epi& E, const int wid  ) {
    const int lane = lane_id_v(), tid = wid * 64 + lane, wr = wid >> 2, wc = wid & 3, fr = lane & 15, fq = lane >> 4;
    const int K = g.K, nt = K / BK;
    unsigned voffA[2], voffB[2];
#pragma unroll
    for (int i = 0; i < 2; ++i) { int R, C; stage_rc(tid * 16 + i * 8192, R, C); const int Rb = Epi::PERM ? ((R & ~31) + perm32(R & 31)) : R;
        voffA[i] = (unsigned)(R * K + C) * 2u; voffB[i] = (unsigned)(Rb * K + C) * 2u; }
    const size_t kstep = (size_t)(BK * 2);
    const size_t hstep = (size_t)HALF * K * 2;
    const size_t tstep = 2 * hstep;
    const unsigned ldsw = (unsigned)wid * 1024u;
    const int aoff = lds_byte(wr * 64 + fr, fq * 8), boff = lds_byte(wc * 32 + fr, fq * 8);
#define PG8_SA(b, h) (((b) * 2 + (h)) * HTB)
#define PG8_SB(b, h) ((4 + (b) * 2 + (h)) * HTB)
#define PG8_STAGE(bufoff, gbase, voff) do { _Pragma("unroll") for (int _i = 0; _i < 2; ++_i) \
        __builtin_amdgcn_global_load_lds((const unsigned*)((const char*)(gbase) + (voff)[_i]), (PG8_LAS unsigned*)(lds + (bufoff) + ldsw + _i * 8192), 16, 0, 0); } while (0)
#define PG8_LDA(dst, b, h) do { _Pragma("unroll") for (int m = 0; m < 4; ++m) _Pragma("unroll") for (int k = 0; k < 2; ++k) dst[m][k] = *(const PG8_LAS bf16x8*)(lds + PG8_SA(b, h) + aoff + m * 2048 + k * 1024); } while (0)
#define PG8_LDB(dst, b, h) do { _Pragma("unroll") for (int n = 0; n < 2; ++n) _Pragma("unroll") for (int k = 0; k < 2; ++k) dst[n][k] = *(const PG8_LAS bf16x8*)(lds + PG8_SB(b, h) + boff + n * 2048 + k * 1024); } while (0)
#define PG8_MMA(ai, bj, At, Bt) do { __builtin_amdgcn_s_setprio(1); _Pragma("unroll") for (int m = 0; m < 4; ++m) _Pragma("unroll") for (int n = 0; n < 2; ++n) _Pragma("unroll") for (int k = 0; k < 2; ++k) \
        acc[ai][bj][m][n] = __builtin_amdgcn_mfma_f32_16x16x32_bf16(Bt[n][k], At[m][k], acc[ai][bj][m][n], 0, 0, 0); __builtin_amdgcn_s_setprio(0); } while (0)
#define PG8_WAIT_V(n) asm volatile("s_waitcnt vmcnt(" #n ")" ::: "memory")
#define PG8_WAIT_L(n) asm volatile("s_waitcnt lgkmcnt(" #n ")" ::: "memory")
#define PG8_BAR __builtin_amdgcn_s_barrier()
#define PG8_SCHED __builtin_amdgcn_sched_barrier(0)
    Unit cur, nxt; int ui = 0;
    if (!S.next(0, cur)) return;
    f32x4 acc[2][2][4][2];
#pragma unroll
    for (int a = 0; a < 2; ++a)
#pragma unroll
        for (int b = 0; b < 2; ++b)
#pragma unroll
            for (int m = 0; m < 4; ++m)
#pragma unroll
                for (int n = 0; n < 2; ++n) acc[a][b][m][n] = (f32x4){0.f, 0.f, 0.f, 0.f};
    bf16x8 At[4][2], B0[2][2], B1[2][2];
    const char* cA = (const char*)g.A + (size_t)cur.pm * tstep; const char* cB = (const char*)g.Bt + (size_t)cur.pn * tstep;
    S.a_ready(cur);
    if constexpr (SP2) {
        PG8_STAGE(PG8_SB(0, 0), cB, voffB); PG8_STAGE(PG8_SB(0, 1), cB + hstep, voffB); PG8_STAGE(PG8_SA(0, 0), cA, voffA); PG8_STAGE(PG8_SA(0, 1), cA + hstep, voffA);
        if (wr == 1) PG8_BAR;
        PG8_WAIT_V(2); PG8_BAR;
        PG8_STAGE(PG8_SB(1, 0), cB + kstep, voffB); PG8_STAGE(PG8_SA(1, 0), cA + kstep, voffA); PG8_STAGE(PG8_SB(1, 1), cB + hstep + kstep, voffB);
        PG8_WAIT_V(6); PG8_BAR;
    } else {
        PG8_STAGE(PG8_SB(0, 0), cB, voffB); PG8_STAGE(PG8_SA(0, 0), cA, voffA); PG8_STAGE(PG8_SB(0, 1), cB + hstep, voffB); PG8_STAGE(PG8_SA(0, 1), cA + hstep, voffA);
        if (wr == 1) PG8_BAR;
        PG8_WAIT_V(4); PG8_BAR;
        PG8_STAGE(PG8_SB(1, 0), cB + kstep, voffB); PG8_STAGE(PG8_SA(1, 0), cA + kstep, voffA); PG8_STAGE(PG8_SB(1, 1), cB + hstep + kstep, voffB);
        PG8_WAIT_V(6); PG8_BAR;
    }
    for (;;) {
        const bool has_next = S.next(ui + 1, nxt);
        const char* nA = has_next ? (const char*)g.A + (size_t)nxt.pm * tstep : cA; const char* nB = has_next ? (const char*)g.Bt + (size_t)nxt.pn * tstep : cB;
        for (int t = 0; t < nt; t += 2) {
            const bool last = (t == nt - 2);
            const char* a1 = cA + (size_t)(t + 1) * kstep;
            const char* a2 = last ? nA : cA + (size_t)(t + 2) * kstep; const char* b2 = last ? nB : cB + (size_t)(t + 2) * kstep;
            const char* a3 = a2 + kstep; const char* b3 = b2 + kstep;
            if (last && has_next) S.a_ready(nxt);
            if constexpr (SP2) {
            PG8_LDB(B0, 0, 0); PG8_LDB(B1, 0, 1); PG8_SCHED; PG8_LDA(At, 0, 0); PG8_STAGE(PG8_SA(1, 1), a1 + hstep, voffA);
            PG8_WAIT_V(8); PG8_WAIT_L(0); PG8_BAR; PG8_MMA(0, 0, At, B0); PG8_MMA(0, 1, At, B1); PG8_BAR; PG8_SCHED;
            PG8_LDA(At, 0, 1); PG8_STAGE(PG8_SB(0, 0), b2, voffB); PG8_STAGE(PG8_SB(0, 1), b2 + hstep, voffB); PG8_STAGE(PG8_SA(0, 0), a2, voffA);
            PG8_WAIT_V(8); PG8_WAIT_L(0); PG8_BAR; PG8_MMA(1, 0, At, B0); PG8_MMA(1, 1, At, B1); PG8_BAR; PG8_SCHED;
            PG8_LDB(B0, 1, 0); PG8_LDB(B1, 1, 1); PG8_SCHED; PG8_LDA(At, 1, 0); PG8_STAGE(PG8_SA(0, 1), a2 + hstep, voffA);
            PG8_WAIT_V(8); PG8_WAIT_L(0); PG8_BAR; PG8_MMA(0, 0, At, B0); PG8_MMA(0, 1, At, B1); PG8_BAR; PG8_SCHED;
            PG8_LDA(At, 1, 1); PG8_STAGE(PG8_SB(1, 0), b3, voffB); PG8_STAGE(PG8_SB(1, 1), b3 + hstep, voffB); PG8_STAGE(PG8_SA(1, 0), a3, voffA);
            PG8_WAIT_V(8); PG8_WAIT_L(0); PG8_BAR; PG8_MMA(1, 0, At, B0); PG8_MMA(1, 1, At, B1); PG8_BAR; PG8_SCHED;
            } else {
            PG8_LDB(B0, 0, 0); PG8_SCHED; PG8_LDA(At, 0, 0); PG8_STAGE(PG8_SA(1, 1), a1 + hstep, voffA);
            PG8_WAIT_L(8); PG8_BAR; PG8_WAIT_L(0); PG8_MMA(0, 0, At, B0); PG8_BAR; PG8_SCHED;
            PG8_LDB(B1, 0, 1); PG8_STAGE(PG8_SB(0, 0), b2, voffB);
            PG8_BAR; PG8_WAIT_L(0); PG8_MMA(0, 1, At, B1); PG8_BAR;
            PG8_LDA(At, 0, 1); PG8_STAGE(PG8_SA(0, 0), a2, voffA);
            PG8_BAR; PG8_WAIT_L(0); PG8_MMA(1, 0, At, B0); PG8_BAR; PG8_SCHED;
            PG8_STAGE(PG8_SB(0, 1), b2 + hstep, voffB);
            PG8_WAIT_V(6); PG8_BAR; PG8_MMA(1, 1, At, B1); PG8_BAR;
            PG8_LDB(B0, 1, 0); PG8_SCHED; PG8_LDA(At, 1, 0); PG8_STAGE(PG8_SA(0, 1), a2 + hstep, voffA);
            PG8_WAIT_L(8); PG8_BAR; PG8_WAIT_L(0); PG8_MMA(0, 0, At, B0); PG8_BAR; PG8_SCHED;
            PG8_LDB(B1, 1, 1); PG8_STAGE(PG8_SB(1, 0), b3, voffB);
            PG8_BAR; PG8_WAIT_L(0); PG8_MMA(0, 1, At, B1); PG8_BAR;
            PG8_LDA(At, 1, 1); PG8_STAGE(PG8_SA(1, 0), a3, voffA);
            PG8_BAR; PG8_WAIT_L(0); PG8_MMA(1, 0, At, B0); PG8_BAR; PG8_SCHED;
            PG8_STAGE(PG8_SB(1, 1), b3 + hstep, voffB);
            PG8_WAIT_V(6); PG8_BAR; PG8_MMA(1, 1, At, B1); PG8_BAR;
            }
        }
        if constexpr (ALIGN_EPI) { if (wr == 0) PG8_BAR; }
        if constexpr (!Epi::AFTER_DRAIN) { E(acc, cur, wr, wc, fr, fq); S.done(cur); }
        if (!has_next) break;
#pragma unroll
        for (int a = 0; a < 2; ++a)
#pragma unroll
            for (int b = 0; b < 2; ++b)
#pragma unroll
                for (int m = 0; m < 4; ++m)
#pragma unroll
                    for (int n = 0; n < 2; ++n) acc[a][b][m][n] = (f32x4){0.f, 0.f, 0.f, 0.f};
        cur = nxt; cA = nA; cB = nB; ++ui;
        if constexpr (ALIGN_EPI) { if (wr == 1) PG8_BAR; }
    }
    PG8_WAIT_V(0);
    if constexpr (!ALIGN_EPI) { if (wr == 0) PG8_BAR; }
    PG8_BAR;
    if constexpr (Epi::AFTER_DRAIN) { E.fused(acc, cur, wr, wc, fr, fq, lds, wid, lane); S.done(cur); }
#undef PG8_SA
#undef PG8_SB
#undef PG8_STAGE
#undef PG8_LDA
#undef PG8_LDB
#undef PG8_MMA
#undef PG8_WAIT_V
#undef PG8_WAIT_L
#undef PG8_BAR
#undef PG8_SCHED
}
}
constexpr int DM = 1024, NB = 8, SEQ = 8192, CTX = 256, SKV = SEQ + CTX;
constexpr int MLAT = NB * SEQ, MALL = MLAT + NB * CTX;
constexpr int NINP = 5376;
typedef unsigned short bf16_t;
typedef short bf16x8 __attribute__((ext_vector_type(8)));
typedef short s16x4 __attribute__((ext_vector_type(4)));
typedef float f32x16 __attribute__((ext_vector_type(16)));
typedef float f32x4 __attribute__((ext_vector_type(4)));
typedef unsigned u32x4 __attribute__((ext_vector_type(4)));
typedef unsigned u32x2 __attribute__((ext_vector_type(2)));
#define LAS __attribute__((address_space(3)))
#define SBAR() __builtin_amdgcn_sched_barrier(0)
__device__ __forceinline__ unsigned cvtpk(float lo, float hi) { unsigned r; asm volatile("v_cvt_pk_bf16_f32 %0, %1, %2" : "=v"(r) : "v"(lo), "v"(hi)); return r; }
__device__ __forceinline__ unsigned f2bf(float f) { unsigned u = __builtin_bit_cast(unsigned, f); return (u + 0x7fffu + ((u >> 16) & 1u)) >> 16; }
__device__ __forceinline__ float bf2f(unsigned short b) { return __builtin_bit_cast(float, (unsigned)b << 16); }
__device__ __forceinline__ float bflo(unsigned w) { return __builtin_bit_cast(float, w << 16); }
__device__ __forceinline__ float bfhi(unsigned w) { return __builtin_bit_cast(float, w & 0xffff0000u); }
__device__ __forceinline__ float sigmoidf_(float v) { return 1.f / (1.f + __expf(-v)); }
__device__ __forceinline__ float wave_sum(float v) {
#pragma unroll
    for (int o = 1; o < 64; o <<= 1) v += shflx(v, o);
    return v;
}

namespace att {
template <bool MLA> struct Cfg {
    static constexpr int DQK = MLA ? 96 : 64, DV = MLA ? 64 : 128, NQ = DQK / 16, NCB = DV / 32;
    static constexpr int KROWB = MLA ? 256 : 128;
    static constexpr int LDQ = MLA ? 768 : 512, LDK = MLA ? 768 : 512, LDV = 512;
    static constexpr int SHM_V = 64 * DV * 2, SHM_K = 64 * KROWB;
};
constexpr float THR = 8.f;
__device__ __forceinline__ int crow(int r, int hi) { return (r & 3) + 8 * (r >> 2) + 4 * hi; }
template <bool MLA> __device__ __forceinline__ int kswz(int row, int colB) {
    if constexpr (MLA) return row * 256 + (colB ^ ((row & 15) << 4));
    else return row * 128 + (colB ^ (((row >> 1) & 7) << 4));
}
__device__ __forceinline__ float max3f(float a, float b, float c) { float r; asm("v_max3_f32 %0, %1, %2, %3" : "=v"(r) : "v"(a), "v"(b), "v"(c)); return r; }
template <bool FIRST> __device__ __forceinline__ void partialSM(f32x16& p0, f32x16& p1, float& m2, f32x16& negm, float& alpha) {
    constexpr float THR2 = THR * 1.4426950408889634f;
    float pmax = max3f(p0[0], p0[1], p0[2]);
#pragma unroll
    for (int r = 3; r < 15; r += 2) pmax = max3f(pmax, p0[r], p0[r + 1]);
    pmax = max3f(pmax, p0[15], p1[0]);
#pragma unroll
    for (int r = 1; r < 15; r += 2) pmax = max3f(pmax, p1[r], p1[r + 1]);
    pmax = fmaxf(pmax, p1[15]);
    { auto rr = __builtin_amdgcn_permlane32_swap(__float_as_uint(pmax), __float_as_uint(pmax), false, false);
      pmax = fmaxf(__uint_as_float(rr[0]), __uint_as_float(rr[1])); }
    if (!FIRST && __builtin_expect(__all(pmax <= THR2), 1)) { alpha = 1.f; }
    else {
        const float delta = FIRST ? pmax : fmaxf(pmax, 0.f);
        alpha = FIRST ? 1.f : __builtin_amdgcn_exp2f(-delta);
        m2 += delta;
#pragma unroll
        for (int r = 0; r < 16; ++r) { p0[r] -= delta; p1[r] -= delta; }
        const float nm = -m2;
#pragma unroll
        for (int r = 0; r < 16; ++r) negm[r] = nm;
    }
#pragma unroll
    for (int r = 0; r < 16; ++r) p0[r] = __builtin_amdgcn_exp2f(p0[r]);
}
__device__ __forceinline__ void finishSM(f32x16& p0, f32x16& p1, bf16x8& pa0, bf16x8& pa1, bf16x8& pa2, bf16x8& pa3) {
#pragma unroll
    for (int r = 0; r < 16; ++r) p1[r] = __builtin_amdgcn_exp2f(p1[r]);
#define PK4(P, BASE, OUT) do { unsigned a0 = cvtpk(P[BASE + 0], P[BASE + 1]), a1 = cvtpk(P[BASE + 2], P[BASE + 3]);   \
    unsigned b0 = cvtpk(P[BASE + 4], P[BASE + 5]), b1 = cvtpk(P[BASE + 6], P[BASE + 7]);                              \
    auto r0 = __builtin_amdgcn_permlane32_swap(a0, b0, false, false); auto r1 = __builtin_amdgcn_permlane32_swap(a1, b1, false, false); \
    u32x4 w = {r0[0], r1[0], r0[1], r1[1]}; OUT = *reinterpret_cast<bf16x8*>(&w); } while (0)
    PK4(p0, 0, pa0); PK4(p0, 8, pa1); PK4(p1, 0, pa2); PK4(p1, 8, pa3);
#undef PK4
}
template <bool MLA> __device__ __forceinline__ void qkt(f32x16& p0, f32x16& p1, const char* Ks, const bf16x8* qr, const f32x16& negm, int r32, int hi) {
    p0 = negm; p1 = negm;
#pragma unroll
    for (int d0 = 0; d0 < Cfg<MLA>::NQ; ++d0) { int cb = (d0 * 16 + hi * 8) * 2;
        bf16x8 b0 = *reinterpret_cast<const bf16x8*>(Ks + kswz<MLA>(r32, cb));
        bf16x8 b1 = *reinterpret_cast<const bf16x8*>(Ks + kswz<MLA>(32 + r32, cb));
        p0 = __builtin_amdgcn_mfma_f32_32x32x16_bf16(b0, qr[d0], p0, 0, 0, 0);
        p1 = __builtin_amdgcn_mfma_f32_32x32x16_bf16(b1, qr[d0], p1, 0, 0, 0); }
}
template <int NCB> __device__ __forceinline__ int v_st(int k, int c) { const int kk = (k & ~0xC) | ((k & 4) << 1) | ((k & 8) >> 1); return ((kk >> 3) * NCB + (c >> 5)) * 512 + ((kk & 7) * 32 + (c & 31)) * 2; }
__device__ __forceinline__ int v_rd_base(int lane) { return ((lane & 3) << 3) | (((lane >> 2) & 3) << 6) | (((lane >> 4) & 1) << 5) | (((lane >> 5) & 1) << 8); }
template <int NCB> constexpr int v_rd_off(int d0, int ks, int half) { return d0 * 512 + (ks * 2 + half) * NCB * 512; }
template <int OFF> __device__ __forceinline__ s16x4 tr_read(int vb) {
    s16x4 r; asm volatile("ds_read_b64_tr_b16 %0, %1 offset:%2" : "=&v"(r) : "v"(vb), "i"(OFF) : "memory"); return r;
}
template <int NCB, int D0> __device__ __forceinline__ void pv_one(f32x16& od, int vb, bf16x8 pa0, bf16x8 pa1, bf16x8 pa2, bf16x8 pa3) {
    const s16x4 l0 = tr_read<v_rd_off<NCB>(D0, 0, 0)>(vb), h0 = tr_read<v_rd_off<NCB>(D0, 0, 1)>(vb), l1 = tr_read<v_rd_off<NCB>(D0, 1, 0)>(vb), h1 = tr_read<v_rd_off<NCB>(D0, 1, 1)>(vb);
    const s16x4 l2 = tr_read<v_rd_off<NCB>(D0, 2, 0)>(vb), h2 = tr_read<v_rd_off<NCB>(D0, 2, 1)>(vb), l3 = tr_read<v_rd_off<NCB>(D0, 3, 0)>(vb), h3 = tr_read<v_rd_off<NCB>(D0, 3, 1)>(vb);
    asm volatile("s_waitcnt lgkmcnt(0)" ::: "memory"); SBAR();
#define PK(L, H) (bf16x8){L[0], L[1], L[2], L[3], H[0], H[1], H[2], H[3]}
    od = __builtin_amdgcn_mfma_f32_32x32x16_bf16(pa0, PK(l0, h0), od, 0, 0, 0);
    od = __builtin_amdgcn_mfma_f32_32x32x16_bf16(pa1, PK(l1, h1), od, 0, 0, 0);
    od = __builtin_amdgcn_mfma_f32_32x32x16_bf16(pa2, PK(l2, h2), od, 0, 0, 0);
    od = __builtin_amdgcn_mfma_f32_32x32x16_bf16(pa3, PK(l3, h3), od, 0, 0, 0);
#undef PK
}
template <int NCB> __device__ __forceinline__ void pv_all(f32x16* o, f32x16& ol, int vb, bf16x8 pa0, bf16x8 pa1, bf16x8 pa2, bf16x8 pa3) {
    { const short one = (short)0x3F80; const bf16x8 ones = {one, one, one, one, one, one, one, one};
      ol = __builtin_amdgcn_mfma_f32_32x32x16_bf16(pa0, ones, ol, 0, 0, 0); ol = __builtin_amdgcn_mfma_f32_32x32x16_bf16(pa1, ones, ol, 0, 0, 0);
      ol = __builtin_amdgcn_mfma_f32_32x32x16_bf16(pa2, ones, ol, 0, 0, 0); ol = __builtin_amdgcn_mfma_f32_32x32x16_bf16(pa3, ones, ol, 0, 0, 0); }
    pv_one<NCB, 0>(o[0], vb, pa0, pa1, pa2, pa3); pv_one<NCB, 1>(o[1], vb, pa0, pa1, pa2, pa3);
    if constexpr (NCB == 4) { pv_one<NCB, 2>(o[2], vb, pa0, pa1, pa2, pa3); pv_one<NCB, 3>(o[3], vb, pa0, pa1, pa2, pa3); }
}

template <bool MLA>
__device__ __forceinline__ void attn_core(const bf16_t* __restrict__ Qb, const bf16_t* __restrict__ Kh, const bf16_t* __restrict__ Vh, int seq, char* lds,
                                          f32x16 (&o)[Cfg<MLA>::NCB], const int wid  ) {
    using CF = Cfg<MLA>;
    constexpr int NQ = CF::NQ, NCB = CF::NCB, SHM_V = CF::SHM_V, SHM_K = CF::SHM_K, LDQ = CF::LDQ, LDK = CF::LDK, LDV = CF::LDV;
    const int lane = lane_id_v(), tid = wid * 64 + lane, r32 = lane & 31, hi = lane >> 5;
    char* V_lds = lds; char* K_lds = lds + 2 * SHM_V;
    float* wsp = (float*)(lds + 2 * SHM_V + 2 * SHM_K) + wid * 64; float* al_l = wsp + 32;
    float m2 = 0.f; f32x16 negm = f32x16{}, ol = f32x16{}; bf16x8 qr[NQ];
#pragma unroll
    for (int d = 0; d < NCB; ++d) o[d] = f32x16{};
    const bf16_t* Qw = Qb + (long)(wid * 32 + r32) * LDQ + hi * 8;
#pragma unroll
    for (int d0 = 0; d0 < NQ; ++d0) qr[d0] = *reinterpret_cast<const bf16x8*>(Qw + d0 * 16);
    const int vr0 = MLA ? (tid >> 3) : (tid >> 4), vc0 = MLA ? (tid & 7) * 8 : (tid & 15) * 8;
    const int vst0 = v_st<NCB>(vr0, vc0), vst1 = v_st<NCB>(32 + vr0, vc0);
    const int kcA = MLA ? tid : tid, krA = MLA ? (kcA / 12) : (tid >> 3), kcolA = MLA ? (kcA % 12) * 8 : (tid & 7) * 8;
    const int kcB = 512 + (tid & 255), krB = kcB / 12, kcolB = (kcB % 12) * 8;
    const int kstA = kswz<MLA>(krA, kcolA * 2), kstB = kswz<MLA>(krB, kcolB * 2);
    const int vb0 = (int)(uintptr_t)V_lds + v_rd_base(lane);
    struct { bf16x8 a, b, c; } sr_[2];
#define SLOAD(i, k0) do { if constexpr (MLA) { \
        sr_[i].a = *reinterpret_cast<const bf16x8*>(&Vh[(long)((k0) + vr0) * LDV + vc0]); \
        sr_[i].b = *reinterpret_cast<const bf16x8*>(&Kh[(long)((k0) + krA) * LDK + kcolA]); \
        sr_[i].c = *reinterpret_cast<const bf16x8*>(&Kh[(long)((k0) + krB) * LDK + kcolB]); \
    } else { \
        sr_[i].a = *reinterpret_cast<const bf16x8*>(&Vh[(long)((k0) + vr0) * LDV + vc0]); \
        sr_[i].b = *reinterpret_cast<const bf16x8*>(&Vh[(long)((k0) + 32 + vr0) * LDV + vc0]); \
        sr_[i].c = *reinterpret_cast<const bf16x8*>(&Kh[(long)((k0) + krA) * LDK + kcolA]); } } while (0)
#define SWRITE(bf, i) do { if constexpr (MLA) { \
        *(bf16x8*)(V_lds + (bf) * SHM_V + vst0) = sr_[i].a; \
        *(bf16x8*)(K_lds + (bf) * SHM_K + kstA) = sr_[i].b; \
        if (tid < 256) *(bf16x8*)(K_lds + (bf) * SHM_K + kstB) = sr_[i].c; \
    } else { \
        *(bf16x8*)(V_lds + (bf) * SHM_V + vst0) = sr_[i].a; \
        *(bf16x8*)(V_lds + (bf) * SHM_V + vst1) = sr_[i].b; \
        *(bf16x8*)(K_lds + (bf) * SHM_K + kstA) = sr_[i].c; } } while (0)
#define SWAIT() asm volatile("s_waitcnt vmcnt(3)" ::: "memory")
#define RESC(a) do { if (__any((a) < 1.f)) { if (hi == 0) al_l[r32] = (a); asm volatile("s_waitcnt lgkmcnt(0)" ::: "memory"); \
    _Pragma("unroll") for (int r = 0; r < 16; ++r) { const float al_ = al_l[crow(r, hi)]; ol[r] *= al_; _Pragma("unroll") for (int d = 0; d < NCB; ++d) o[d][r] *= al_; } } } while (0)
    f32x16 pA0, pA1, pB0, pB1; float alA, alB; bf16x8 pa0, pa1, pa2, pa3; const int NT = seq / 64;
    constexpr int SE = 0, SO = 1;
    SLOAD(SE, 0); asm volatile("s_waitcnt vmcnt(0)" ::: "memory"); SWRITE(0, SE); __syncthreads();
    qkt<MLA>(pA0, pA1, K_lds, qr, negm, r32, hi); partialSM<true>(pA0, pA1, m2, negm, alA);
    SLOAD(SO, 64); if (2 < NT) SLOAD(SE, 2 * 64);
    SWAIT(); SWRITE(1, SO); __syncthreads();
    for (int j = 1; j + 1 < NT; j += 2) {
        SBAR(); qkt<MLA>(pB0, pB1, K_lds + SHM_K, qr, negm, r32, hi);
        finishSM(pA0, pA1, pa0, pa1, pa2, pa3); SBAR();
        SLOAD(SO, (j + 2) * 64); SBAR();
        pv_all<NCB>(o, ol, vb0, pa0, pa1, pa2, pa3); partialSM<false>(pB0, pB1, m2, negm, alB);
        __syncthreads(); SWAIT(); SWRITE(0, SE);
        RESC(alB); __syncthreads();
        SBAR(); qkt<MLA>(pA0, pA1, K_lds, qr, negm, r32, hi);
        finishSM(pB0, pB1, pa0, pa1, pa2, pa3); SBAR();
        if (j + 3 < NT) SLOAD(SE, (j + 3) * 64); SBAR();
        pv_all<NCB>(o, ol, vb0 + SHM_V, pa0, pa1, pa2, pa3); partialSM<false>(pA0, pA1, m2, negm, alA);
        __syncthreads(); SWAIT(); SWRITE(1, SO);
        RESC(alA); __syncthreads();
    }
    SBAR(); qkt<MLA>(pB0, pB1, K_lds + SHM_K, qr, negm, r32, hi);
    finishSM(pA0, pA1, pa0, pa1, pa2, pa3); SBAR();
    pv_all<NCB>(o, ol, vb0, pa0, pa1, pa2, pa3); partialSM<false>(pB0, pB1, m2, negm, alB);
    __syncthreads(); RESC(alB);
    finishSM(pB0, pB1, pa0, pa1, pa2, pa3); SBAR();
    pv_all<NCB>(o, ol, vb0 + SHM_V, pa0, pa1, pa2, pa3);
#pragma unroll
    for (int r = 0; r < 16; ++r) { const float rl = __builtin_amdgcn_rcpf(ol[r]);
#pragma unroll
        for (int d = 0; d < NCB; ++d) o[d][r] *= rl; }
#undef SLOAD
#undef SWRITE
#undef SWAIT
#undef RESC
}
}
typedef float2 cs_t;
__device__ __forceinline__ void store8(bf16_t* p, f32x4 v0, f32x4 v1) {
    u32x4 w; w.x = cvtpk(v0[0], v0[1]); w.y = cvtpk(v0[2], v0[3]); w.z = cvtpk(v1[0], v1[1]); w.w = cvtpk(v1[2], v1[3]);
    *(u32x4*)p = w;
}
__device__ __forceinline__ float dot8(f32x4 v0, f32x4 v1) { return (v0[0] * v0[0] + v0[1] * v0[1]) + (v0[2] * v0[2] + v0[3] * v0[3]) + (v1[0] * v1[0] + v1[1] * v1[1]) + (v1[2] * v1[2] + v1[3] * v1[3]); }
__device__ __forceinline__ void rope64(f32x4& v0, f32x4& v1, const cs_t* __restrict__ CS16, int gr, int gc, int wc, int fq, bool apply) {
    f32x4 p0, p1; const int ix = (lane_id_v() ^ 32) << 2;
#pragma unroll
    for (int j = 0; j < 4; ++j) { p0[j] = shfli(v0[j], ix); p1[j] = shfli(v1[j], ix); }
    if (apply) {
        const int pos = (wc & 1) ? gc : gr; const cs_t* t = CS16 + pos * 16 + 8 * (fq & 1);
        const float sg = (fq < 2) ? -1.f : 1.f;
#pragma unroll
        for (int j = 0; j < 4; ++j) { const cs_t a = t[j], b = t[4 + j];
            v0[j] = v0[j] * a.x + sg * p0[j] * a.y; v1[j] = v1[j] * b.x + sg * p1[j] * b.y; }
    }
}
__device__ __forceinline__ void rope32(f32x4& v0, f32x4& v1, const cs_t* __restrict__ CS8, int gr, int gc, int g, bool apply) {
    f32x4 p0, p1; const int ix = (lane_id_v() ^ 16) << 2;
#pragma unroll
    for (int j = 0; j < 4; ++j) { p0[j] = shfli(v0[j], ix); p1[j] = shfli(v1[j], ix); }
    if (apply) {
        const int pos = (g >= 2) ? gc : gr; const cs_t* t = CS8 + pos * 8;
        const float sg = (g & 1) ? 1.f : -1.f;
#pragma unroll
        for (int j = 0; j < 4; ++j) { const cs_t a = t[j], b = t[4 + j];
            v0[j] = v0[j] * a.x + sg * p0[j] * a.y; v1[j] = v1[j] * b.x + sg * p1[j] * b.y; }
    }
}
#define EPI_ARGS const pg8::f32x4 (&acc)[2][2][4][2], const pg8::Unit& u, int wr, int wc, int fr, int fq
#define EPI_RECOMPUTE { const int l_ = lane_id_v(); fr = l_ & 15; fq = l_ >> 4; }

struct EpiP1 {
    static constexpr bool PERM = true, AFTER_DRAIN = false;
    bf16_t *CKV, *CQ, *KMLA, *GA, *DQ, *DK, *DV, *GD, *MG; float *SSKV, *SSQ; const cs_t *CS16, *CS8;
    __device__ __forceinline__ void operator()(EPI_ARGS) const {
        EPI_RECOMPUTE
        const int pm = u.pm, pn = u.pn; const bool lat = pm < 256;
        if (!lat && !(pn == 0 || pn == 2 || (pn >= 7 && pn <= 10))) return;
        const int row0 = pm * 256 + wr * 64 + fr;
        const int kv0 = (lat ? (pm >> 5) * SKV + CTX + (pm & 31) * 256 : (pm - 256) * SKV) + wr * 64 + fr;
        const int lcw = wc * 32 + 8 * fq;
#pragma unroll
        for (int ai = 0; ai < 2; ++ai)
#pragma unroll
            for (int m = 0; m < 4; ++m) {
                __builtin_amdgcn_sched_barrier(0); const int row = opq(row0 + ai * 128 + m * 16), kvrow = kv0 + (row - row0);
                const int s = row & (SEQ - 1), gr = s >> 6, gc = s & 63;
                float ssq = 0.f;
#pragma unroll
                for (int bj = 0; bj < 2; ++bj) {
                    f32x4 v0 = acc[ai][bj][m][0], v1 = acc[ai][bj][m][1]; const int lc = bj * 128 + lcw;
                    if (pn == 0) { ssq += dot8(v0, v1); store8(CKV + (size_t)kvrow * 256 + lc, v0, v1); }
                    else if (pn == 1) { ssq += dot8(v0, v1); store8(CQ + (size_t)row * 384 + lc, v0, v1); }
                    else if (pn == 2) {
                        if (bj == 0) { if (lat) { ssq += dot8(v0, v1); store8(CQ + (size_t)row * 384 + 256 + lc, v0, v1); } }
                        else if (wc == 0) { rope32(v0, v1, CS8, gr, gc, fq, lat);
#pragma unroll
                            for (int h = 0; h < 8; ++h) store8(KMLA + (size_t)kvrow * 768 + h * 96 + 64 + 8 * fq, v0, v1); }
                    }
                    else if (pn <= 4 || pn == 11 || pn == 12) {
#pragma unroll
                        for (int j = 0; j < 4; ++j) { v0[j] = v0[j] * sigmoidf_(v0[j]); v1[j] = v1[j] * sigmoidf_(v1[j]); }
                        bf16_t* dst = (pn <= 4) ? GA + (size_t)row * 512 + (pn - 3) * 256 + lc : GD + (size_t)row * 512 + (pn - 11) * 256 + lc;
                        store8(dst, v0, v1);
                    }
                    else if (pn <= 6) { v0 = v0 * 0.18033688011112042f; v1 = v1 * 0.18033688011112042f;
                        rope64(v0, v1, CS16, gr, gc, wc, fq, true); store8(DQ + (size_t)row * 512 + (pn - 5) * 256 + lc, v0, v1); }
                    else if (pn <= 8) { rope64(v0, v1, CS16, gr, gc, wc, fq, lat); store8(DK + (size_t)kvrow * 512 + (pn - 7) * 256 + lc, v0, v1); }
                    else if (pn <= 10) { store8(DV + (size_t)kvrow * 512 + (pn - 9) * 256 + lc, v0, v1); }
                    else {
#pragma unroll
                        for (int j = 0; j < 4; ++j) { v0[j] = sigmoidf_(v0[j]); v1[j] = sigmoidf_(v1[j]); }
                        store8(MG + (size_t)row * 2048 + (pn - 13) * 256 + lc, v0, v1);
                    }
                }
                if (pn <= 2) {
                    ssq += shflx(ssq, 16); ssq += shflx(ssq, 32);
                    if (fq == 0) { if (pn == 0) atomicAdd(SSKV + kvrow, ssq); else if (lat) atomicAdd(SSQ + row, ssq); }
                }
            }
    }
};
struct EpiQ {
    static constexpr bool PERM = true, AFTER_DRAIN = false;
    bf16_t* QMLA; const float* SSQ; const cs_t* CS8;
    __device__ __forceinline__ void operator()(EPI_ARGS) const {
        EPI_RECOMPUTE
        const int row0 = u.pm * 256 + wr * 64 + fr;
#pragma unroll
        for (int ai = 0; ai < 2; ++ai)
#pragma unroll
            for (int m = 0; m < 4; ++m) {
                __builtin_amdgcn_sched_barrier(0); const int row = opq(row0 + ai * 128 + m * 16); const int s = row & (SEQ - 1), gr = s >> 6, gc = s & 63;
                const float rs = 0.14724445f / sqrtf(SSQ[row] * (1.f / 384.f) + 1e-6f);
#pragma unroll
                for (int bj = 0; bj < 2; ++bj) {
                    f32x4 v0 = acc[ai][bj][m][0] * rs, v1 = acc[ai][bj][m][1] * rs;
                    const int c0 = u.pn * 256 + bj * 128 + wc * 32 + 8 * fq, d = c0 % 96;
                    rope32(v0, v1, CS8, gr, gc, (d - 64) >> 3, d >= 64);
                    store8(QMLA + (size_t)row * 768 + c0, v0, v1);
                }
            }
    }
};
struct EpiKV {
    static constexpr bool PERM = true, AFTER_DRAIN = false;
    bf16_t *KMLA, *VMLA; const float* SSKV;
    __device__ __forceinline__ void operator()(EPI_ARGS) const {
        EPI_RECOMPUTE
        const int row0 = u.pm * 256 + wr * 64 + fr;
#pragma unroll
        for (int ai = 0; ai < 2; ++ai)
#pragma unroll
            for (int m = 0; m < 4; ++m) {
                __builtin_amdgcn_sched_barrier(0); const int row = opq(row0 + ai * 128 + m * 16);
                const float rs = 1.f / sqrtf(SSKV[row] * (1.f / 256.f) + 1e-6f);
#pragma unroll
                for (int bj = 0; bj < 2; ++bj) {
                    const f32x4 v0 = acc[ai][bj][m][0] * rs, v1 = acc[ai][bj][m][1] * rs;
                    const int h = u.pn * 2 + bj, d = wc * 32 + 8 * fq;
                    if (wc < 2) store8(KMLA + (size_t)row * 768 + h * 96 + d, v0, v1);
                    else store8(VMLA + (size_t)row * 512 + h * 64 + (d - 64), v0, v1);
                }
            }
    }
};
template <bool ACCUM> struct EpiZ {
    static constexpr bool PERM = true, AFTER_DRAIN = false;
    bf16_t* Z; const bf16_t* MG;
    __device__ __forceinline__ void operator()(EPI_ARGS) const {
        EPI_RECOMPUTE
        const int row0 = u.pm * 256 + wr * 64 + fr;
#pragma unroll
        for (int ai = 0; ai < 2; ++ai)
#pragma unroll
            for (int m = 0; m < 4; ++m) {
                __builtin_amdgcn_sched_barrier(0); const int row = opq(row0 + ai * 128 + m * 16);
#pragma unroll
                for (int bj = 0; bj < 2; ++bj) {
                    f32x4 v0 = acc[ai][bj][m][0], v1 = acc[ai][bj][m][1];
                    const int c0 = u.pn * 256 + bj * 128 + wc * 32 + 8 * fq;
                    const u32x4 g = *(const u32x4*)(MG + (size_t)row * 2048 + c0);
                    v0[0] *= bflo(g.x); v0[1] *= bfhi(g.x); v0[2] *= bflo(g.y); v0[3] *= bfhi(g.y);
                    v1[0] *= bflo(g.z); v1[1] *= bfhi(g.z); v1[2] *= bflo(g.w); v1[3] *= bfhi(g.w);
                    bf16_t* zp = Z + (size_t)row * 1024 + c0;
                    if (ACCUM) { const u32x4 z = *(const u32x4*)zp;
                        v0[0] += bflo(z.x); v0[1] += bfhi(z.x); v0[2] += bflo(z.y); v0[3] += bfhi(z.y);
                        v1[0] += bflo(z.z); v1[1] += bfhi(z.z); v1[2] += bflo(z.w); v1[3] += bfhi(z.w); }
                    store8(zp, v0, v1);
                }
            }
    }
};
struct EpiOut {
    static constexpr bool PERM = true, AFTER_DRAIN = false;
    float* OUT; const float* X; const float* MOD;
    __device__ __forceinline__ void operator()(EPI_ARGS) const {
        EPI_RECOMPUTE
        const int row0 = u.pm * 256 + wr * 64 + fr; const float ALPHA = 1.189207115002721f;
        const float* gate = MOD + (size_t)(u.pm >> 5) * 3072 + 2048;
#pragma unroll
        for (int ai = 0; ai < 2; ++ai)
#pragma unroll
            for (int m = 0; m < 4; ++m) {
                __builtin_amdgcn_sched_barrier(0); const int row = opq(row0 + ai * 128 + m * 16);
#pragma unroll
                for (int bj = 0; bj < 2; ++bj) {
                    const int c0 = u.pn * 256 + bj * 128 + wc * 32 + 8 * fq;
                    const f32x4 x0 = *(const f32x4*)(X + (size_t)row * 1024 + c0), x1 = *(const f32x4*)(X + (size_t)row * 1024 + c0 + 4);
                    const f32x4 g0 = *(const f32x4*)(gate + c0), g1 = *(const f32x4*)(gate + c0 + 4);
                    *(f32x4*)(OUT + (size_t)row * 1024 + c0) = x0 * ALPHA + g0 * acc[ai][bj][m][0];
                    *(f32x4*)(OUT + (size_t)row * 1024 + c0 + 4) = x1 * ALPHA + g1 * acc[ai][bj][m][1];
                }
            }
    }
};
constexpr size_t MiB = 1u << 20;
constexpr size_t WS_SSKV = 0, WS_SSQ = 512 * 1024, CTL_ZERO_BYTES = 1 * MiB;
constexpr size_t WS_MOD = 1 * MiB, WS_CS16 = 1 * MiB + 128 * 1024, WS_CS8 = 1 * MiB + 192 * 1024;
constexpr size_t WS_WIN = 2 * MiB, WS_WUQ = 13 * MiB, WS_WUKV = 14 * MiB, WS_WOA = 15 * MiB, WS_WOB = 16 * MiB, WS_WOUT = 17 * MiB;
constexpr size_t WS_HBF = 32 * MiB;
constexpr size_t WS_VMLA = WS_HBF, WS_Z = WS_HBF;
constexpr size_t WS_KMLA = 164 * MiB;
constexpr size_t WS_GA = 263 * MiB;
constexpr size_t WS_DQ = 327 * MiB;
constexpr size_t WS_DK = 391 * MiB;
constexpr size_t WS_DV = 457 * MiB;
constexpr size_t WS_GD = 523 * MiB;
constexpr size_t WS_MG = 587 * MiB;
constexpr size_t WS_QMLA = 843 * MiB;
constexpr size_t WS_END = 939 * MiB;
constexpr size_t OUT_CKV = 0, OUT_CQ = 33 * MiB;
constexpr int LDS_BYTES = 131072;

struct Args {
    const float *x, *c, *ctx, *c_ctx, *w_mod, *b_mod, *w_in, *q_norm, *kv_norm, *w_uq, *w_ukv, *dlam, *subln, *w_oa, *w_ob, *w_out, *ln_g, *ln_b;
    float* out; unsigned char* ws;
};

__device__ __forceinline__ void tr_item(const float* __restrict__ W, int K, int N, int srcn0, const float* __restrict__ ksc, bf16_t* WT, int dstn0, int k0, float* scr, int lane) {
#pragma unroll 8
    for (int i = 0; i < 32; ++i) { const int kk = 2 * i + (lane >> 5);
        float v = 0.f; if (srcn0 >= 0) { v = W[(size_t)(k0 + kk) * N + srcn0 + (lane & 31)]; if (ksc) v *= ksc[k0 + kk]; }
        scr[kk * 33 + (lane & 31)] = v; }
    asm volatile("s_waitcnt lgkmcnt(0)" ::: "memory");
    const int c = lane & 7;
#pragma unroll
    for (int j = 0; j < 4; ++j) { const int n = (lane >> 3) + 8 * j; const float* s = scr + (8 * c) * 33 + n;
        u32x4 o; o.x = cvtpk(s[0 * 33], s[1 * 33]); o.y = cvtpk(s[2 * 33], s[3 * 33]); o.z = cvtpk(s[4 * 33], s[5 * 33]); o.w = cvtpk(s[6 * 33], s[7 * 33]);
        *(u32x4*)(WT + (size_t)(dstn0 + n) * K + k0 + 8 * c) = o; }
    asm volatile("s_waitcnt lgkmcnt(0)" ::: "memory");
}

__global__ void __launch_bounds__(512, 2) fwd_mega(Args a) {
    extern __shared__ __attribute__((aligned(16))) unsigned char lds[];
    cg::grid_group grid = cg::this_grid();
    const int wave = __builtin_amdgcn_readfirstlane((int)threadIdx.x >> 6);
#define LANE_TID const int lane = lane_id_v(), tid = wave * 64 + lane; (void)tid; (void)lane;
    const int G = gridDim.x, bid = blockIdx.x;
    const int gw = bid * 8 + wave, NGW = G * 8;
    unsigned char* ws = a.ws; unsigned char* ob = (unsigned char*)a.out;
    float* SSKV = (float*)(ws + WS_SSKV); float* SSQ = (float*)(ws + WS_SSQ); float* MOD = (float*)(ws + WS_MOD);
    cs_t* CS16 = (cs_t*)(ws + WS_CS16); cs_t* CS8 = (cs_t*)(ws + WS_CS8);
    bf16_t* WIN = (bf16_t*)(ws + WS_WIN); bf16_t* WUQ = (bf16_t*)(ws + WS_WUQ); bf16_t* WUKV = (bf16_t*)(ws + WS_WUKV);
    bf16_t* WOA = (bf16_t*)(ws + WS_WOA); bf16_t* WOB = (bf16_t*)(ws + WS_WOB); bf16_t* WOUT = (bf16_t*)(ws + WS_WOUT);
    bf16_t* HBF = (bf16_t*)(ws + WS_HBF); bf16_t* VMLA = (bf16_t*)(ws + WS_VMLA); bf16_t* Z = (bf16_t*)(ws + WS_Z);
    bf16_t* KMLA = (bf16_t*)(ws + WS_KMLA); bf16_t* GA = (bf16_t*)(ws + WS_GA); bf16_t* DQ = (bf16_t*)(ws + WS_DQ); bf16_t* DK = (bf16_t*)(ws + WS_DK);
    bf16_t* DV = (bf16_t*)(ws + WS_DV); bf16_t* GD = (bf16_t*)(ws + WS_GD); bf16_t* MG = (bf16_t*)(ws + WS_MG); bf16_t* QMLA = (bf16_t*)(ws + WS_QMLA);
    bf16_t* CKV = (bf16_t*)(ob + OUT_CKV); bf16_t* CQ = (bf16_t*)(ob + OUT_CQ);
    PG8_LAS unsigned char* ldsp = (PG8_LAS unsigned char*)lds;

#ifndef PHMASK
#define PHMASK 0xfff
#endif
    if (PHMASK & (1 << 0)) {
        LANE_TID
        float* A = (float*)lds; float* red = (float*)(lds + 36864);
        for (int cb = bid; cb < 96; cb += G) {
            __syncthreads();
            for (int i = tid; i < 9 * 1024; i += 512) { const int r = i >> 10, k = i & 1023; const float v = r < 8 ? a.c[r * 1024 + k] : a.c_ctx[k]; A[i] = v * sigmoidf_(v); }
            __syncthreads();
            const int cl = tid & 31, col = cb * 32 + cl, kq = tid >> 5;
            float acc[9];
#pragma unroll
            for (int r = 0; r < 9; ++r) acc[r] = 0.f;
#pragma unroll 4
            for (int kk = 0; kk < 64; ++kk) { const int k = kq * 64 + kk; const float w = a.w_mod[(size_t)k * 3072 + col];
#pragma unroll
                for (int r = 0; r < 9; ++r) acc[r] += A[r * 1024 + k] * w; }
#pragma unroll
            for (int r = 0; r < 9; ++r) red[(kq * 9 + r) * 32 + cl] = acc[r];
            __syncthreads();
            if (tid < 288) { const int r = tid >> 5; float s = 0.f;
                for (int q = 0; q < 16; ++q) s += red[(q * 9 + r) * 32 + cl];
                MOD[r * 3072 + col] = s + a.b_mod[col]; }
        }
        __syncthreads();
        float* scr = (float*)lds + wave * (64 * 33);
        constexpr int I_IN = 16 * 168, I_UQ = 6 * 24, I_UKV = 4 * 32, I_OA = 8 * 32, I_OB = 8 * 32, I_OUT = 16 * 32;
        constexpr int NITEMS = I_IN + I_UQ + I_UKV + I_OA + I_OB + I_OUT;
        for (int it = gw; it < NITEMS; it += NGW) {
            int r = it;
            if (r < I_IN) { const int kb = r / 168, nb = r % 168, d0 = nb * 32;
                const int s0 = d0 < 256 ? 384 + d0 : d0 < 640 ? d0 - 256 : d0 < 672 ? d0 : d0 < 768 ? -1 : d0 - 96;
                tr_item(a.w_in, 1024, 5280, s0, nullptr, WIN, d0, kb * 64, scr, lane); continue; } r -= I_IN;
            if (r < I_UQ) { tr_item(a.w_uq, 384, 768, (r % 24) * 32, a.q_norm, WUQ, (r % 24) * 32, (r / 24) * 64, scr, lane); continue; } r -= I_UQ;
            if (r < I_UKV) { tr_item(a.w_ukv, 256, 1024, (r % 32) * 32, a.kv_norm, WUKV, (r % 32) * 32, (r / 32) * 64, scr, lane); continue; } r -= I_UKV;
            if (r < I_OA) { tr_item(a.w_oa, 512, 1024, (r % 32) * 32, nullptr, WOA, (r % 32) * 32, (r / 32) * 64, scr, lane); continue; } r -= I_OA;
            if (r < I_OB) { tr_item(a.w_ob, 512, 1024, (r % 32) * 32, nullptr, WOB, (r % 32) * 32, (r / 32) * 64, scr, lane); continue; } r -= I_OB;
            tr_item(a.w_out, 1024, 1024, (r % 32) * 32, nullptr, WOUT, (r % 32) * 32, (r / 32) * 64, scr, lane);
        }
        if (bid == G - 1) {
            for (int i = tid; i < 128 * 16; i += 512) { const int pos = i >> 4, f = i & 15; const float inv = powf(10000.f, -(float)f / 16.f), ang = (float)pos * inv; CS16[i] = make_float2(cosf(ang), sinf(ang)); }
            for (int i = tid; i < 128 * 8; i += 512) { const int pos = i >> 3, f = i & 7; const float inv = powf(10000.f, -(float)f / 8.f), ang = (float)pos * inv; CS8[i] = make_float2(cosf(ang), sinf(ang)); }
        }
    }
    grid.sync();

    if (PHMASK & (1 << 1)) for (int m = gw; m < MALL; m += NGW) {
        LANE_TID
        const float* src; const float* mod;
        if (m < MLAT) { src = a.x + (size_t)m * 1024; mod = MOD + (size_t)(m >> 13) * 3072; } else { src = a.ctx + (size_t)(m - MLAT) * 1024; mod = MOD + 8 * 3072; }
#pragma unroll
        for (int j = 0; j < 4; ++j) { const int c4 = lane + 64 * j;
            const f32x4 v = ((const f32x4*)src)[c4], sh = ((const f32x4*)mod)[c4], sc = ((const f32x4*)(mod + 1024))[c4];
            const f32x4 h = v * (sc + 1.f) + sh; u32x2 w; w.x = cvtpk(h[0], h[1]); w.y = cvtpk(h[2], h[3]);
            *(u32x2*)(HBF + (size_t)m * 1024 + c4 * 4) = w; }
    }
    grid.sync();

    if (PHMASK & (1 << 2)) {
        pg8::Gemm g{HBF, WIN, MALL, NINP, 1024}; pg8::StaticOrder S; S.init(MALL, NINP, G, bid);
        EpiP1 E{CKV, CQ, KMLA, GA, DQ, DK, DV, GD, MG, SSKV, SSQ, CS16, CS8};
        pg8::gemm_phase<EpiP1, pg8::StaticOrder, true, true>(ldsp, g, S, E, wave);
    }
    grid.sync();

    if (PHMASK & (1 << 3)) {
        pg8::Gemm g{CQ, WUQ, MLAT, 768, 384}; pg8::StaticOrder S; S.init(MLAT, 768, G, bid);
        EpiQ E{QMLA, SSQ, CS8};
        pg8::gemm_phase<EpiQ, pg8::StaticOrder, true, true>(ldsp, g, S, E, wave);
    }
    if (PHMASK & (1 << 4)) {
        pg8::Gemm g{CKV, WUKV, MALL, 1024, 256}; pg8::StaticOrder S; S.init(MALL, 1024, G, bid);
        EpiKV E{KMLA, VMLA, SSKV};
        pg8::gemm_phase<EpiKV, pg8::StaticOrder, true, true>(ldsp, g, S, E, wave);
    }
    grid.sync();

    if (PHMASK & (3 << 5)) {
        float lam;
        { LANE_TID
        { const float s1 = wave_sum(a.dlam[lane] * a.dlam[64 + lane]), s2 = wave_sum(a.dlam[128 + lane] * a.dlam[192 + lane]); lam = __builtin_bit_cast(float, __builtin_amdgcn_readfirstlane(__builtin_bit_cast(int, __expf(s1) - __expf(s2) + 0.2f))); } }
        const bool xcd_order = (G == 256);
        const int nrounds = xcd_order ? 12 : (NB * 12 * 32 + G - 1) / G;
        for (int rd = 0; rd < nrounds; ++rd) {
            int b, hs, qb;
            if (xcd_order) { b = bid & 7; qb = bid >> 3; hs = rd; }
            else { const int idx = rd * G + bid; if (idx >= NB * 12 * 32) break; b = idx / (12 * 32); hs = (idx / 32) % 12; qb = idx % 32; }
            const size_t qrow0 = (size_t)b * SEQ + qb * 256, krow0 = (size_t)b * SKV;
            __syncthreads();
            LANE_TID
            const int r32 = lane & 31, hi = lane >> 5;
            if (hs < 8) { if (PHMASK & (1 << 5)) {
                f32x16 o[2];
                att::attn_core<true>(QMLA + qrow0 * 768 + hs * 96, KMLA + krow0 * 768 + hs * 96, VMLA + krow0 * 512 + hs * 64, SKV, (char*)lds, o, wave);
                char* T = (char*)lds + 51200 + wave * 8192; char* tw = T + hi * 512 + r32 * 2;
#pragma unroll
                for (int r = 0; r < 16; ++r)
#pragma unroll
                    for (int d0 = 0; d0 < 2; ++d0) *(bf16_t*)(tw + ((r & 3) + 8 * (r >> 2)) * 128 + d0 * 64) = (bf16_t)cvtpk(o[d0][r], o[d0][r]);
#pragma unroll
                for (int j = 0; j < 4; ++j) { const int id = j * 64 + lane, row = id >> 3, c8 = id & 7;
                    const u32x4 t = *(const u32x4*)(T + id * 16);
                    bf16_t* gp = GA + (qrow0 + wave * 32 + row) * 512 + hs * 64 + c8 * 8; const u32x4 g = *(const u32x4*)gp;
                    u32x4 w; w.x = cvtpk(bflo(t.x) * bflo(g.x), bfhi(t.x) * bfhi(g.x)); w.y = cvtpk(bflo(t.y) * bflo(g.y), bfhi(t.y) * bfhi(g.y));
                    w.z = cvtpk(bflo(t.z) * bflo(g.z), bfhi(t.z) * bfhi(g.z)); w.w = cvtpk(bflo(t.w) * bflo(g.w), bfhi(t.w) * bfhi(g.w));
                    *(u32x4*)gp = w; }
            } } else if (PHMASK & (1 << 6)) {
                const int h = hs - 8;
                unsigned* stash = (unsigned*)(lds + 51200 + wave * 8192) + lane;
                f32x16 o[4];
                att::attn_core<false>(DQ + qrow0 * 512 + h * 128, DK + krow0 * 512 + h * 128, DV + krow0 * 512 + h * 128, SKV, (char*)lds, o, wave);
#pragma unroll
                for (int d0 = 0; d0 < 4; ++d0)
#pragma unroll
                    for (int r = 0; r < 16; r += 2) stash[(d0 * 8 + (r >> 1)) * 64] = cvtpk(o[d0][r], o[d0][r + 1]);
                att::attn_core<false>(DQ + qrow0 * 512 + h * 128 + 64, DK + krow0 * 512 + h * 128 + 64, DV + krow0 * 512 + h * 128, SKV, (char*)lds, o, wave);
#pragma unroll
                for (int d0 = 0; d0 < 4; ++d0)
#pragma unroll
                    for (int r = 0; r < 16; r += 2) { const unsigned w = stash[(d0 * 8 + (r >> 1)) * 64];
                        o[d0][r] = bflo(w) - lam * o[d0][r]; o[d0][r + 1] = bfhi(w) - lam * o[d0][r + 1]; }
                asm volatile("s_waitcnt lgkmcnt(0)" ::: "memory"); SBAR();
                char* T = (char*)lds + 51200 + wave * 8192; char* tw = T + hi * 1024 + r32 * 2;
#pragma unroll
                for (int r = 0; r < 16; ++r)
#pragma unroll
                    for (int d0 = 0; d0 < 4; ++d0) *(bf16_t*)(tw + ((r & 3) + 8 * (r >> 2)) * 256 + d0 * 64) = (bf16_t)cvtpk(o[d0][r], o[d0][r]);
                const int c16 = lane & 15;
                const f32x4 sw0 = *(const f32x4*)(a.subln + c16 * 8), sw1 = *(const f32x4*)(a.subln + c16 * 8 + 4);
#pragma unroll
                for (int j = 0; j < 8; ++j) { const int id = j * 64 + lane, row = id >> 4;
                    const u32x4 t = *(const u32x4*)(T + id * 16);
                    float e[8] = {bflo(t.x), bfhi(t.x), bflo(t.y), bfhi(t.y), bflo(t.z), bfhi(t.z), bflo(t.w), bfhi(t.w)};
                    float ss = 0.f;
#pragma unroll
                    for (int k = 0; k < 8; ++k) ss += e[k] * e[k];
                    ss += shflx(ss, 1); ss += shflx(ss, 2); ss += shflx(ss, 4); ss += shflx(ss, 8);
                    const float rs = 0.8f / sqrtf(ss * (1.f / 128.f) + 1e-5f);
                    bf16_t* gp = GD + (qrow0 + wave * 32 + row) * 512 + h * 128 + c16 * 8; const u32x4 g = *(const u32x4*)gp;
                    u32x4 w; w.x = cvtpk(e[0] * rs * sw0[0] * bflo(g.x), e[1] * rs * sw0[1] * bfhi(g.x)); w.y = cvtpk(e[2] * rs * sw0[2] * bflo(g.y), e[3] * rs * sw0[3] * bfhi(g.y));
                    w.z = cvtpk(e[4] * rs * sw1[0] * bflo(g.z), e[5] * rs * sw1[1] * bfhi(g.z)); w.w = cvtpk(e[6] * rs * sw1[2] * bflo(g.w), e[7] * rs * sw1[3] * bfhi(g.w));
                    *(u32x4*)gp = w; }
            }
        }
    }
    grid.sync();

    if (PHMASK & (1 << 7)) {
        pg8::Gemm g{GA, WOA, MLAT, 1024, 512}; pg8::StaticOrder S; S.init(MLAT, 1024, G, bid);
        EpiZ<false> E{Z, MG};
        pg8::gemm_phase<EpiZ<false>, pg8::StaticOrder, true, true>(ldsp, g, S, E, wave);
    }
    if (PHMASK & (1 << 8)) {
        pg8::Gemm g{GD, WOB, MLAT, 1024, 512}; pg8::StaticOrder S; S.init(MLAT, 1024, G, bid);
        EpiZ<true> E{Z, MG + 1024};
        pg8::gemm_phase<EpiZ<true>, pg8::StaticOrder, true, true>(ldsp, g, S, E, wave);
    }
    grid.sync();

    if (PHMASK & (1 << 9)) {
        pg8::Gemm g{Z, WOUT, MLAT, 1024, 1024}; pg8::StaticOrder S; S.init(MLAT, 1024, G, bid);
        EpiOut E{a.out, a.x, MOD};
        pg8::gemm_phase<EpiOut, pg8::StaticOrder, true, true>(ldsp, g, S, E, wave);
    }
    grid.sync();

    if (PHMASK & (1 << 10)) for (int m = gw; m < MLAT; m += NGW) {
        LANE_TID
        f32x4* rowp = (f32x4*)(a.out + (size_t)m * 1024) + lane;
        f32x4 v[4]; float s = 0.f;
#pragma unroll
        for (int j = 0; j < 4; ++j) { v[j] = rowp[64 * j]; s += (v[j][0] + v[j][1]) + (v[j][2] + v[j][3]); }
        const float mean = wave_sum(s) * (1.f / 1024.f); float s2 = 0.f;
#pragma unroll
        for (int j = 0; j < 4; ++j) { v[j] = v[j] - mean; s2 += (v[j][0] * v[j][0] + v[j][1] * v[j][1]) + (v[j][2] * v[j][2] + v[j][3] * v[j][3]); }
        const float rstd = 1.f / sqrtf(wave_sum(s2) * (1.f / 1024.f) + 1e-5f);
#pragma unroll
        for (int j = 0; j < 4; ++j) { const f32x4 g = ((const f32x4*)a.ln_g)[lane + 64 * j], bb = ((const f32x4*)a.ln_b)[lane + 64 * j]; rowp[64 * j] = v[j] * rstd * g + bb; }
    }
}

extern "C" void kernel_launch(void* const* d_in, const int* in_sizes, int n_in, void* d_out, int out_size, void* d_ws, size_t ws_size, hipStream_t stream) {
    static int grid = 0;
    if (grid == 0) {
        if (n_in != 18 || in_sizes[0] != MLAT * DM || out_size != MLAT * DM || ws_size < WS_END) {
            fprintf(stderr, "kernel_launch: shape/workspace mismatch: n_in %d in0 %d out %d ws %zu (need %zu)\n", n_in, n_in > 0 ? in_sizes[0] : -1, out_size, ws_size, (size_t)WS_END); grid = -1; return; }
        int dev = 0, cus = 0, per_cu = 0;
        hipGetDevice(&dev); hipDeviceGetAttribute(&cus, hipDeviceAttributeMultiprocessorCount, dev);
        if (hipFuncSetAttribute((const void*)fwd_mega, hipFuncAttributeMaxDynamicSharedMemorySize, LDS_BYTES) != hipSuccess) { fprintf(stderr, "kernel_launch: hipFuncSetAttribute failed\n"); grid = -1; return; }
        if (hipOccupancyMaxActiveBlocksPerMultiprocessor(&per_cu, (const void*)fwd_mega, 512, LDS_BYTES) != hipSuccess || per_cu < 1) { fprintf(stderr, "kernel_launch: occupancy query gave %d\n", per_cu); per_cu = 1; }
        (void)hipGetLastError();
        grid = cus * 1;
    }
    if (grid < 0) return;
    hipMemsetAsync((char*)d_ws, 0, CTL_ZERO_BYTES, stream);
    Args a{};
    a.x = (const float*)d_in[0]; a.c = (const float*)d_in[1]; a.ctx = (const float*)d_in[2]; a.c_ctx = (const float*)d_in[3]; a.w_mod = (const float*)d_in[4]; a.b_mod = (const float*)d_in[5];
    a.w_in = (const float*)d_in[6]; a.q_norm = (const float*)d_in[7]; a.kv_norm = (const float*)d_in[8]; a.w_uq = (const float*)d_in[9]; a.w_ukv = (const float*)d_in[10];
    a.dlam = (const float*)d_in[11]; a.subln = (const float*)d_in[12]; a.w_oa = (const float*)d_in[13]; a.w_ob = (const float*)d_in[14]; a.w_out = (const float*)d_in[15];
    a.ln_g = (const float*)d_in[16]; a.ln_b = (const float*)d_in[17]; a.out = (float*)d_out; a.ws = (unsigned char*)d_ws;
    void* args[] = {&a};
    hipError_t e = hipLaunchCooperativeKernel((const void*)fwd_mega, dim3(grid), dim3(512), args, LDS_BYTES, stream);
    if (e != hipSuccess) fprintf(stderr, "kernel_launch: cooperative launch failed: %s (grid %d)\n", hipGetErrorString(e), grid);
}
```

```cpp
#include <hip/hip_runtime.h>
#include <hip/hip_cooperative_groups.h>
#include <cstdio>
#include <cstdint>
namespace cg = cooperative_groups;
__device__ __forceinline__ int opq(int v) { asm volatile("" : "+v"(v)); return v; }
__device__ __forceinline__ int lane_id_v() { int l; asm volatile("v_mbcnt_lo_u32_b32 %0, -1, 0\n\tv_mbcnt_hi_u32_b32 %0, -1, %0" : "=v"(l)); return l; }
__device__ __forceinline__ float shflx(float v, int mask) { return __builtin_bit_cast(float, __builtin_amdgcn_ds_bpermute((lane_id_v() ^ mask) << 2, __builtin_bit_cast(int, v))); }
__device__ __forceinline__ float shfli(float v, int idx4) { return __builtin_bit_cast(float, __builtin_amdgcn_ds_bpermute(idx4, __builtin_bit_cast(int, v))); }
namespace pg8 {
#define PG8_LAS __attribute__((address_space(3)))
typedef unsigned short bf16_t;
typedef short bf16x8 __attribute__((ext_vector_type(8)));
typedef float f32x4 __attribute__((ext_vector_type(4)));
typedef unsigned u32x4 __attribute__((ext_vector_type(4)));
constexpr int BM = 256, BK = 64, HALF = 128, HTB = HALF * BK * 2  , STAGE_BYTES = 8 * HTB, NXCD = 8, WGM = 8;

__host__ __device__ __forceinline__ int lds_byte(int r, int c) { const int st = (r >> 4) * 2 + (c >> 5), rr = r & 15, cc = c & 31, ob = rr * 64 + cc * 2; return st * 1024 + (ob ^ (((ob >> 9) & 1) << 5)); }
__host__ __device__ __forceinline__ void stage_rc(int b, int& R, int& C) { const int st = b / 1024, sb = b % 1024, swz = sb ^ (((sb >> 9) & 1) << 5); R = (st >> 1) * 16 + swz / 64; C = (st & 1) * 32 + (swz % 64) / 2; }
__host__ __device__ __forceinline__ int perm32(int rho) { const int n = rho >> 4, i = rho & 15; return 8 * (i >> 2) + 4 * n + (i & 3); }

struct Unit { int pm, pn; };
struct Gemm { const bf16_t* A; const bf16_t* Bt; int M, N, K; };

struct StaticOrder {
    int nM, nN, nwg, G, c;
    __host__ __device__ void init(int M, int N, int G_, int c_) { nM = M / BM; nN = N / BM; nwg = nM * nN; G = G_; c = c_; }
    __host__ __device__ bool next(int i, Unit& u) const {
        const long L = (long)i * G + c; if (L >= nwg) return false;
        int wgid = (int)L; { const int q = nwg / NXCD, r = nwg % NXCD, xcd = wgid % NXCD, off = wgid / NXCD; wgid = (xcd < r ? xcd * (q + 1) : r * (q + 1) + (xcd - r) * q) + off; }
        const int nig = WGM * nN, gid = wgid / nig, fm = gid * WGM, gsz = (nM - fm) < WGM ? (nM - fm) : WGM;
        u.pm = fm + ((wgid % nig) % gsz); u.pn = (wgid % nig) / gsz; return true;
    }
    __device__ __forceinline__ void a_ready(const Unit&) const {}
    __device__ __forceinline__ void done(const Unit&) const {}
};

template <class Epi, class Sched, bool ALIGN_EPI = false, bool SP2 = false>
__device__ __forceinline__ void gemm_phase(PG8_LAS unsigned char* lds, const Gemm g, const Sched& S, const Epi& E, const int wid  ) {
    const int lane = lane_id_v(), tid = wid * 64 + lane, wr = wid >> 2, wc = wid & 3, fr = lane & 15, fq = lane >> 4;
    const int K = g.K, nt = K / BK;
    unsigned voffA[2], voffB[2];
#pragma unroll
    for (int i = 0; i < 2; ++i) { int R, C; stage_rc(tid * 16 + i * 8192, R, C); const int Rb = Epi::PERM ? ((R & ~31) + perm32(R & 31)) : R;
        voffA[i] = (unsigned)(R * K + C) * 2u; voffB[i] = (unsigned)(Rb * K + C) * 2u; }
    const size_t kstep = (size_t)(BK * 2);
    const size_t hstep = (size_t)HALF * K * 2;
    const size_t tstep = 2 * hstep;
    const unsigned ldsw = (unsigned)wid * 1024u;
    const int aoff = lds_byte(wr * 64 + fr, fq * 8), boff = lds_byte(wc * 32 + fr, fq * 8);
#define PG8_SA(b, h) (((b) * 2 + (h)) * HTB)
#define PG8_SB(b, h) ((4 + (b) * 2 + (h)) * HTB)
#define PG8_STAGE(bufoff, gbase, voff) do { _Pragma("unroll") for (int _i = 0; _i < 2; ++_i) \
        __builtin_amdgcn_global_load_lds((const unsigned*)((const char*)(gbase) + (voff)[_i]), (PG8_LAS unsigned*)(lds + (bufoff) + ldsw + _i * 8192), 16, 0, 0); } while (0)
#define PG8_LDA(dst, b, h) do { _Pragma("unroll") for (int m = 0; m < 4; ++m) _Pragma("unroll") for (int k = 0; k < 2; ++k) dst[m][k] = *(const PG8_LAS bf16x8*)(lds + PG8_SA(b, h) + aoff + m * 2048 + k * 1024); } while (0)
#define PG8_LDB(dst, b, h) do { _Pragma("unroll") for (int n = 0; n < 2; ++n) _Pragma("unroll") for (int k = 0; k < 2; ++k) dst[n][k] = *(const PG8_LAS bf16x8*)(lds + PG8_SB(b, h) + boff + n * 2048 + k * 1024); } while (0)
#define PG8_MMA(ai, bj, At, Bt) do { __builtin_amdgcn_s_setprio(1); _Pragma("unroll") for (int m = 0; m < 4; ++m) _Pragma("unroll") for (int n = 0; n < 2; ++n) _Pragma("unroll") for (int k = 0; k < 2; ++k) \
        acc[ai][bj][m][n] = __builtin_amdgcn_mfma_f32_16x16x32_bf16(Bt[n][k], At[m][k], acc[ai][bj][m][n], 0, 0, 0); __builtin_amdgcn_s_setprio(0); } while (0)
#define PG8_WAIT_V(n) asm volatile("s_waitcnt vmcnt(" #n ")" ::: "memory")
#define PG8_WAIT_L(n) asm volatile("s_waitcnt lgkmcnt(" #n ")" ::: "memory")
#define PG8_BAR __builtin_amdgcn_s_barrier()
#define PG8_SCHED __builtin_amdgcn_sched_barrier(0)
    Unit cur, nxt; int ui = 0;
    if (!S.next(0, cur)) return;
    f32x4 acc[2][2][4][2];
#pragma unroll
    for (int a = 0; a < 2; ++a)
#pragma unroll
        for (int b = 0; b < 2; ++b)
#pragma unroll
            for (int m = 0; m < 4; ++m)
#pragma unroll
                for (int n = 0; n < 2; ++n) acc[a][b][m][n] = (f32x4){0.f, 0.f, 0.f, 0.f};
    bf16x8 At[4][2], B0[2][2], B1[2][2];
    const char* cA = (const char*)g.A + (size_t)cur.pm * tstep; const char* cB = (const char*)g.Bt + (size_t)cur.pn * tstep;
    S.a_ready(cur);
    if constexpr (SP2) {
        PG8_STAGE(PG8_SB(0, 0), cB, voffB); PG8_STAGE(PG8_SB(0, 1), cB + hstep, voffB); PG8_STAGE(PG8_SA(0, 0), cA, voffA); PG8_STAGE(PG8_SA(0, 1), cA + hstep, voffA);
        if (wr == 1) PG8_BAR;
        PG8_WAIT_V(2); PG8_BAR;
        PG8_STAGE(PG8_SB(1, 0), cB + kstep, voffB); PG8_STAGE(PG8_SA(1, 0), cA + kstep, voffA); PG8_STAGE(PG8_SB(1, 1), cB + hstep + kstep, voffB);
        PG8_WAIT_V(6); PG8_BAR;
    } else {
        PG8_STAGE(PG8_SB(0, 0), cB, voffB); PG8_STAGE(PG8_SA(0, 0), cA, voffA); PG8_STAGE(PG8_SB(0, 1), cB + hstep, voffB); PG8_STAGE(PG8_SA(0, 1), cA + hstep, voffA);
        if (wr == 1) PG8_BAR;
        PG8_WAIT_V(4); PG8_BAR;
        PG8_STAGE(PG8_SB(1, 0), cB + kstep, voffB); PG8_STAGE(PG8_SA(1, 0), cA + kstep, voffA); PG8_STAGE(PG8_SB(1, 1), cB + hstep + kstep, voffB);
        PG8_WAIT_V(6); PG8_BAR;
    }
    for (;;) {
        const bool has_next = S.next(ui + 1, nxt);
        const char* nA = has_next ? (const char*)g.A + (size_t)nxt.pm * tstep : cA; const char* nB = has_next ? (const char*)g.Bt + (size_t)nxt.pn * tstep : cB;
        for (int t = 0; t < nt; t += 2) {
            const bool last = (t == nt - 2);
            const char* a1 = cA + (size_t)(t + 1) * kstep;
            const char* a2 = last ? nA : cA + (size_t)(t + 2) * kstep; const char* b2 = last ? nB : cB + (size_t)(t + 2) * kstep;
            const char* a3 = a2 + kstep; const char* b3 = b2 + kstep;
            if (last && has_next) S.a_ready(nxt);
            if constexpr (SP2) {
            PG8_LDB(B0, 0, 0); PG8_LDB(B1, 0, 1); PG8_SCHED; PG8_LDA(At, 0, 0); PG8_STAGE(PG8_SA(1, 1), a1 + hstep, voffA);
            PG8_WAIT_V(8); PG8_WAIT_L(0); PG8_BAR; PG8_MMA(0, 0, At, B0); PG8_MMA(0, 1, At, B1); PG8_BAR; PG8_SCHED;
            PG8_LDA(At, 0, 1); PG8_STAGE(PG8_SB(0, 0), b2, voffB); PG8_STAGE(PG8_SB(0, 1), b2 + hstep, voffB); PG8_STAGE(PG8_SA(0, 0), a2, voffA);
            PG8_WAIT_V(8); PG8_WAIT_L(0); PG8_BAR; PG8_MMA(1, 0, At, B0); PG8_MMA(1, 1, At, B1); PG8_BAR; PG8_SCHED;
            PG8_LDB(B0, 1, 0); PG8_LDB(B1, 1, 1); PG8_SCHED; PG8_LDA(At, 1, 0); PG8_STAGE(PG8_SA(0, 1), a2 + hstep, voffA);
            PG8_WAIT_V(8); PG8_WAIT_L(0); PG8_BAR; PG8_MMA(0, 0, At, B0); PG8_MMA(0, 1, At, B1); PG8_BAR; PG8_SCHED;
            PG8_LDA(At, 1, 1); PG8_STAGE(PG8_SB(1, 0), b3, voffB); PG8_STAGE(PG8_SB(1, 1), b3 + hstep, voffB); PG8_STAGE(PG8_SA(1, 0), a3, voffA);
            PG8_WAIT_V(8); PG8_WAIT_L(0); PG8_BAR; PG8_MMA(1, 0, At, B0); PG8_MMA(1, 1, At, B1); PG8_BAR; PG8_SCHED;
            } else {
            PG8_LDB(B0, 0, 0); PG8_SCHED; PG8_LDA(At, 0, 0); PG8_STAGE(PG8_SA(1, 1), a1 + hstep, voffA);
            PG8_WAIT_L(8); PG8_BAR; PG8_WAIT_L(0); PG8_MMA(0, 0, At, B0); PG8_BAR; PG8_SCHED;
            PG8_LDB(B1, 0, 1); PG8_STAGE(PG8_SB(0, 0), b2, voffB);
            PG8_BAR; PG8_WAIT_L(0); PG8_MMA(0, 1, At, B1); PG8_BAR;
            PG8_LDA(At, 0, 1); PG8_STAGE(PG8_SA(0, 0), a2, voffA);
            PG8_BAR; PG8_WAIT_L(0); PG8_MMA(1, 0, At, B0); PG8_BAR; PG8_SCHED;
            PG8_STAGE(PG8_SB(0, 1), b2 + hstep, voffB);
            PG8_WAIT_V(6); PG8_BAR; PG8_MMA(1, 1, At, B1); PG8_BAR;
            PG8_LDB(B0, 1, 0); PG8_SCHED; PG8_LDA(At, 1, 0); PG8_STAGE(PG8_SA(0, 1), a2 + hstep, voffA);
            PG8_WAIT_L(8); PG8_BAR; PG8_WAIT_L(0); PG8_MMA(0, 0, At, B0); PG8_BAR; PG8_SCHED;
            PG8_LDB(B1, 1, 1); PG8_STAGE(PG8_SB(1, 0), b3, voffB);
            PG8_BAR; PG8_WAIT_L(0); PG8_MMA(0, 1, At, B1); PG8_BAR;
            PG8_LDA(At, 1, 1); PG8_STAGE(PG8_SA(1, 0), a3, voffA);
            PG8_BAR; PG8_WAIT_L(0); PG8_MMA(1, 0, At, B0); PG8_BAR; PG8_SCHED;
            PG8_STAGE(PG8_SB(1, 1), b3 + hstep, voffB);
            PG8_WAIT_V(6); PG8_BAR; PG8_MMA(1, 1, At, B1); PG8_BAR;
            }
        }
        if constexpr (ALIGN_EPI) { if (wr == 0) PG8_BAR; }
        if constexpr (!Epi::AFTER_DRAIN) { E(acc, cur, wr, wc, fr, fq); S.done(cur); }
        if (!has_next) break;
#pragma unroll
        for (int a = 0; a < 2; ++a)
#pragma unroll
            for (int b = 0; b < 2; ++b)
#pragma unroll
                for (int m = 0; m < 4; ++m)
#pragma unroll
                    for (int n = 0; n < 2; ++n) acc[a][b][m][n] = (f32x4){0.f, 0.f, 0.f, 0.f};
        cur = nxt; cA = nA; cB = nB; ++ui;
        if constexpr (ALIGN_EPI) { if (wr == 1) PG8_BAR; }
    }
    PG8_WAIT_V(0);
    if constexpr (!ALIGN_EPI) { if (wr == 0) PG8_BAR; }
    PG8_BAR;
    if constexpr (Epi::AFTER_DRAIN) { E.fused(acc, cur, wr, wc, fr, fq, lds, wid, lane); S.done(cur); }
#undef PG8_SA
#undef PG8_SB
#undef PG8_STAGE
#undef PG8_LDA
#undef PG8_LDB
#undef PG8_MMA
#undef PG8_WAIT_V
#undef PG8_WAIT_L
#undef PG8_BAR
#undef PG8_SCHED
}
}
constexpr int DM = 1024, NB = 8, SEQ = 8192, CTX = 256, SKV = SEQ + CTX;
constexpr int MLAT = NB * SEQ, MALL = MLAT + NB * CTX;
constexpr int NINP = 5376;
typedef unsigned short bf16_t;
typedef short bf16x8 __attribute__((ext_vector_type(8)));
typedef short s16x4 __attribute__((ext_vector_type(4)));
typedef float f32x16 __attribute__((ext_vector_type(16)));
typedef float f32x4 __attribute__((ext_vector_type(4)));
typedef unsigned u32x4 __attribute__((ext_vector_type(4)));
typedef unsigned u32x2 __attribute__((ext_vector_type(2)));
#define LAS __attribute__((address_space(3)))
#define SBAR() __builtin_amdgcn_sched_barrier(0)
typedef float f32x2_t __attribute__((ext_vector_type(2)));
typedef __bf16 bf16x2_t __attribute__((ext_vector_type(2)));
__device__ __forceinline__ unsigned cvtpk(float lo, float hi) { f32x2_t v = {lo, hi}; bf16x2_t b = __builtin_convertvector(v, bf16x2_t); return __builtin_bit_cast(unsigned, b); }
__device__ __forceinline__ unsigned cvtpk_a(float lo, float hi) { unsigned r; asm volatile("v_cvt_pk_bf16_f32 %0, %1, %2" : "=v"(r) : "v"(lo), "v"(hi)); return r; }
__device__ __forceinline__ unsigned f2bf(float f) { unsigned u = __builtin_bit_cast(unsigned, f); return (u + 0x7fffu + ((u >> 16) & 1u)) >> 16; }
__device__ __forceinline__ float bf2f(unsigned short b) { return __builtin_bit_cast(float, (unsigned)b << 16); }
__device__ __forceinline__ float bflo(unsigned w) { return __builtin_bit_cast(float, w << 16); }
__device__ __forceinline__ float bfhi(unsigned w) { return __builtin_bit_cast(float, w & 0xffff0000u); }
__device__ __forceinline__ float sigmoidf_(float v) { return 1.f / (1.f + __expf(-v)); }
__device__ __forceinline__ float sigmoid_fast(float v) { return __builtin_amdgcn_rcpf(1.f + __builtin_amdgcn_exp2f(-1.4426950408889634f * v)); }
__device__ __forceinline__ float wave_sum(float v) {
#pragma unroll
    for (int o = 1; o < 64; o <<= 1) v += shflx(v, o);
    return v;
}

namespace att {
#ifndef PROBE_NOLOAD
#define PROBE_NOLOAD 0
#endif
template <bool MLA> struct Cfg {
    static constexpr int DQK = MLA ? 96 : 64, DV = MLA ? 64 : 128, NQ = DQK / 16, NCB = DV / 32;
    static constexpr int KROWB = MLA ? 256 : 128;
    static constexpr int LDQ = MLA ? 768 : 512, LDK = MLA ? 768 : 512, LDV = 512;
    static constexpr int SHM_V = 64 * DV * 2, SHM_K = 64 * KROWB;
};
constexpr float THR = 8.f;
__device__ __forceinline__ int crow(int r, int hi) { return (r & 3) + 8 * (r >> 2) + 4 * hi; }
template <bool MLA> __device__ __forceinline__ int kswz(int row, int colB) {
    if constexpr (MLA) return row * 256 + (colB ^ ((row & 15) << 4));
    else return row * 128 + (colB ^ (((row >> 1) & 7) << 4));
}
__device__ __forceinline__ float max3f(float a, float b, float c) { float r; asm("v_max3_f32 %0, %1, %2, %3" : "=v"(r) : "v"(a), "v"(b), "v"(c)); return r; }
__device__ __forceinline__ void rowmax_adjust(f32x16& p0, f32x16& p1, float& m2, f32x16& negm, float& alpha, const bool first) {
    constexpr float THR2 = THR * 1.4426950408889634f;
    float pmax = max3f(p0[0], p0[1], p0[2]);
#pragma unroll
    for (int r = 3; r < 15; r += 2) pmax = max3f(pmax, p0[r], p0[r + 1]);
    pmax = max3f(pmax, p0[15], p1[0]);
#pragma unroll
    for (int r = 1; r < 15; r += 2) pmax = max3f(pmax, p1[r], p1[r + 1]);
    pmax = fmaxf(pmax, p1[15]);
    { auto rr = __builtin_amdgcn_permlane32_swap(__float_as_uint(pmax), __float_as_uint(pmax), false, false);
      pmax = fmaxf(__uint_as_float(rr[0]), __uint_as_float(rr[1])); }
    if (!first && __builtin_expect(__all(pmax <= THR2), 1)) { alpha = 1.f; }
    else {
        const float delta = first ? pmax : fmaxf(pmax, 0.f);
        alpha = first ? 1.f : __builtin_amdgcn_exp2f(-delta);
        m2 += delta;
#pragma unroll
        for (int r = 0; r < 16; ++r) { p0[r] -= delta; p1[r] -= delta; }
        const float nm = -m2;
#pragma unroll
        for (int r = 0; r < 16; ++r) negm[r] = nm;
    }
}
__device__ __forceinline__ float exp_pack(f32x16& p0, f32x16& p1, bf16x8& pa0, bf16x8& pa1, bf16x8& pa2, bf16x8& pa3) {
#pragma unroll
    for (int r = 0; r < 16; ++r) p0[r] = __builtin_amdgcn_exp2f(p0[r]);
#pragma unroll
    for (int r = 0; r < 16; ++r) p1[r] = __builtin_amdgcn_exp2f(p1[r]);
    SBAR(); asm volatile("s_nop 1" ::: "memory"); SBAR();
#define PK4(P, BASE, OUT) do { unsigned a0 = cvtpk_a(P[BASE + 0], P[BASE + 1]), a1 = cvtpk_a(P[BASE + 2], P[BASE + 3]);   \
    unsigned b0 = cvtpk_a(P[BASE + 4], P[BASE + 5]), b1 = cvtpk_a(P[BASE + 6], P[BASE + 7]);                              \
    auto r0 = __builtin_amdgcn_permlane32_swap(a0, b0, false, false); auto r1 = __builtin_amdgcn_permlane32_swap(a1, b1, false, false); \
    u32x4 w = {r0[0], r1[0], r0[1], r1[1]}; OUT = *reinterpret_cast<bf16x8*>(&w); } while (0)
    PK4(p0, 0, pa0); PK4(p0, 8, pa1); PK4(p1, 0, pa2); PK4(p1, 8, pa3);
#undef PK4
    float ps0 = 0.f, ps1 = 0.f;
#pragma unroll
    for (int r = 0; r < 16; ++r) { ps0 += p0[r]; ps1 += p1[r]; }
    float ps = ps0 + ps1;
    { auto rr = __builtin_amdgcn_permlane32_swap(__float_as_uint(ps), __float_as_uint(ps), false, false);
      ps = __uint_as_float(rr[0]) + __uint_as_float(rr[1]); }
    return ps;
}
template <bool MLA> __device__ __forceinline__ void qkt(f32x16& p0, f32x16& p1, const char* Ks, const bf16x8* qr, const f32x16& negm, int r32, int hi) {
    constexpr int NQ = Cfg<MLA>::NQ;
    bf16x8 kf[2 * NQ];
#pragma unroll
    for (int d0 = 0; d0 < NQ; ++d0) { const int cb = (d0 * 16 + hi * 8) * 2;
        kf[2 * d0] = *reinterpret_cast<const bf16x8*>(Ks + kswz<MLA>(r32, cb));
        kf[2 * d0 + 1] = *reinterpret_cast<const bf16x8*>(Ks + kswz<MLA>(32 + r32, cb)); }
    SBAR();
    p0 = negm; p1 = negm;
#pragma unroll
    for (int d0 = 0; d0 < NQ; ++d0) {
        p0 = __builtin_amdgcn_mfma_f32_32x32x16_bf16(kf[2 * d0], qr[d0], p0, 0, 0, 0);
        p1 = __builtin_amdgcn_mfma_f32_32x32x16_bf16(kf[2 * d0 + 1], qr[d0], p1, 0, 0, 0); }
}
template <int NCB> __device__ __forceinline__ int v_st(int k, int c) { const int kk = (k & ~0xC) | ((k & 4) << 1) | ((k & 8) >> 1); return ((kk >> 3) * NCB + (c >> 5)) * 512 + ((kk & 7) * 32 + (c & 31)) * 2; }
__device__ __forceinline__ int v_rd_base(int lane) { return ((lane & 3) << 3) | (((lane >> 2) & 3) << 6) | (((lane >> 4) & 1) << 5) | (((lane >> 5) & 1) << 8); }
template <int NCB> constexpr int v_rd_off(int d0, int ks, int half) { return d0 * 512 + (ks * 2 + half) * NCB * 512; }
template <int OFF> __device__ __forceinline__ s16x4 tr_read(int vb) {
    s16x4 r; asm volatile("ds_read_b64_tr_b16 %0, %1 offset:%2" : "=&v"(r) : "v"(vb), "i"(OFF) : "memory"); return r;
}
template <int NCB, int D0> __device__ __forceinline__ void pv_one(f32x16& od, int vb, bf16x8 pa0, bf16x8 pa1, bf16x8 pa2, bf16x8 pa3) {
    const s16x4 l0 = tr_read<v_rd_off<NCB>(D0, 0, 0)>(vb), h0 = tr_read<v_rd_off<NCB>(D0, 0, 1)>(vb), l1 = tr_read<v_rd_off<NCB>(D0, 1, 0)>(vb), h1 = tr_read<v_rd_off<NCB>(D0, 1, 1)>(vb);
    const s16x4 l2 = tr_read<v_rd_off<NCB>(D0, 2, 0)>(vb), h2 = tr_read<v_rd_off<NCB>(D0, 2, 1)>(vb), l3 = tr_read<v_rd_off<NCB>(D0, 3, 0)>(vb), h3 = tr_read<v_rd_off<NCB>(D0, 3, 1)>(vb);
    asm volatile("s_waitcnt lgkmcnt(0)" ::: "memory"); SBAR();
#define PK(L, H) (bf16x8){L[0], L[1], L[2], L[3], H[0], H[1], H[2], H[3]}
    od = __builtin_amdgcn_mfma_f32_32x32x16_bf16(pa0, PK(l0, h0), od, 0, 0, 0);
    od = __builtin_amdgcn_mfma_f32_32x32x16_bf16(pa1, PK(l1, h1), od, 0, 0, 0);
    od = __builtin_amdgcn_mfma_f32_32x32x16_bf16(pa2, PK(l2, h2), od, 0, 0, 0);
    od = __builtin_amdgcn_mfma_f32_32x32x16_bf16(pa3, PK(l3, h3), od, 0, 0, 0);
#undef PK
}
template <int NCB> __device__ __forceinline__ void pv_all(f32x16* o, int vb, bf16x8 pa0, bf16x8 pa1, bf16x8 pa2, bf16x8 pa3) {
    pv_one<NCB, 0>(o[0], vb, pa0, pa1, pa2, pa3); pv_one<NCB, 1>(o[1], vb, pa0, pa1, pa2, pa3);
    if constexpr (NCB == 4) { pv_one<NCB, 2>(o[2], vb, pa0, pa1, pa2, pa3); pv_one<NCB, 3>(o[3], vb, pa0, pa1, pa2, pa3); }
}

template <int NCB, int D0> __device__ __forceinline__ void v_frag_read(s16x4 (&f)[8], int vb) {
    f[0] = tr_read<v_rd_off<NCB>(D0, 0, 0)>(vb); f[1] = tr_read<v_rd_off<NCB>(D0, 0, 1)>(vb); f[2] = tr_read<v_rd_off<NCB>(D0, 1, 0)>(vb); f[3] = tr_read<v_rd_off<NCB>(D0, 1, 1)>(vb);
    f[4] = tr_read<v_rd_off<NCB>(D0, 2, 0)>(vb); f[5] = tr_read<v_rd_off<NCB>(D0, 2, 1)>(vb); f[6] = tr_read<v_rd_off<NCB>(D0, 3, 0)>(vb); f[7] = tr_read<v_rd_off<NCB>(D0, 3, 1)>(vb);
}
__device__ __forceinline__ void pv_mma(f32x16& od, const s16x4 (&f)[8], bf16x8 pa0, bf16x8 pa1, bf16x8 pa2, bf16x8 pa3) {
#define PK(L, H) (bf16x8){L[0], L[1], L[2], L[3], H[0], H[1], H[2], H[3]}
    od = __builtin_amdgcn_mfma_f32_32x32x16_bf16(pa0, PK(f[0], f[1]), od, 0, 0, 0);
    od = __builtin_amdgcn_mfma_f32_32x32x16_bf16(pa1, PK(f[2], f[3]), od, 0, 0, 0);
    od = __builtin_amdgcn_mfma_f32_32x32x16_bf16(pa2, PK(f[4], f[5]), od, 0, 0, 0);
    od = __builtin_amdgcn_mfma_f32_32x32x16_bf16(pa3, PK(f[6], f[7]), od, 0, 0, 0);
#undef PK
}
__device__ __forceinline__ void pv_mma2(f32x16& oa, f32x16& ob, const s16x4 (&f)[8], const s16x4 (&h)[8], bf16x8 pa0, bf16x8 pa1, bf16x8 pa2, bf16x8 pa3) {
#define PK(L, H) (bf16x8){L[0], L[1], L[2], L[3], H[0], H[1], H[2], H[3]}
    oa = __builtin_amdgcn_mfma_f32_32x32x16_bf16(pa0, PK(f[0], f[1]), oa, 0, 0, 0); ob = __builtin_amdgcn_mfma_f32_32x32x16_bf16(pa0, PK(h[0], h[1]), ob, 0, 0, 0);
    oa = __builtin_amdgcn_mfma_f32_32x32x16_bf16(pa1, PK(f[2], f[3]), oa, 0, 0, 0); ob = __builtin_amdgcn_mfma_f32_32x32x16_bf16(pa1, PK(h[2], h[3]), ob, 0, 0, 0);
    oa = __builtin_amdgcn_mfma_f32_32x32x16_bf16(pa2, PK(f[4], f[5]), oa, 0, 0, 0); ob = __builtin_amdgcn_mfma_f32_32x32x16_bf16(pa2, PK(h[4], h[5]), ob, 0, 0, 0);
    oa = __builtin_amdgcn_mfma_f32_32x32x16_bf16(pa3, PK(f[6], f[7]), oa, 0, 0, 0); ob = __builtin_amdgcn_mfma_f32_32x32x16_bf16(pa3, PK(h[6], h[7]), ob, 0, 0, 0);
#undef PK
}
#define LWAIT0() do { asm volatile("s_waitcnt lgkmcnt(0)" ::: "memory"); SBAR(); } while (0)
template <bool MLA>
__device__ __forceinline__ void attn_core(const bf16_t* __restrict__ Qb, const bf16_t* __restrict__ Kh, const bf16_t* __restrict__ Vh, int seq, char* lds,
                                          f32x16 (&o)[Cfg<MLA>::NCB], const int wid  , const int g  ) {
    using CF = Cfg<MLA>;
    constexpr int NQ = CF::NQ, NCB = CF::NCB, SHM_V = CF::SHM_V, SHM_K = CF::SHM_K, LDQ = CF::LDQ, LDK = CF::LDK, LDV = CF::LDV;
    const int lane = lane_id_v(), tid = wid * 64 + lane, r32 = lane & 31, hi = lane >> 5;
    char* V_lds = lds; char* K_lds = lds + 4 * SHM_V;
    float* wsp = (float*)(lds + 90112) + wid * 64; float* li_l = wsp; float* al_l = wsp + 32;
    float m2 = 0.f, l_reg = 0.f; f32x16 negm = f32x16{}; bf16x8 qr[NQ];
#pragma unroll
    for (int d = 0; d < NCB; ++d) o[d] = f32x16{};
    const bf16_t* Qw = Qb + (long)(wid * 32 + r32) * LDQ + hi * 8;
#pragma unroll
    for (int d0 = 0; d0 < NQ; ++d0) qr[d0] = *reinterpret_cast<const bf16x8*>(Qw + d0 * 16);
    const int vr0 = MLA ? (tid >> 3) : (tid >> 4), vc0 = MLA ? (tid & 7) * 8 : (tid & 15) * 8;
    const int vst0 = v_st<NCB>(vr0, vc0), vst1 = v_st<NCB>(32 + vr0, vc0);
    const int kcA = tid, krA = MLA ? (kcA / 12) : (tid >> 3), kcolA = MLA ? (kcA % 12) * 8 : (tid & 7) * 8;
    const int kcB = 512 + (tid & 255), krB = kcB / 12, kcolB = (kcB % 12) * 8;
    const int kstA = kswz<MLA>(krA, kcolA * 2), kstB = kswz<MLA>(krB, kcolB * 2);
    const int vb0 = (int)(uintptr_t)V_lds + v_rd_base(lane);
    struct { bf16x8 a, b, c; } sr_[2];
#define SLOAD(i, k0) do { if constexpr (MLA) { \
        sr_[i].a = *reinterpret_cast<const bf16x8*>(&Vh[(long)((k0) + vr0) * LDV + vc0]); \
        sr_[i].b = *reinterpret_cast<const bf16x8*>(&Kh[(long)((k0) + krA) * LDK + kcolA]); \
        sr_[i].c = *reinterpret_cast<const bf16x8*>(&Kh[(long)((k0) + krB) * LDK + kcolB]); \
    } else { \
        sr_[i].a = *reinterpret_cast<const bf16x8*>(&Vh[(long)((k0) + vr0) * LDV + vc0]); \
        sr_[i].b = *reinterpret_cast<const bf16x8*>(&Vh[(long)((k0) + 32 + vr0) * LDV + vc0]); \
        sr_[i].c = *reinterpret_cast<const bf16x8*>(&Kh[(long)((k0) + krA) * LDK + kcolA]); } } while (0)
#define SWRITE(ko, vo, i) do { if constexpr (MLA) { \
        *(bf16x8*)(V_lds + (vo) + vst0) = sr_[i].a; \
        *(bf16x8*)(K_lds + (ko) + kstA) = sr_[i].b; \
        if (wid < 4) *(bf16x8*)(K_lds + (ko) + kstB) = sr_[i].c; \
    } else { \
        *(bf16x8*)(V_lds + (vo) + vst0) = sr_[i].a; \
        *(bf16x8*)(V_lds + (vo) + vst1) = sr_[i].b; \
        *(bf16x8*)(K_lds + (ko) + kstA) = sr_[i].c; } } while (0)
#define SWAIT() asm volatile("s_waitcnt vmcnt(3)" ::: "memory")
#define RESC(a) do { if (__any((a) < 1.f)) { if (hi == 0) al_l[r32] = (a); asm volatile("s_waitcnt lgkmcnt(0)" ::: "memory"); \
    _Pragma("unroll") for (int r = 0; r < 16; ++r) { const float al_ = al_l[crow(r, hi)]; _Pragma("unroll") for (int d = 0; d < NCB; ++d) o[d][r] *= al_; } } } while (0)
    f32x16 S0, S1; float alpha = 1.f; bf16x8 pa0, pa1, pa2, pa3; const int NT = seq / 64;
    constexpr int SE = 0, SO = 1;
#define MSEG(j) do { const int j_ = (j); const bool doqk = j_ < NT, dopv = j_ > 0; \
        const char* Ks_ = K_lds + (j_ % 3) * SHM_K; const int vb_ = vb0 + ((j_ - 1) & 3) * SHM_V; \
        bf16x8 kf[2 * NQ]; s16x4 fa[8], fb[8]; \
        if (doqk) { _Pragma("unroll") for (int d0 = 0; d0 < NQ; ++d0) { const int cb = (d0 * 16 + hi * 8) * 2; \
            kf[2 * d0] = *reinterpret_cast<const bf16x8*>(Ks_ + kswz<MLA>(r32, cb)); kf[2 * d0 + 1] = *reinterpret_cast<const bf16x8*>(Ks_ + kswz<MLA>(32 + r32, cb)); } } \
        if (dopv) { v_frag_read<NCB, 0>(fa, vb_); if constexpr (NCB == 2) v_frag_read<NCB, 1>(fb, vb_); }     \
        SBAR(); \
        if (doqk) { S0 = negm; S1 = negm; _Pragma("unroll") for (int d0 = 0; d0 < NQ; ++d0) { \
            S0 = __builtin_amdgcn_mfma_f32_32x32x16_bf16(kf[2 * d0], qr[d0], S0, 0, 0, 0); S1 = __builtin_amdgcn_mfma_f32_32x32x16_bf16(kf[2 * d0 + 1], qr[d0], S1, 0, 0, 0); } } \
        if (dopv) { if constexpr (NCB == 4) { SBAR(); v_frag_read<NCB, 1>(fb, vb_); }     \
            LWAIT0(); \
            if constexpr (NCB == 4) { pv_mma2(o[0], o[1], fa, fb, pa0, pa1, pa2, pa3); SBAR(); v_frag_read<NCB, 2>(fa, vb_); v_frag_read<NCB, 3>(fb, vb_); \
                LWAIT0(); pv_mma2(o[2], o[NCB - 1], fa, fb, pa0, pa1, pa2, pa3); } \
            else { pv_mma2(o[0], o[1], fa, fb, pa0, pa1, pa2, pa3); } } } while (0)
#define VSEG(j) do { rowmax_adjust(S0, S1, m2, negm, alpha, (j) == 0); RESC(alpha); l_reg = l_reg * alpha + exp_pack(S0, S1, pa0, pa1, pa2, pa3); } while (0)
    __syncthreads();
    SLOAD(SE, 0); SLOAD(SO, 64); asm volatile("s_waitcnt vmcnt(0)" ::: "memory");
    SWRITE(0, 0, SE); SWRITE(SHM_K, SHM_V, SO);
    SLOAD(SE, 2 * 64); SLOAD(SO, 3 * 64);
    __syncthreads();
    { int g_ = g; asm volatile("" : "+s"(g_)); if (g_ == 1) __syncthreads(); }
    for (int j = 0; j < NT; j += 2) {
        SBAR(); MSEG(j); SBAR();
        __syncthreads();
        SBAR(); VSEG(j);
        SWAIT(); if (j + 2 < NT) SWRITE(((j + 2) % 3) * SHM_K, ((j + 2) & 3) * SHM_V, SE);
        if (!(MLA && PROBE_NOLOAD)) { const int tn = (j + 4 < NT) ? j + 4 : NT - 1; SLOAD(SE, tn * 64); } SBAR();
        __syncthreads();
        SBAR(); MSEG(j + 1); SBAR();
        __syncthreads();
        SBAR(); VSEG(j + 1);
        SWAIT(); if (j + 3 < NT) SWRITE(((j + 3) % 3) * SHM_K, ((j + 3) & 3) * SHM_V, SO);
        if (!(MLA && PROBE_NOLOAD)) { const int tn = (j + 5 < NT) ? j + 5 : NT - 1; SLOAD(SO, tn * 64); } SBAR();
        __syncthreads();
    }
    SBAR(); MSEG(NT); SBAR();
    { int g_ = g; asm volatile("" : "+s"(g_)); if (g_ == 0) __syncthreads(); }
#undef MSEG
#undef VSEG
    asm volatile("s_waitcnt vmcnt(0)" ::: "memory");
    if (hi == 0) li_l[r32] = l_reg; asm volatile("s_waitcnt lgkmcnt(0)" ::: "memory");
#pragma unroll
    for (int r = 0; r < 16; ++r) { const float rl = __builtin_amdgcn_rcpf(li_l[crow(r, hi)]);
#pragma unroll
        for (int d = 0; d < NCB; ++d) o[d][r] *= rl; }
#undef SLOAD
#undef SWRITE
#undef SWAIT
#undef RESC
}
}
typedef float2 cs_t;
__device__ __forceinline__ void store8(bf16_t* p, f32x4 v0, f32x4 v1) {
    u32x4 w; w.x = cvtpk(v0[0], v0[1]); w.y = cvtpk(v0[2], v0[3]); w.z = cvtpk(v1[0], v1[1]); w.w = cvtpk(v1[2], v1[3]);
    *(u32x4*)p = w;
}
__device__ __forceinline__ float dot8(f32x4 v0, f32x4 v1) { return (v0[0] * v0[0] + v0[1] * v0[1]) + (v0[2] * v0[2] + v0[3] * v0[3]) + (v1[0] * v1[0] + v1[1] * v1[1]) + (v1[2] * v1[2] + v1[3] * v1[3]); }
__device__ __forceinline__ void rope64(f32x4& v0, f32x4& v1, const cs_t* __restrict__ CS16, int gr, int gc, int wc, int fq, bool apply) {
    f32x4 p0, p1; const int ix = (lane_id_v() ^ 32) << 2;
#pragma unroll
    for (int j = 0; j < 4; ++j) { p0[j] = shfli(v0[j], ix); p1[j] = shfli(v1[j], ix); }
    if (apply) {
        const int pos = (wc & 1) ? gc : gr; const cs_t* t = CS16 + pos * 16 + 8 * (fq & 1);
        const float sg = (fq < 2) ? -1.f : 1.f;
#pragma unroll
        for (int j = 0; j < 4; ++j) { const cs_t a = t[j], b = t[4 + j];
            v0[j] = v0[j] * a.x + sg * p0[j] * a.y; v1[j] = v1[j] * b.x + sg * p1[j] * b.y; }
    }
}
__device__ __forceinline__ void rope32(f32x4& v0, f32x4& v1, const cs_t* __restrict__ CS8, int gr, int gc, int g, bool apply) {
    f32x4 p0, p1; const int ix = (lane_id_v() ^ 16) << 2;
#pragma unroll
    for (int j = 0; j < 4; ++j) { p0[j] = shfli(v0[j], ix); p1[j] = shfli(v1[j], ix); }
    if (apply) {
        const int pos = (g >= 2) ? gc : gr; const cs_t* t = CS8 + pos * 8;
        const float sg = (g & 1) ? 1.f : -1.f;
#pragma unroll
        for (int j = 0; j < 4; ++j) { const cs_t a = t[j], b = t[4 + j];
            v0[j] = v0[j] * a.x + sg * p0[j] * a.y; v1[j] = v1[j] * b.x + sg * p1[j] * b.y; }
    }
}
#define EPI_ARGS const pg8::f32x4 (&acc)[2][2][4][2], const pg8::Unit& u, int wr, int wc, int fr, int fq
#define EPI_RECOMPUTE { const int l_ = lane_id_v(); fr = l_ & 15; fq = l_ >> 4; }

struct EpiP1 {
    static constexpr bool PERM = true, AFTER_DRAIN = false;
    bf16_t *CKV, *CQ, *KMLA, *GA, *DQ, *DK, *DV, *GD, *MG; float *SSKV, *SSQ; const cs_t *CS16, *CS8; bool do_stats;
    __device__ __forceinline__ void operator()(EPI_ARGS) const {
        EPI_RECOMPUTE
        const int pm = u.pm, pn = u.pn; const bool lat = pm < 256;
        if (!lat && !(pn == 0 || pn == 2 || (pn >= 7 && pn <= 10))) return;
        const int row0 = pm * 256 + wr * 64 + fr;
        const int kv0 = (lat ? (pm >> 5) * SKV + CTX + (pm & 31) * 256 : (pm - 256) * SKV) + wr * 64 + fr;
        const int lcw = wc * 32 + 8 * fq;
#pragma unroll
        for (int ai = 0; ai < 2; ++ai)
#pragma unroll
            for (int m = 0; m < 4; ++m) {
                __builtin_amdgcn_sched_barrier(0); const int row = opq(row0 + ai * 128 + m * 16), kvrow = kv0 + (row - row0);
                const int s = row & (SEQ - 1), gr = s >> 6, gc = s & 63;
                float ssq = 0.f;
#pragma unroll
                for (int bj = 0; bj < 2; ++bj) {
                    f32x4 v0 = acc[ai][bj][m][0], v1 = acc[ai][bj][m][1]; const int lc = bj * 128 + lcw;
                    if (pn == 0) { ssq += dot8(v0, v1); store8(CKV + (size_t)kvrow * 256 + lc, v0, v1); }
                    else if (pn == 1) { ssq += dot8(v0, v1); store8(CQ + (size_t)row * 384 + lc, v0, v1); }
                    else if (pn == 2) {
                        if (bj == 0) { if (lat) { ssq += dot8(v0, v1); store8(CQ + (size_t)row * 384 + 256 + lc, v0, v1); } }
                        else if (wc == 0) { rope32(v0, v1, CS8, gr, gc, fq, lat);
#pragma unroll
                            for (int h = 0; h < 8; ++h) store8(KMLA + (size_t)kvrow * 768 + h * 96 + 64 + 8 * fq, v0, v1); }
                    }
                    else if (pn <= 4 || pn == 11 || pn == 12) {
#pragma unroll
                        for (int j = 0; j < 4; ++j) { v0[j] = v0[j] * sigmoid_fast(v0[j]); v1[j] = v1[j] * sigmoid_fast(v1[j]); }
                        bf16_t* dst = (pn <= 4) ? GA + (size_t)row * 512 + (pn - 3) * 256 + lc : GD + (size_t)row * 512 + (pn - 11) * 256 + lc;
                        store8(dst, v0, v1);
                    }
                    else if (pn <= 6) { v0 = v0 * 0.18033688011112042f; v1 = v1 * 0.18033688011112042f;
                        rope64(v0, v1, CS16, gr, gc, wc, fq, true); store8(DQ + (size_t)row * 512 + (pn - 5) * 256 + lc, v0, v1); }
                    else if (pn <= 8) { rope64(v0, v1, CS16, gr, gc, wc, fq, lat); store8(DK + (size_t)kvrow * 512 + (pn - 7) * 256 + lc, v0, v1); }
                    else if (pn <= 10) { store8(DV + (size_t)kvrow * 512 + (pn - 9) * 256 + lc, v0, v1); }
                    else {
#pragma unroll
                        for (int j = 0; j < 4; ++j) { v0[j] = sigmoid_fast(v0[j]); v1[j] = sigmoid_fast(v1[j]); }
                        store8(MG + (size_t)row * 2048 + (pn - 13) * 256 + lc, v0, v1);
                    }
                }
                if (pn <= 2) {
                    ssq += shflx(ssq, 16); ssq += shflx(ssq, 32);
                    if (fq == 0) { if (pn == 0) SSKV[(size_t)kvrow * 4 + wc] = ssq; else if (lat) SSQ[(size_t)row * 8 + (pn - 1) * 4 + wc] = ssq; }
                }
            }
    }
};
struct EpiQ {
    static constexpr bool PERM = true, AFTER_DRAIN = false;
    bf16_t* QMLA; const float* SSQ; const cs_t* CS8;
    __device__ __forceinline__ void operator()(EPI_ARGS) const {
        EPI_RECOMPUTE
        const int row0 = u.pm * 256 + wr * 64 + fr;
#pragma unroll
        for (int ai = 0; ai < 2; ++ai)
#pragma unroll
            for (int m = 0; m < 4; ++m) {
                __builtin_amdgcn_sched_barrier(0); const int row = opq(row0 + ai * 128 + m * 16); const int s = row & (SEQ - 1), gr = s >> 6, gc = s & 63;
                const f32x4 sa = *(const f32x4*)(SSQ + (size_t)row * 8), sb = *(const f32x4*)(SSQ + (size_t)row * 8 + 4);
                const float rs = 0.14724445f / sqrtf((((sa[0] + sa[1]) + (sa[2] + sa[3])) + ((sb[0] + sb[1]) + (sb[2] + sb[3]))) * (1.f / 384.f) + 1e-6f);
#pragma unroll
                for (int bj = 0; bj < 2; ++bj) {
                    f32x4 v0 = acc[ai][bj][m][0] * rs, v1 = acc[ai][bj][m][1] * rs;
                    const int c0 = u.pn * 256 + bj * 128 + wc * 32 + 8 * fq, d = c0 % 96;
                    rope32(v0, v1, CS8, gr, gc, (d - 64) >> 3, d >= 64);
                    store8(QMLA + (size_t)row * 768 + c0, v0, v1);
                }
            }
    }
};
struct EpiKV {
    static constexpr bool PERM = true, AFTER_DRAIN = false;
    bf16_t *KMLA, *VMLA; const float* SSKV;
    __device__ __forceinline__ void operator()(EPI_ARGS) const {
        EPI_RECOMPUTE
        const int row0 = u.pm * 256 + wr * 64 + fr;
#pragma unroll
        for (int ai = 0; ai < 2; ++ai)
#pragma unroll
            for (int m = 0; m < 4; ++m) {
                __builtin_amdgcn_sched_barrier(0); const int row = opq(row0 + ai * 128 + m * 16);
                const f32x4 sa = *(const f32x4*)(SSKV + (size_t)row * 4);
                const float rs = 1.f / sqrtf(((sa[0] + sa[1]) + (sa[2] + sa[3])) * (1.f / 256.f) + 1e-6f);
#pragma unroll
                for (int bj = 0; bj < 2; ++bj) {
                    const f32x4 v0 = acc[ai][bj][m][0] * rs, v1 = acc[ai][bj][m][1] * rs;
                    const int h = u.pn * 2 + bj, d = wc * 32 + 8 * fq;
                    if (wc < 2) store8(KMLA + (size_t)row * 768 + h * 96 + d, v0, v1);
                    else store8(VMLA + (size_t)row * 512 + h * 64 + (d - 64), v0, v1);
                }
            }
    }
};
template <bool ACCUM> struct EpiZ {
    static constexpr bool PERM = true, AFTER_DRAIN = false;
    bf16_t* Z; const bf16_t* MG;
    __device__ __forceinline__ void operator()(EPI_ARGS) const {
        EPI_RECOMPUTE
        const int row0 = u.pm * 256 + wr * 64 + fr;
#pragma unroll
        for (int ai = 0; ai < 2; ++ai)
#pragma unroll
            for (int m = 0; m < 4; ++m) {
                __builtin_amdgcn_sched_barrier(0); const int row = opq(row0 + ai * 128 + m * 16);
#pragma unroll
                for (int bj = 0; bj < 2; ++bj) {
                    f32x4 v0 = acc[ai][bj][m][0], v1 = acc[ai][bj][m][1];
                    const int c0 = u.pn * 256 + bj * 128 + wc * 32 + 8 * fq;
                    const u32x4 g = *(const u32x4*)(MG + (size_t)row * 2048 + c0);
                    v0[0] *= bflo(g.x); v0[1] *= bfhi(g.x); v0[2] *= bflo(g.y); v0[3] *= bfhi(g.y);
                    v1[0] *= bflo(g.z); v1[1] *= bfhi(g.z); v1[2] *= bflo(g.w); v1[3] *= bfhi(g.w);
                    bf16_t* zp = Z + (size_t)row * 1024 + c0;
                    if (ACCUM) { const u32x4 z = *(const u32x4*)zp;
                        v0[0] += bflo(z.x); v0[1] += bfhi(z.x); v0[2] += bflo(z.y); v0[3] += bfhi(z.y);
                        v1[0] += bflo(z.z); v1[1] += bfhi(z.z); v1[2] += bflo(z.w); v1[3] += bfhi(z.w); }
                    store8(zp, v0, v1);
                }
            }
    }
};
struct EpiOut {
    static constexpr bool PERM = true, AFTER_DRAIN = false;
    float* OUT; const float* X; const float* MOD;
    __device__ __forceinline__ void operator()(EPI_ARGS) const {
        EPI_RECOMPUTE
        const int row0 = u.pm * 256 + wr * 64 + fr; const float ALPHA = 1.189207115002721f;
        const float* gate = MOD + (size_t)(u.pm >> 5) * 3072 + 2048;
#pragma unroll
        for (int ai = 0; ai < 2; ++ai)
#pragma unroll
            for (int m = 0; m < 4; ++m) {
                __builtin_amdgcn_sched_barrier(0); const int row = opq(row0 + ai * 128 + m * 16);
#pragma unroll
                for (int bj = 0; bj < 2; ++bj) {
                    const int c0 = u.pn * 256 + bj * 128 + wc * 32 + 8 * fq;
                    const f32x4 x0 = *(const f32x4*)(X + (size_t)row * 1024 + c0), x1 = *(const f32x4*)(X + (size_t)row * 1024 + c0 + 4);
                    const f32x4 g0 = *(const f32x4*)(gate + c0), g1 = *(const f32x4*)(gate + c0 + 4);
                    *(f32x4*)(OUT + (size_t)row * 1024 + c0) = x0 * ALPHA + g0 * acc[ai][bj][m][0];
                    *(f32x4*)(OUT + (size_t)row * 1024 + c0 + 4) = x1 * ALPHA + g1 * acc[ai][bj][m][1];
                }
            }
    }
};
constexpr size_t MiB = 1u << 20;
constexpr size_t WS_SSKV = 0, WS_SSQ = 512 * 1024, CTL_ZERO_BYTES = 1 * MiB;
constexpr size_t WS_MOD = 1 * MiB, WS_CS16 = 1 * MiB + 128 * 1024, WS_CS8 = 1 * MiB + 192 * 1024;
constexpr size_t WS_WIN = 2 * MiB, WS_WUQ = 13 * MiB, WS_WUKV = 14 * MiB, WS_WOA = 15 * MiB, WS_WOB = 16 * MiB, WS_WOUT = 17 * MiB;
constexpr size_t WS_HBF = 32 * MiB;
constexpr size_t WS_VMLA = WS_HBF, WS_Z = WS_HBF;
constexpr size_t WS_KMLA = 164 * MiB;
constexpr size_t WS_GA = 263 * MiB;
constexpr size_t WS_DQ = 327 * MiB;
constexpr size_t WS_DK = 391 * MiB;
constexpr size_t WS_DV = 457 * MiB;
constexpr size_t WS_GD = 523 * MiB;
constexpr size_t WS_MG = 587 * MiB;
constexpr size_t WS_QMLA = 843 * MiB;
constexpr size_t WS_SSKVP = 939 * MiB, WS_SSQP = 941 * MiB;
constexpr size_t WS_END = 944 * MiB;
constexpr size_t OUT_XA = 96 * MiB, OUT_XD = 160 * MiB;
constexpr size_t OUT_CKV = 0, OUT_CQ = 33 * MiB;
constexpr int LDS_BYTES = 157696;

struct Args {
    const float *x, *c, *ctx, *c_ctx, *w_mod, *b_mod, *w_in, *q_norm, *kv_norm, *w_uq, *w_ukv, *dlam, *subln, *w_oa, *w_ob, *w_out, *ln_g, *ln_b;
    float* out; unsigned char* ws;
};

__device__ __forceinline__ void tr_item(const float* __restrict__ W, int K, int N, int srcn0, const float* __restrict__ ksc, bf16_t* WT, int dstn0, int k0, float* scr, int lane) {
#pragma unroll 8
    for (int i = 0; i < 32; ++i) { const int kk = 2 * i + (lane >> 5);
        float v = 0.f; if (srcn0 >= 0) { v = W[(size_t)(k0 + kk) * N + srcn0 + (lane & 31)]; if (ksc) v *= ksc[k0 + kk]; }
        scr[kk * 33 + (lane & 31)] = v; }
    asm volatile("s_waitcnt lgkmcnt(0)" ::: "memory");
    const int c = lane & 7;
#pragma unroll
    for (int j = 0; j < 4; ++j) { const int n = (lane >> 3) + 8 * j; const float* s = scr + (8 * c) * 33 + n;
        u32x4 o; o.x = cvtpk(s[0 * 33], s[1 * 33]); o.y = cvtpk(s[2 * 33], s[3 * 33]); o.z = cvtpk(s[4 * 33], s[5 * 33]); o.w = cvtpk(s[6 * 33], s[7 * 33]);
        *(u32x4*)(WT + (size_t)(dstn0 + n) * K + k0 + 8 * c) = o; }
    asm volatile("s_waitcnt lgkmcnt(0)" ::: "memory");
}

__global__ void __launch_bounds__(512, 2) fwd_mega(Args a) {
    extern __shared__ __attribute__((aligned(16))) unsigned char lds[];
    cg::grid_group grid = cg::this_grid();
    const int wave = __builtin_amdgcn_readfirstlane((int)threadIdx.x >> 6);
#define LANE_TID const int lane = lane_id_v(), tid = wave * 64 + lane; (void)tid; (void)lane;
    const int G = gridDim.x, bid = blockIdx.x;
    const int gw = bid * 8 + wave, NGW = G * 8;
    unsigned char* ws = a.ws; unsigned char* ob = (unsigned char*)a.out;
    float* SSKV = (float*)(ws + WS_SSKVP); float* SSQ = (float*)(ws + WS_SSQP); float* MOD = (float*)(ws + WS_MOD);
    cs_t* CS16 = (cs_t*)(ws + WS_CS16); cs_t* CS8 = (cs_t*)(ws + WS_CS8);
    bf16_t* WIN = (bf16_t*)(ws + WS_WIN); bf16_t* WUQ = (bf16_t*)(ws + WS_WUQ); bf16_t* WUKV = (bf16_t*)(ws + WS_WUKV);
    bf16_t* WOA = (bf16_t*)(ws + WS_WOA); bf16_t* WOB = (bf16_t*)(ws + WS_WOB); bf16_t* WOUT = (bf16_t*)(ws + WS_WOUT);
    bf16_t* HBF = (bf16_t*)(ws + WS_HBF); bf16_t* VMLA = (bf16_t*)(ws + WS_VMLA); bf16_t* Z = (bf16_t*)(ws + WS_Z);
    bf16_t* KMLA = (bf16_t*)(ws + WS_KMLA); bf16_t* GA = (bf16_t*)(ws + WS_GA); bf16_t* DQ = (bf16_t*)(ws + WS_DQ); bf16_t* DK = (bf16_t*)(ws + WS_DK);
    bf16_t* DV = (bf16_t*)(ws + WS_DV); bf16_t* GD = (bf16_t*)(ws + WS_GD); bf16_t* MG = (bf16_t*)(ws + WS_MG); bf16_t* QMLA = (bf16_t*)(ws + WS_QMLA);
    bf16_t* CKV = (bf16_t*)(ob + OUT_CKV); bf16_t* CQ = (bf16_t*)(ob + OUT_CQ); bf16_t* XA = (bf16_t*)(ob + OUT_XA); bf16_t* XD = (bf16_t*)(ob + OUT_XD);
    PG8_LAS unsigned char* ldsp = (PG8_LAS unsigned char*)lds;

#ifndef REP1
#define REP1 1
#endif
#ifndef REP2
#define REP2 1
#endif
#ifndef REP3A
#define REP3A 0
#endif
#ifndef REP3D
#define REP3D 0
#endif
#ifndef REP4A
#define REP4A 1
#endif
#ifndef REP4B
#define REP4B 1
#endif
#ifndef PHMASK
#define PHMASK 0xfff
#endif
    if (PHMASK & (1 << 0)) {
        LANE_TID
        float* A = (float*)lds; float* red = (float*)(lds + 36864);
        for (int cb = bid; cb < 96; cb += G) {
            __syncthreads();
            for (int i = tid; i < 9 * 1024; i += 512) { const int r = i >> 10, k = i & 1023; const float v = r < 8 ? a.c[r * 1024 + k] : a.c_ctx[k]; A[i] = v * sigmoidf_(v); }
            __syncthreads();
            const int cl = tid & 31, col = cb * 32 + cl, kq = tid >> 5;
            float acc[9];
#pragma unroll
            for (int r = 0; r < 9; ++r) acc[r] = 0.f;
#pragma unroll 4
            for (int kk = 0; kk < 64; ++kk) { const int k = kq * 64 + kk; const float w = a.w_mod[(size_t)k * 3072 + col];
#pragma unroll
                for (int r = 0; r < 9; ++r) acc[r] += A[r * 1024 + k] * w; }
#pragma unroll
            for (int r = 0; r < 9; ++r) red[(kq * 9 + r) * 32 + cl] = acc[r];
            __syncthreads();
            if (tid < 288) { const int r = tid >> 5; float s = 0.f;
                for (int q = 0; q < 16; ++q) s += red[(q * 9 + r) * 32 + cl];
                MOD[r * 3072 + col] = s + a.b_mod[col]; }
        }
        __syncthreads();
        float* scr = (float*)lds + wave * (64 * 33);
        constexpr int I_IN = 16 * 168, I_UQ = 6 * 24, I_UKV = 4 * 32, I_OA = 8 * 32, I_OB = 8 * 32, I_OUT = 16 * 32;
        constexpr int NITEMS = I_IN + I_UQ + I_UKV + I_OA + I_OB + I_OUT;
        for (int it = gw; it < NITEMS; it += NGW) {
            int r = it;
            if (r < I_IN) { const int kb = r / 168, nb = r % 168, d0 = nb * 32;
                const int s0 = d0 < 256 ? 384 + d0 : d0 < 640 ? d0 - 256 : d0 < 672 ? d0 : d0 < 768 ? -1 : d0 - 96;
                tr_item(a.w_in, 1024, 5280, s0, nullptr, WIN, d0, kb * 64, scr, lane); continue; } r -= I_IN;
            if (r < I_UQ) { tr_item(a.w_uq, 384, 768, (r % 24) * 32, a.q_norm, WUQ, (r % 24) * 32, (r / 24) * 64, scr, lane); continue; } r -= I_UQ;
            if (r < I_UKV) { tr_item(a.w_ukv, 256, 1024, (r % 32) * 32, a.kv_norm, WUKV, (r % 32) * 32, (r / 32) * 64, scr, lane); continue; } r -= I_UKV;
            if (r < I_OA) { tr_item(a.w_oa, 512, 1024, (r % 32) * 32, nullptr, WOA, (r % 32) * 32, (r / 32) * 64, scr, lane); continue; } r -= I_OA;
            if (r < I_OB) { tr_item(a.w_ob, 512, 1024, (r % 32) * 32, nullptr, WOB, (r % 32) * 32, (r / 32) * 64, scr, lane); continue; } r -= I_OB;
            tr_item(a.w_out, 1024, 1024, (r % 32) * 32, nullptr, WOUT, (r % 32) * 32, (r / 32) * 64, scr, lane);
        }
        if (bid == G - 1) {
            for (int i = tid; i < 128 * 16; i += 512) { const int pos = i >> 4, f = i & 15; const float inv = powf(10000.f, -(float)f / 16.f), ang = (float)pos * inv; CS16[i] = make_float2(cosf(ang), sinf(ang)); }
            for (int i = tid; i < 128 * 8; i += 512) { const int pos = i >> 3, f = i & 7; const float inv = powf(10000.f, -(float)f / 8.f), ang = (float)pos * inv; CS8[i] = make_float2(cosf(ang), sinf(ang)); }
        }
    }
    grid.sync();

    if (PHMASK & (1 << 1)) for (int m = gw; m < MALL; m += NGW) {
        LANE_TID
        const float* src; const float* mod;
        if (m < MLAT) { src = a.x + (size_t)m * 1024; mod = MOD + (size_t)(m >> 13) * 3072; } else { src = a.ctx + (size_t)(m - MLAT) * 1024; mod = MOD + 8 * 3072; }
#pragma unroll
        for (int j = 0; j < 4; ++j) { const int c4 = lane + 64 * j;
            const f32x4 v = ((const f32x4*)src)[c4], sh = ((const f32x4*)mod)[c4], sc = ((const f32x4*)(mod + 1024))[c4];
            const f32x4 h = v * (sc + 1.f) + sh; u32x2 w; w.x = cvtpk(h[0], h[1]); w.y = cvtpk(h[2], h[3]);
            *(u32x2*)(HBF + (size_t)m * 1024 + c4 * 4) = w; }
    }
    grid.sync();

    if (PHMASK & (1 << 2)) for (int rep = 0; rep < REP1; ++rep) {
        pg8::Gemm g{HBF, WIN, MALL, NINP, 1024}; pg8::StaticOrder S; S.init(MALL, NINP, G, bid);
        EpiP1 E{CKV, CQ, KMLA, GA, DQ, DK, DV, GD, MG, SSKV, SSQ, CS16, CS8, rep == 0};
        pg8::gemm_phase<EpiP1, pg8::StaticOrder, true, true>(ldsp, g, S, E, wave);
    }
    grid.sync();

    for (int rep = 0; rep < REP2; ++rep) {
    if (PHMASK & (1 << 3)) {
        pg8::Gemm g{CQ, WUQ, MLAT, 768, 384}; pg8::StaticOrder S; S.init(MLAT, 768, G, bid);
        EpiQ E{QMLA, SSQ, CS8};
        pg8::gemm_phase<EpiQ, pg8::StaticOrder, true, true>(ldsp, g, S, E, wave);
    }
    if (PHMASK & (1 << 4)) {
        pg8::Gemm g{CKV, WUKV, MALL, 1024, 256}; pg8::StaticOrder S; S.init(MALL, 1024, G, bid);
        EpiKV E{KMLA, VMLA, SSKV};
        pg8::gemm_phase<EpiKV, pg8::StaticOrder, true, true>(ldsp, g, S, E, wave);
    }
    }
    grid.sync();

    if (PHMASK & (3 << 5)) {
        float lam;
        { LANE_TID
        { const float s1 = wave_sum(a.dlam[lane] * a.dlam[64 + lane]), s2 = wave_sum(a.dlam[128 + lane] * a.dlam[192 + lane]); lam = __builtin_bit_cast(float, __builtin_amdgcn_readfirstlane(__builtin_bit_cast(int, __expf(s1) - __expf(s2) + 0.2f))); } }
        int grp;
        { LANE_TID
          int* tab = (int*)(lds + 92160); const int simd = (__builtin_amdgcn_s_getreg((1 << 11) | (4 << 6) | 4)) & 3;
          __syncthreads(); if (lane == 0) tab[wave] = simd; __syncthreads();
          int cnt = 0;
#pragma unroll
          for (int w = 0; w < 8; ++w) cnt += (w < wave && tab[w] == simd) ? 1 : 0;
          grp = __builtin_amdgcn_readfirstlane(cnt > 0 ? 1 : 0); asm volatile("" : "+s"(grp)); __syncthreads(); }
        const int nrounds = (NB * 12 * 32 + G - 1) / G;
        for (int rdx = 0; rdx < nrounds + REP3A * 8 + REP3D * 4; ++rdx) {
            const int rd = rdx < nrounds ? rdx : (rdx - nrounds < REP3A * 8 ? (rdx - nrounds) & 7 : 8 + ((rdx - nrounds - REP3A * 8) & 3));
            int b, hs, qb;
            { const int idx = rd * G + bid; if (idx >= NB * 12 * 32) break; b = idx & 7; qb = (idx >> 3) & 31; hs = idx >> 8; }
            const size_t qrow0 = (size_t)b * SEQ + qb * 256, krow0 = (size_t)b * SKV;
            __syncthreads();
            if (hs < 8) { if (PHMASK & (1 << 5)) {
                f32x16 o[2];
                att::attn_core<true>(QMLA + qrow0 * 768 + hs * 96, KMLA + krow0 * 768 + hs * 96, VMLA + krow0 * 512 + hs * 64, SKV, (char*)lds, o, wave, grp);
                LANE_TID
                const int r32 = lane & 31, hi = lane >> 5;
                char* T = (char*)lds + 92160 + wave * 8192; char* tw = T + hi * 512 + r32 * 2;
#pragma unroll
                for (int r = 0; r < 16; ++r)
#pragma unroll
                    for (int d0 = 0; d0 < 2; ++d0) *(bf16_t*)(tw + ((r & 3) + 8 * (r >> 2)) * 128 + d0 * 64) = (bf16_t)cvtpk(o[d0][r], o[d0][r]);
#pragma unroll
                for (int j = 0; j < 4; ++j) { const int id = j * 64 + lane, row = id >> 3, c8 = id & 7;
                    const u32x4 t = *(const u32x4*)(T + id * 16);
                    const size_t go = (qrow0 + wave * 32 + row) * 512 + hs * 64 + c8 * 8; const u32x4 g = *(const u32x4*)(GA + go);
                    u32x4 w; w.x = cvtpk(bflo(t.x) * bflo(g.x), bfhi(t.x) * bfhi(g.x)); w.y = cvtpk(bflo(t.y) * bflo(g.y), bfhi(t.y) * bfhi(g.y));
                    w.z = cvtpk(bflo(t.z) * bflo(g.z), bfhi(t.z) * bfhi(g.z)); w.w = cvtpk(bflo(t.w) * bflo(g.w), bfhi(t.w) * bfhi(g.w));
                    *(u32x4*)(XA + go) = w; }
            } } else if (PHMASK & (1 << 6)) {
                const int h = hs - 8;
                f32x16 o[4];
                att::attn_core<false>(DQ + qrow0 * 512 + h * 128, DK + krow0 * 512 + h * 128, DV + krow0 * 512 + h * 128, SKV, (char*)lds, o, wave, grp);
                { unsigned* stash = (unsigned*)(lds + 92160 + wave * 8192) + lane_id_v();
#pragma unroll
                for (int d0 = 0; d0 < 4; ++d0)
#pragma unroll
                    for (int r = 0; r < 16; r += 2) stash[(d0 * 8 + (r >> 1)) * 64] = cvtpk(o[d0][r], o[d0][r + 1]); }
                att::attn_core<false>(DQ + qrow0 * 512 + h * 128 + 64, DK + krow0 * 512 + h * 128 + 64, DV + krow0 * 512 + h * 128, SKV, (char*)lds, o, wave, grp);
                LANE_TID
                const int r32 = lane & 31, hi = lane >> 5;
                unsigned* stash = (unsigned*)(lds + 92160 + wave * 8192) + lane;
#pragma unroll
                for (int d0 = 0; d0 < 4; ++d0)
#pragma unroll
                    for (int r = 0; r < 16; r += 2) { const unsigned w = stash[(d0 * 8 + (r >> 1)) * 64];
                        o[d0][r] = bflo(w) - lam * o[d0][r]; o[d0][r + 1] = bfhi(w) - lam * o[d0][r + 1]; }
                asm volatile("s_waitcnt lgkmcnt(0)" ::: "memory"); SBAR();
                char* T = (char*)lds + 92160 + wave * 8192; char* tw = T + hi * 1024 + r32 * 2;
#pragma unroll
                for (int r = 0; r < 16; ++r)
#pragma unroll
                    for (int d0 = 0; d0 < 4; ++d0) *(bf16_t*)(tw + ((r & 3) + 8 * (r >> 2)) * 256 + d0 * 64) = (bf16_t)cvtpk(o[d0][r], o[d0][r]);
                const int c16 = lane & 15;
                const f32x4 sw0 = *(const f32x4*)(a.subln + c16 * 8), sw1 = *(const f32x4*)(a.subln + c16 * 8 + 4);
#pragma unroll
                for (int j = 0; j < 8; ++j) { const int id = j * 64 + lane, row = id >> 4;
                    const u32x4 t = *(const u32x4*)(T + id * 16);
                    float e[8] = {bflo(t.x), bfhi(t.x), bflo(t.y), bfhi(t.y), bflo(t.z), bfhi(t.z), bflo(t.w), bfhi(t.w)};
                    float ss = 0.f;
#pragma unroll
                    for (int k = 0; k < 8; ++k) ss += e[k] * e[k];
                    ss += shflx(ss, 1); ss += shflx(ss, 2); ss += shflx(ss, 4); ss += shflx(ss, 8);
                    const float rs = 0.8f / sqrtf(ss * (1.f / 128.f) + 1e-5f);
                    const size_t go = (qrow0 + wave * 32 + row) * 512 + h * 128 + c16 * 8; const u32x4 g = *(const u32x4*)(GD + go);
                    u32x4 w; w.x = cvtpk(e[0] * rs * sw0[0] * bflo(g.x), e[1] * rs * sw0[1] * bfhi(g.x)); w.y = cvtpk(e[2] * rs * sw0[2] * bflo(g.y), e[3] * rs * sw0[3] * bfhi(g.y));
                    w.z = cvtpk(e[4] * rs * sw1[0] * bflo(g.z), e[5] * rs * sw1[1] * bfhi(g.z)); w.w = cvtpk(e[6] * rs * sw1[2] * bflo(g.w), e[7] * rs * sw1[3] * bfhi(g.w));
                    *(u32x4*)(XD + go) = w; }
            }
        }
    }
    grid.sync();

    for (int rep = 0; rep < REP4A; ++rep) {
    if (PHMASK & (1 << 7)) {
        pg8::Gemm g{XA, WOA, MLAT, 1024, 512}; pg8::StaticOrder S; S.init(MLAT, 1024, G, bid);
        EpiZ<false> E{Z, MG};
        pg8::gemm_phase<EpiZ<false>, pg8::StaticOrder, true, true>(ldsp, g, S, E, wave);
    }
    if (PHMASK & (1 << 8)) {
        pg8::Gemm g{XD, WOB, MLAT, 1024, 512}; pg8::StaticOrder S; S.init(MLAT, 1024, G, bid);
        EpiZ<true> E{Z, MG + 1024};
        pg8::gemm_phase<EpiZ<true>, pg8::StaticOrder, true, true>(ldsp, g, S, E, wave);
    }
    }
    grid.sync();

    if (PHMASK & (1 << 9)) for (int rep = 0; rep < REP4B; ++rep) {
        pg8::Gemm g{Z, WOUT, MLAT, 1024, 1024}; pg8::StaticOrder S; S.init(MLAT, 1024, G, bid);
        EpiOut E{a.out, a.x, MOD};
        pg8::gemm_phase<EpiOut, pg8::StaticOrder, true, true>(ldsp, g, S, E, wave);
    }
    grid.sync();

    if (PHMASK & (1 << 10)) for (int m = gw; m < MLAT; m += NGW) {
        LANE_TID
        f32x4* rowp = (f32x4*)(a.out + (size_t)m * 1024) + lane;
        f32x4 v[4]; float s = 0.f;
#pragma unroll
        for (int j = 0; j < 4; ++j) { v[j] = rowp[64 * j]; s += (v[j][0] + v[j][1]) + (v[j][2] + v[j][3]); }
        const float mean = wave_sum(s) * (1.f / 1024.f); float s2 = 0.f;
#pragma unroll
        for (int j = 0; j < 4; ++j) { v[j] = v[j] - mean; s2 += (v[j][0] * v[j][0] + v[j][1] * v[j][1]) + (v[j][2] * v[j][2] + v[j][3] * v[j][3]); }
        const float rstd = 1.f / sqrtf(wave_sum(s2) * (1.f / 1024.f) + 1e-5f);
#pragma unroll
        for (int j = 0; j < 4; ++j) { const f32x4 g = ((const f32x4*)a.ln_g)[lane + 64 * j], bb = ((const f32x4*)a.ln_b)[lane + 64 * j]; rowp[64 * j] = v[j] * rstd * g + bb; }
    }
}

extern "C" void kernel_launch(void* const* d_in, const int* in_sizes, int n_in, void* d_out, int out_size, void* d_ws, size_t ws_size, hipStream_t stream) {
    static int grid = 0;
    if (grid == 0) {
        if (n_in != 18 || in_sizes[0] != MLAT * DM || out_size != MLAT * DM || ws_size < WS_END) {
            fprintf(stderr, "kernel_launch: shape/workspace mismatch: n_in %d in0 %d out %d ws %zu (need %zu)\n", n_in, n_in > 0 ? in_sizes[0] : -1, out_size, ws_size, (size_t)WS_END); grid = -1; return; }
        int dev = 0, cus = 0, per_cu = 0;
        hipGetDevice(&dev); hipDeviceGetAttribute(&cus, hipDeviceAttributeMultiprocessorCount, dev);
        if (hipFuncSetAttribute((const void*)fwd_mega, hipFuncAttributeMaxDynamicSharedMemorySize, LDS_BYTES) != hipSuccess) { fprintf(stderr, "kernel_launch: hipFuncSetAttribute failed\n"); grid = -1; return; }
        if (hipOccupancyMaxActiveBlocksPerMultiprocessor(&per_cu, (const void*)fwd_mega, 512, LDS_BYTES) != hipSuccess || per_cu < 1) { fprintf(stderr, "kernel_launch: occupancy query gave %d\n", per_cu); per_cu = 1; }
        (void)hipGetLastError();
        grid = cus * 1;
    }
    if (grid < 0) return;
    Args a{};
    a.x = (const float*)d_in[0]; a.c = (const float*)d_in[1]; a.ctx = (const float*)d_in[2]; a.c_ctx = (const float*)d_in[3]; a.w_mod = (const float*)d_in[4]; a.b_mod = (const float*)d_in[5];
    a.w_in = (const float*)d_in[6]; a.q_norm = (const float*)d_in[7]; a.kv_norm = (const float*)d_in[8]; a.w_uq = (const float*)d_in[9]; a.w_ukv = (const float*)d_in[10];
    a.dlam = (const float*)d_in[11]; a.subln = (const float*)d_in[12]; a.w_oa = (const float*)d_in[13]; a.w_ob = (const float*)d_in[14]; a.w_out = (const float*)d_in[15];
    a.ln_g = (const float*)d_in[16]; a.ln_b = (const float*)d_in[17]; a.out = (float*)d_out; a.ws = (unsigned char*)d_ws;
    void* args[] = {&a};
    hipError_t e = hipLaunchCooperativeKernel((const void*)fwd_mega, dim3(grid), dim3(512), args, LDS_BYTES, stream);
    if (e != hipSuccess) fprintf(stderr, "kernel_launch: cooperative launch failed: %s (grid %d)\n", hipGetErrorString(e), grid);
}
```

```cpp
#include <hip/hip_runtime.h>
#include <hip/hip_cooperative_groups.h>
#include <cstdio>
#include <cstdint>
namespace cg = cooperative_groups;
__device__ __forceinline__ int opq(int v) { asm volatile("" : "+v"(v)); return v; }
__device__ __forceinline__ int lane_id_v() { int l; asm volatile("v_mbcnt_lo_u32_b32 %0, -1, 0\n\tv_mbcnt_hi_u32_b32 %0, -1, %0" : "=v"(l)); return l; }
__device__ __forceinline__ float shflx(float v, int mask) { return __builtin_bit_cast(float, __builtin_amdgcn_ds_bpermute((lane_id_v() ^ mask) << 2, __builtin_bit_cast(int, v))); }
__device__ __forceinline__ float shfli(float v, int idx4) { return __builtin_bit_cast(float, __builtin_amdgcn_ds_bpermute(idx4, __builtin_bit_cast(int, v))); }
namespace pg8 {
#define PG8_LAS __attribute__((address_space(3)))
typedef unsigned short bf16_t;
typedef short bf16x8 __attribute__((ext_vector_type(8)));
typedef float f32x4 __attribute__((ext_vector_type(4)));
typedef unsigned u32x4 __attribute__((ext_vector_type(4)));
constexpr int BM = 256, BK = 64, HALF = 128, HTB = HALF * BK * 2  , STAGE_BYTES = 8 * HTB, NXCD = 8, WGM = 8;

__host__ __device__ __forceinline__ int lds_byte(int r, int c) { const int st = (r >> 4) * 2 + (c >> 5), rr = r & 15, cc = c & 31, ob = rr * 64 + cc * 2; return st * 1024 + (ob ^ (((ob >> 9) & 1) << 5)); }
__host__ __device__ __forceinline__ void stage_rc(int b, int& R, int& C) { const int st = b / 1024, sb = b % 1024, swz = sb ^ (((sb >> 9) & 1) << 5); R = (st >> 1) * 16 + swz / 64; C = (st & 1) * 32 + (swz % 64) / 2; }
__host__ __device__ __forceinline__ int perm32(int rho) { const int n = rho >> 4, i = rho & 15; return 8 * (i >> 2) + 4 * n + (i & 3); }

struct Unit { int pm, pn; };
struct Gemm { const bf16_t* A; const bf16_t* Bt; int M, N, K; };

struct StaticOrder {
    int nM, nN, nwg, G, c;
    __host__ __device__ void init(int M, int N, int G_, int c_) { nM = M / BM; nN = N / BM; nwg = nM * nN; G = G_; c = c_; }
    __host__ __device__ bool next(int i, Unit& u) const {
        const long L = (long)i * G + c; if (L >= nwg) return false;
        int wgid = (int)L; { const int q = nwg / NXCD, r = nwg % NXCD, xcd = wgid % NXCD, off = wgid / NXCD; wgid = (xcd < r ? xcd * (q + 1) : r * (q + 1) + (xcd - r) * q) + off; }
        const int nig = WGM * nN, gid = wgid / nig, fm = gid * WGM, gsz = (nM - fm) < WGM ? (nM - fm) : WGM;
        u.pm = fm + ((wgid % nig) % gsz); u.pn = (wgid % nig) / gsz; return true;
    }
    __device__ __forceinline__ void a_ready(const Unit&) const {}
    __device__ __forceinline__ void done(const Unit&) const {}
};

template <class Epi, class Sched, bool ALIGN_EPI = false, bool SP2 = false>
__device__ __forceinline__ void gemm_phase(PG8_LAS unsigned char* lds, const Gemm g, const Sched& S, const Epi& E, const int wid  ) {
    const int lane = lane_id_v(), tid = wid * 64 + lane, wr = wid >> 2, wc = wid & 3, fr = lane & 15, fq = lane >> 4;
    const int K = g.K, nt = K / BK;
    unsigned voffA[2], voffB[2];
#pragma unroll
    for (int i = 0; i < 2; ++i) { int R, C; stage_rc(tid * 16 + i * 8192, R, C); const int Rb = Epi::PERM ? ((R & ~31) + perm32(R & 31)) : R;
        voffA[i] = (unsigned)(R * K + C) * 2u; voffB[i] = (unsigned)(Rb * K + C) * 2u; }
    const size_t kstep = (size_t)(BK * 2);
    const size_t hstep = (size_t)HALF * K * 2;
    const size_t tstep = 2 * hstep;
    const unsigned ldsw = (unsigned)wid * 1024u;
    const int aoff = lds_byte(wr * 64 + fr, fq * 8), boff = lds_byte(wc * 32 + fr, fq * 8);
#define PG8_SA(b, h) (((b) * 2 + (h)) * HTB)
#define PG8_SB(b, h) ((4 + (b) * 2 + (h)) * HTB)
#define PG8_STAGE(bufoff, gbase, voff) do { _Pragma("unroll") for (int _i = 0; _i < 2; ++_i) \
        __builtin_amdgcn_global_load_lds((const unsigned*)((const char*)(gbase) + (voff)[_i]), (PG8_LAS unsigned*)(lds + (bufoff) + ldsw + _i * 8192), 16, 0, 0); } while (0)
#define PG8_LDA(dst, b, h) do { _Pragma("unroll") for (int m = 0; m < 4; ++m) _Pragma("unroll") for (int k = 0; k < 2; ++k) dst[m][k] = *(const PG8_LAS bf16x8*)(lds + PG8_SA(b, h) + aoff + m * 2048 + k * 1024); } while (0)
#define PG8_LDB(dst, b, h) do { _Pragma("unroll") for (int n = 0; n < 2; ++n) _Pragma("unroll") for (int k = 0; k < 2; ++k) dst[n][k] = *(const PG8_LAS bf16x8*)(lds + PG8_SB(b, h) + boff + n * 2048 + k * 1024); } while (0)
#define PG8_MMA(ai, bj, At, Bt) do { __builtin_amdgcn_s_setprio(1); _Pragma("unroll") for (int m = 0; m < 4; ++m) _Pragma("unroll") for (int n = 0; n < 2; ++n) _Pragma("unroll") for (int k = 0; k < 2; ++k) \
        acc[ai][bj][m][n] = __builtin_amdgcn_mfma_f32_16x16x32_bf16(Bt[n][k], At[m][k], acc[ai][bj][m][n], 0, 0, 0); __builtin_amdgcn_s_setprio(0); } while (0)
#define PG8_WAIT_V(n) asm volatile("s_waitcnt vmcnt(" #n ")" ::: "memory")
#define PG8_WAIT_L(n) asm volatile("s_waitcnt lgkmcnt(" #n ")" ::: "memory")
#define PG8_BAR __builtin_amdgcn_s_barrier()
#define PG8_SCHED __builtin_amdgcn_sched_barrier(0)
    Unit cur, nxt; int ui = 0;
    if (!S.next(0, cur)) return;
    f32x4 acc[2][2][4][2];
#pragma unroll
    for (int a = 0; a < 2; ++a)
#pragma unroll
        for (int b = 0; b < 2; ++b)
#pragma unroll
            for (int m = 0; m < 4; ++m)
#pragma unroll
                for (int n = 0; n < 2; ++n) acc[a][b][m][n] = (f32x4){0.f, 0.f, 0.f, 0.f};
    bf16x8 At[4][2], B0[2][2], B1[2][2];
    const char* cA = (const char*)g.A + (size_t)cur.pm * tstep; const char* cB = (const char*)g.Bt + (size_t)cur.pn * tstep;
    S.a_ready(cur);
    if constexpr (SP2) {
        PG8_STAGE(PG8_SB(0, 0), cB, voffB); PG8_STAGE(PG8_SB(0, 1), cB + hstep, voffB); PG8_STAGE(PG8_SA(0, 0), cA, voffA); PG8_STAGE(PG8_SA(0, 1), cA + hstep, voffA);
        if (wr == 1) PG8_BAR;
        PG8_WAIT_V(2); PG8_BAR;
        PG8_STAGE(PG8_SB(1, 0), cB + kstep, voffB); PG8_STAGE(PG8_SA(1, 0), cA + kstep, voffA); PG8_STAGE(PG8_SB(1, 1), cB + hstep + kstep, voffB);
        PG8_WAIT_V(6); PG8_BAR;
    } else {
        PG8_STAGE(PG8_SB(0, 0), cB, voffB); PG8_STAGE(PG8_SA(0, 0), cA, voffA); PG8_STAGE(PG8_SB(0, 1), cB + hstep, voffB); PG8_STAGE(PG8_SA(0, 1), cA + hstep, voffA);
        if (wr == 1) PG8_BAR;
        PG8_WAIT_V(4); PG8_BAR;
        PG8_STAGE(PG8_SB(1, 0), cB + kstep, voffB); PG8_STAGE(PG8_SA(1, 0), cA + kstep, voffA); PG8_STAGE(PG8_SB(1, 1), cB + hstep + kstep, voffB);
        PG8_WAIT_V(6); PG8_BAR;
    }
    for (;;) {
        const bool has_next = S.next(ui + 1, nxt);
        const char* nA = has_next ? (const char*)g.A + (size_t)nxt.pm * tstep : cA; const char* nB = has_next ? (const char*)g.Bt + (size_t)nxt.pn * tstep : cB;
        for (int t = 0; t < nt; t += 2) {
            const bool last = (t == nt - 2);
            const char* a1 = cA + (size_t)(t + 1) * kstep;
            const char* a2 = last ? nA : cA + (size_t)(t + 2) * kstep; const char* b2 = last ? nB : cB + (size_t)(t + 2) * kstep;
            const char* a3 = a2 + kstep; const char* b3 = b2 + kstep;
            if (last && has_next) S.a_ready(nxt);
            if constexpr (SP2) {
            PG8_LDB(B0, 0, 0); PG8_LDB(B1, 0, 1); PG8_SCHED; PG8_LDA(At, 0, 0); PG8_STAGE(PG8_SA(1, 1), a1 + hstep, voffA);
            PG8_WAIT_V(8); PG8_WAIT_L(0); PG8_BAR; PG8_MMA(0, 0, At, B0); PG8_MMA(0, 1, At, B1); PG8_BAR; PG8_SCHED;
            PG8_LDA(At, 0, 1); PG8_STAGE(PG8_SB(0, 0), b2, voffB); PG8_STAGE(PG8_SB(0, 1), b2 + hstep, voffB); PG8_STAGE(PG8_SA(0, 0), a2, voffA);
            PG8_WAIT_V(8); PG8_WAIT_L(0); PG8_BAR; PG8_MMA(1, 0, At, B0); PG8_MMA(1, 1, At, B1); PG8_BAR; PG8_SCHED;
            PG8_LDB(B0, 1, 0); PG8_LDB(B1, 1, 1); PG8_SCHED; PG8_LDA(At, 1, 0); PG8_STAGE(PG8_SA(0, 1), a2 + hstep, voffA);
            PG8_WAIT_V(8); PG8_WAIT_L(0); PG8_BAR; PG8_MMA(0, 0, At, B0); PG8_MMA(0, 1, At, B1); PG8_BAR; PG8_SCHED;
            PG8_LDA(At, 1, 1); PG8_STAGE(PG8_SB(1, 0), b3, voffB); PG8_STAGE(PG8_SB(1, 1), b3 + hstep, voffB); PG8_STAGE(PG8_SA(1, 0), a3, voffA);
            PG8_WAIT_V(8); PG8_WAIT_L(0); PG8_BAR; PG8_MMA(1, 0, At, B0); PG8_MMA(1, 1, At, B1); PG8_BAR; PG8_SCHED;
            } else {
            PG8_LDB(B0, 0, 0); PG8_SCHED; PG8_LDA(At, 0, 0); PG8_STAGE(PG8_SA(1, 1), a1 + hstep, voffA);
            PG8_WAIT_L(8); PG8_BAR; PG8_WAIT_L(0); PG8_MMA(0, 0, At, B0); PG8_BAR; PG8_SCHED;
            PG8_LDB(B1, 0, 1); PG8_STAGE(PG8_SB(0, 0), b2, voffB);
            PG8_BAR; PG8_WAIT_L(0); PG8_MMA(0, 1, At, B1); PG8_BAR;
            PG8_LDA(At, 0, 1); PG8_STAGE(PG8_SA(0, 0), a2, voffA);
            PG8_BAR; PG8_WAIT_L(0); PG8_MMA(1, 0, At, B0); PG8_BAR; PG8_SCHED;
            PG8_STAGE(PG8_SB(0, 1), b2 + hstep, voffB);
            PG8_WAIT_V(6); PG8_BAR; PG8_MMA(1, 1, At, B1); PG8_BAR;
            PG8_LDB(B0, 1, 0); PG8_SCHED; PG8_LDA(At, 1, 0); PG8_STAGE(PG8_SA(0, 1), a2 + hstep, voffA);
            PG8_WAIT_L(8); PG8_BAR; PG8_WAIT_L(0); PG8_MMA(0, 0, At, B0); PG8_BAR; PG8_SCHED;
            PG8_LDB(B1, 1, 1); PG8_STAGE(PG8_SB(1, 0), b3, voffB);
            PG8_BAR; PG8_WAIT_L(0); PG8_MMA(0, 1, At, B1); PG8_BAR;
            PG8_LDA(At, 1, 1); PG8_STAGE(PG8_SA(1, 0), a3, voffA);
            PG8_BAR; PG8_WAIT_L(0); PG8_MMA(1, 0, At, B0); PG8_BAR; PG8_SCHED;
            PG8_STAGE(PG8_SB(1, 1), b3 + hstep, voffB);
            PG8_WAIT_V(6); PG8_BAR; PG8_MMA(1, 1, At, B1); PG8_BAR;
            }
        }
        if constexpr (ALIGN_EPI) { if (wr == 0) PG8_BAR; }
        if constexpr (!Epi::AFTER_DRAIN) { E(acc, cur, wr, wc, fr, fq); S.done(cur); }
        if (!has_next) break;
#pragma unroll
        for (int a = 0; a < 2; ++a)
#pragma unroll
            for (int b = 0; b < 2; ++b)
#pragma unroll
                for (int m = 0; m < 4; ++m)
#pragma unroll
                    for (int n = 0; n < 2; ++n) acc[a][b][m][n] = (f32x4){0.f, 0.f, 0.f, 0.f};
        cur = nxt; cA = nA; cB = nB; ++ui;
        if constexpr (ALIGN_EPI) { if (wr == 1) PG8_BAR; }
    }
    PG8_WAIT_V(0);
    if constexpr (!ALIGN_EPI) { if (wr == 0) PG8_BAR; }
    PG8_BAR;
    if constexpr (Epi::AFTER_DRAIN) { E.fused(acc, cur, wr, wc, fr, fq, lds, wid, lane); S.done(cur); }
#undef PG8_SA
#undef PG8_SB
#undef PG8_STAGE
#undef PG8_LDA
#undef PG8_LDB
#undef PG8_MMA
#undef PG8_WAIT_V
#undef PG8_WAIT_L
#undef PG8_BAR
#undef PG8_SCHED
}
}
constexpr int DM = 1024, NB = 8, SEQ = 8192, CTX = 256, SKV = SEQ + CTX;
constexpr int MLAT = NB * SEQ, MALL = MLAT + NB * CTX;
constexpr int NINP = 5376;
typedef unsigned short bf16_t;
typedef short bf16x8 __attribute__((ext_vector_type(8)));
typedef short s16x4 __attribute__((ext_vector_type(4)));
typedef float f32x16 __attribute__((ext_vector_type(16)));
typedef float f32x4 __attribute__((ext_vector_type(4)));
typedef unsigned u32x4 __attribute__((ext_vector_type(4)));
typedef unsigned u32x2 __attribute__((ext_vector_type(2)));
#define LAS __attribute__((address_space(3)))
#define SBAR() __builtin_amdgcn_sched_barrier(0)
typedef float f32x2_t __attribute__((ext_vector_type(2)));
typedef __bf16 bf16x2_t __attribute__((ext_vector_type(2)));
__device__ __forceinline__ unsigned cvtpk(float lo, float hi) { f32x2_t v = {lo, hi}; bf16x2_t b = __builtin_convertvector(v, bf16x2_t); return __builtin_bit_cast(unsigned, b); }
__device__ __forceinline__ unsigned cvtpk_a(float lo, float hi) { unsigned r; asm volatile("v_cvt_pk_bf16_f32 %0, %1, %2" : "=v"(r) : "v"(lo), "v"(hi)); return r; }
__device__ __forceinline__ unsigned f2bf(float f) { unsigned u = __builtin_bit_cast(unsigned, f); return (u + 0x7fffu + ((u >> 16) & 1u)) >> 16; }
__device__ __forceinline__ float bf2f(unsigned short b) { return __builtin_bit_cast(float, (unsigned)b << 16); }
__device__ __forceinline__ float bflo(unsigned w) { return __builtin_bit_cast(float, w << 16); }
__device__ __forceinline__ float bfhi(unsigned w) { return __builtin_bit_cast(float, w & 0xffff0000u); }
__device__ __forceinline__ float sigmoidf_(float v) { return 1.f / (1.f + __expf(-v)); }
__device__ __forceinline__ float sigmoid_fast(float v) { return __builtin_amdgcn_rcpf(1.f + __builtin_amdgcn_exp2f(-1.4426950408889634f * v)); }
__device__ __forceinline__ float wave_sum(float v) {
#pragma unroll
    for (int o = 1; o < 64; o <<= 1) v += shflx(v, o);
    return v;
}

namespace att {
#ifndef PROBE_NOLOAD
#define PROBE_NOLOAD 0
#endif
template <bool MLA> struct Cfg {
    static constexpr int DQK = MLA ? 96 : 64, DV = MLA ? 64 : 128, NQ = DQK / 16, NCB = DV / 32;
    static constexpr int KROWB = MLA ? 256 : 128;
    static constexpr int LDQ = MLA ? 768 : 512, LDK = MLA ? 768 : 512, LDV = 512;
    static constexpr int SHM_V = 64 * DV * 2, SHM_K = 64 * KROWB;
};
constexpr float THR = 8.f;
__device__ __forceinline__ int crow(int r, int hi) { return (r & 3) + 8 * (r >> 2) + 4 * hi; }
template <bool MLA> __device__ __forceinline__ int kswz(int row, int colB) {
    if constexpr (MLA) return row * 256 + (colB ^ ((row & 15) << 4));
    else return row * 128 + (colB ^ (((row >> 1) & 7) << 4));
}
__device__ __forceinline__ float max3f(float a, float b, float c) { float r; asm("v_max3_f32 %0, %1, %2, %3" : "=v"(r) : "v"(a), "v"(b), "v"(c)); return r; }
__device__ __forceinline__ void rowmax_adjust(f32x16& p0, f32x16& p1, float& m2, f32x16& negm, float& alpha, const bool first) {
    constexpr float THR2 = THR * 1.4426950408889634f;
    float pmax = max3f(p0[0], p0[1], p0[2]);
#pragma unroll
    for (int r = 3; r < 15; r += 2) pmax = max3f(pmax, p0[r], p0[r + 1]);
    pmax = max3f(pmax, p0[15], p1[0]);
#pragma unroll
    for (int r = 1; r < 15; r += 2) pmax = max3f(pmax, p1[r], p1[r + 1]);
    pmax = fmaxf(pmax, p1[15]);
    { auto rr = __builtin_amdgcn_permlane32_swap(__float_as_uint(pmax), __float_as_uint(pmax), false, false);
      pmax = fmaxf(__uint_as_float(rr[0]), __uint_as_float(rr[1])); }
    if (!first && __builtin_expect(__all(pmax <= THR2), 1)) { alpha = 1.f; }
    else {
        const float delta = first ? pmax : fmaxf(pmax, 0.f);
        alpha = first ? 1.f : __builtin_amdgcn_exp2f(-delta);
        m2 += delta;
#pragma unroll
        for (int r = 0; r < 16; ++r) { p0[r] -= delta; p1[r] -= delta; }
        const float nm = -m2;
#pragma unroll
        for (int r = 0; r < 16; ++r) negm[r] = nm;
    }
}
__device__ __forceinline__ float exp_pack(f32x16& p0, f32x16& p1, bf16x8& pa0, bf16x8& pa1, bf16x8& pa2, bf16x8& pa3) {
#pragma unroll
    for (int r = 0; r < 16; ++r) p0[r] = __builtin_amdgcn_exp2f(p0[r]);
#pragma unroll
    for (int r = 0; r < 16; ++r) p1[r] = __builtin_amdgcn_exp2f(p1[r]);
    SBAR(); asm volatile("s_nop 1" ::: "memory"); SBAR();
#define PK4(P, BASE, OUT) do { unsigned a0 = cvtpk_a(P[BASE + 0], P[BASE + 1]), a1 = cvtpk_a(P[BASE + 2], P[BASE + 3]);   \
    unsigned b0 = cvtpk_a(P[BASE + 4], P[BASE + 5]), b1 = cvtpk_a(P[BASE + 6], P[BASE + 7]);                              \
    auto r0 = __builtin_amdgcn_permlane32_swap(a0, b0, false, false); auto r1 = __builtin_amdgcn_permlane32_swap(a1, b1, false, false); \
    u32x4 w = {r0[0], r1[0], r0[1], r1[1]}; OUT = *reinterpret_cast<bf16x8*>(&w); } while (0)
    PK4(p0, 0, pa0); PK4(p0, 8, pa1); PK4(p1, 0, pa2); PK4(p1, 8, pa3);
#undef PK4
    float ps0 = 0.f, ps1 = 0.f;
#pragma unroll
    for (int r = 0; r < 16; ++r) { ps0 += p0[r]; ps1 += p1[r]; }
    float ps = ps0 + ps1;
    { auto rr = __builtin_amdgcn_permlane32_swap(__float_as_uint(ps), __float_as_uint(ps), false, false);
      ps = __uint_as_float(rr[0]) + __uint_as_float(rr[1]); }
    return ps;
}
template <bool MLA> __device__ __forceinline__ void qkt(f32x16& p0, f32x16& p1, const char* Ks, const bf16x8* qr, const f32x16& negm, int r32, int hi) {
    constexpr int NQ = Cfg<MLA>::NQ;
    bf16x8 kf[2 * NQ];
#pragma unroll
    for (int d0 = 0; d0 < NQ; ++d0) { const int cb = (d0 * 16 + hi * 8) * 2;
        kf[2 * d0] = *reinterpret_cast<const bf16x8*>(Ks + kswz<MLA>(r32, cb));
        kf[2 * d0 + 1] = *reinterpret_cast<const bf16x8*>(Ks + kswz<MLA>(32 + r32, cb)); }
    SBAR();
    p0 = negm; p1 = negm;
#pragma unroll
    for (int d0 = 0; d0 < NQ; ++d0) {
        p0 = __builtin_amdgcn_mfma_f32_32x32x16_bf16(kf[2 * d0], qr[d0], p0, 0, 0, 0);
        p1 = __builtin_amdgcn_mfma_f32_32x32x16_bf16(kf[2 * d0 + 1], qr[d0], p1, 0, 0, 0); }
}
template <int NCB> __device__ __forceinline__ int v_st(int k, int c) { const int kk = (k & ~0xC) | ((k & 4) << 1) | ((k & 8) >> 1); return ((kk >> 3) * NCB + (c >> 5)) * 512 + ((kk & 7) * 32 + (c & 31)) * 2; }
__device__ __forceinline__ int v_rd_base(int lane) { return ((lane & 3) << 3) | (((lane >> 2) & 3) << 6) | (((lane >> 4) & 1) << 5) | (((lane >> 5) & 1) << 8); }
template <int NCB> constexpr int v_rd_off(int d0, int ks, int half) { return d0 * 512 + (ks * 2 + half) * NCB * 512; }
template <int OFF> __device__ __forceinline__ s16x4 tr_read(int vb) {
    s16x4 r; asm volatile("ds_read_b64_tr_b16 %0, %1 offset:%2" : "=&v"(r) : "v"(vb), "i"(OFF) : "memory"); return r;
}
template <int NCB, int D0> __device__ __forceinline__ void pv_one(f32x16& od, int vb, bf16x8 pa0, bf16x8 pa1, bf16x8 pa2, bf16x8 pa3) {
    const s16x4 l0 = tr_read<v_rd_off<NCB>(D0, 0, 0)>(vb), h0 = tr_read<v_rd_off<NCB>(D0, 0, 1)>(vb), l1 = tr_read<v_rd_off<NCB>(D0, 1, 0)>(vb), h1 = tr_read<v_rd_off<NCB>(D0, 1, 1)>(vb);
    const s16x4 l2 = tr_read<v_rd_off<NCB>(D0, 2, 0)>(vb), h2 = tr_read<v_rd_off<NCB>(D0, 2, 1)>(vb), l3 = tr_read<v_rd_off<NCB>(D0, 3, 0)>(vb), h3 = tr_read<v_rd_off<NCB>(D0, 3, 1)>(vb);
    asm volatile("s_waitcnt lgkmcnt(0)" ::: "memory"); SBAR();
#define PK(L, H) (bf16x8){L[0], L[1], L[2], L[3], H[0], H[1], H[2], H[3]}
    od = __builtin_amdgcn_mfma_f32_32x32x16_bf16(pa0, PK(l0, h0), od, 0, 0, 0);
    od = __builtin_amdgcn_mfma_f32_32x32x16_bf16(pa1, PK(l1, h1), od, 0, 0, 0);
    od = __builtin_amdgcn_mfma_f32_32x32x16_bf16(pa2, PK(l2, h2), od, 0, 0, 0);
    od = __builtin_amdgcn_mfma_f32_32x32x16_bf16(pa3, PK(l3, h3), od, 0, 0, 0);
#undef PK
}
template <int NCB> __device__ __forceinline__ void pv_all(f32x16* o, int vb, bf16x8 pa0, bf16x8 pa1, bf16x8 pa2, bf16x8 pa3) {
    pv_one<NCB, 0>(o[0], vb, pa0, pa1, pa2, pa3); pv_one<NCB, 1>(o[1], vb, pa0, pa1, pa2, pa3);
    if constexpr (NCB == 4) { pv_one<NCB, 2>(o[2], vb, pa0, pa1, pa2, pa3); pv_one<NCB, 3>(o[3], vb, pa0, pa1, pa2, pa3); }
}

template <int NCB, int D0> __device__ __forceinline__ void v_frag_read(s16x4 (&f)[8], int vb) {
    f[0] = tr_read<v_rd_off<NCB>(D0, 0, 0)>(vb); f[1] = tr_read<v_rd_off<NCB>(D0, 0, 1)>(vb); f[2] = tr_read<v_rd_off<NCB>(D0, 1, 0)>(vb); f[3] = tr_read<v_rd_off<NCB>(D0, 1, 1)>(vb);
    f[4] = tr_read<v_rd_off<NCB>(D0, 2, 0)>(vb); f[5] = tr_read<v_rd_off<NCB>(D0, 2, 1)>(vb); f[6] = tr_read<v_rd_off<NCB>(D0, 3, 0)>(vb); f[7] = tr_read<v_rd_off<NCB>(D0, 3, 1)>(vb);
}
__device__ __forceinline__ void pv_mma(f32x16& od, const s16x4 (&f)[8], bf16x8 pa0, bf16x8 pa1, bf16x8 pa2, bf16x8 pa3) {
#define PK(L, H) (bf16x8){L[0], L[1], L[2], L[3], H[0], H[1], H[2], H[3]}
    od = __builtin_amdgcn_mfma_f32_32x32x16_bf16(pa0, PK(f[0], f[1]), od, 0, 0, 0);
    od = __builtin_amdgcn_mfma_f32_32x32x16_bf16(pa1, PK(f[2], f[3]), od, 0, 0, 0);
    od = __builtin_amdgcn_mfma_f32_32x32x16_bf16(pa2, PK(f[4], f[5]), od, 0, 0, 0);
    od = __builtin_amdgcn_mfma_f32_32x32x16_bf16(pa3, PK(f[6], f[7]), od, 0, 0, 0);
#undef PK
}
__device__ __forceinline__ void pv_mma2(f32x16& oa, f32x16& ob, const s16x4 (&f)[8], const s16x4 (&h)[8], bf16x8 pa0, bf16x8 pa1, bf16x8 pa2, bf16x8 pa3) {
#define PK(L, H) (bf16x8){L[0], L[1], L[2], L[3], H[0], H[1], H[2], H[3]}
    oa = __builtin_amdgcn_mfma_f32_32x32x16_bf16(pa0, PK(f[0], f[1]), oa, 0, 0, 0); ob = __builtin_amdgcn_mfma_f32_32x32x16_bf16(pa0, PK(h[0], h[1]), ob, 0, 0, 0);
    oa = __builtin_amdgcn_mfma_f32_32x32x16_bf16(pa1, PK(f[2], f[3]), oa, 0, 0, 0); ob = __builtin_amdgcn_mfma_f32_32x32x16_bf16(pa1, PK(h[2], h[3]), ob, 0, 0, 0);
    oa = __builtin_amdgcn_mfma_f32_32x32x16_bf16(pa2, PK(f[4], f[5]), oa, 0, 0, 0); ob = __builtin_amdgcn_mfma_f32_32x32x16_bf16(pa2, PK(h[4], h[5]), ob, 0, 0, 0);
    oa = __builtin_amdgcn_mfma_f32_32x32x16_bf16(pa3, PK(f[6], f[7]), oa, 0, 0, 0); ob = __builtin_amdgcn_mfma_f32_32x32x16_bf16(pa3, PK(h[6], h[7]), ob, 0, 0, 0);
#undef PK
}
#define LWAIT0() do { asm volatile("s_waitcnt lgkmcnt(0)" ::: "memory"); SBAR(); } while (0)
template <bool MLA>
__device__ __forceinline__ void attn_core(const bf16_t* __restrict__ Qb, const bf16_t* __restrict__ Kh, const bf16_t* __restrict__ Vh, int seq, char* lds,
                                          f32x16 (&o)[Cfg<MLA>::NCB], const int wid  , const int g  ) {
    using CF = Cfg<MLA>;
    constexpr int NQ = CF::NQ, NCB = CF::NCB, SHM_V = CF::SHM_V, SHM_K = CF::SHM_K, LDQ = CF::LDQ, LDK = CF::LDK, LDV = CF::LDV;
    const int lane = lane_id_v(), tid = wid * 64 + lane, r32 = lane & 31, hi = lane >> 5;
    char* V_lds = lds; char* K_lds = lds + 4 * SHM_V;
    float* wsp = (float*)(lds + 90112) + wid * 64; float* li_l = wsp; float* al_l = wsp + 32;
    float m2 = 0.f, l_reg = 0.f; f32x16 negm = f32x16{}; bf16x8 qr[NQ];
#pragma unroll
    for (int d = 0; d < NCB; ++d) o[d] = f32x16{};
    const bf16_t* Qw = Qb + (long)(wid * 32 + r32) * LDQ + hi * 8;
#pragma unroll
    for (int d0 = 0; d0 < NQ; ++d0) qr[d0] = *reinterpret_cast<const bf16x8*>(Qw + d0 * 16);
    const int vr0 = MLA ? (tid >> 3) : (tid >> 4), vc0 = MLA ? (tid & 7) * 8 : (tid & 15) * 8;
    const int vst0 = v_st<NCB>(vr0, vc0), vst1 = v_st<NCB>(32 + vr0, vc0);
    const int kcA = tid, krA = MLA ? (kcA / 12) : (tid >> 3), kcolA = MLA ? (kcA % 12) * 8 : (tid & 7) * 8;
    const int kcB = 512 + (tid & 255), krB = kcB / 12, kcolB = (kcB % 12) * 8;
    const int kstA = kswz<MLA>(krA, kcolA * 2), kstB = kswz<MLA>(krB, kcolB * 2);
    const int vb0 = (int)(uintptr_t)V_lds + v_rd_base(lane);
    struct { bf16x8 a, b, c; } sr_[2];
#define SLOAD(i, k0) do { if constexpr (MLA) { \
        sr_[i].a = *reinterpret_cast<const bf16x8*>(&Vh[(long)((k0) + vr0) * LDV + vc0]); \
        sr_[i].b = *reinterpret_cast<const bf16x8*>(&Kh[(long)((k0) + krA) * LDK + kcolA]); \
        sr_[i].c = *reinterpret_cast<const bf16x8*>(&Kh[(long)((k0) + krB) * LDK + kcolB]); \
    } else { \
        sr_[i].a = *reinterpret_cast<const bf16x8*>(&Vh[(long)((k0) + vr0) * LDV + vc0]); \
        sr_[i].b = *reinterpret_cast<const bf16x8*>(&Vh[(long)((k0) + 32 + vr0) * LDV + vc0]); \
        sr_[i].c = *reinterpret_cast<const bf16x8*>(&Kh[(long)((k0) + krA) * LDK + kcolA]); } } while (0)
#define SWRITE(ko, vo, i) do { if constexpr (MLA) { \
        *(bf16x8*)(V_lds + (vo) + vst0) = sr_[i].a; \
        *(bf16x8*)(K_lds + (ko) + kstA) = sr_[i].b; \
        if (wid < 4) *(bf16x8*)(K_lds + (ko) + kstB) = sr_[i].c; \
    } else { \
        *(bf16x8*)(V_lds + (vo) + vst0) = sr_[i].a; \
        *(bf16x8*)(V_lds + (vo) + vst1) = sr_[i].b; \
        *(bf16x8*)(K_lds + (ko) + kstA) = sr_[i].c; } } while (0)
#define SWAIT() asm volatile("s_waitcnt vmcnt(3)" ::: "memory")
#define RESC(a) do { if (__any((a) < 1.f)) { if (hi == 0) al_l[r32] = (a); asm volatile("s_waitcnt lgkmcnt(0)" ::: "memory"); \
    _Pragma("unroll") for (int r = 0; r < 16; ++r) { const float al_ = al_l[crow(r, hi)]; _Pragma("unroll") for (int d = 0; d < NCB; ++d) o[d][r] *= al_; } } } while (0)
    f32x16 S0, S1; float alpha = 1.f; bf16x8 pa0, pa1, pa2, pa3; const int NT = seq / 64;
    constexpr int SE = 0, SO = 1;
#define MSEG(j) do { const int j_ = (j); const bool doqk = j_ < NT, dopv = j_ > 0; \
        const char* Ks_ = K_lds + (j_ % 3) * SHM_K; const int vb_ = vb0 + ((j_ - 1) & 3) * SHM_V; \
        bf16x8 kf[2 * NQ]; s16x4 fa[8], fb[8]; \
        if (doqk) { _Pragma("unroll") for (int d0 = 0; d0 < NQ; ++d0) { const int cb = (d0 * 16 + hi * 8) * 2; \
            kf[2 * d0] = *reinterpret_cast<const bf16x8*>(Ks_ + kswz<MLA>(r32, cb)); kf[2 * d0 + 1] = *reinterpret_cast<const bf16x8*>(Ks_ + kswz<MLA>(32 + r32, cb)); } } \
        if (dopv) { v_frag_read<NCB, 0>(fa, vb_); if constexpr (NCB == 2) v_frag_read<NCB, 1>(fb, vb_); }     \
        SBAR(); \
        if (doqk) { S0 = negm; S1 = negm; _Pragma("unroll") for (int d0 = 0; d0 < NQ; ++d0) { \
            S0 = __builtin_amdgcn_mfma_f32_32x32x16_bf16(kf[2 * d0], qr[d0], S0, 0, 0, 0); S1 = __builtin_amdgcn_mfma_f32_32x32x16_bf16(kf[2 * d0 + 1], qr[d0], S1, 0, 0, 0); } } \
        if (dopv) { if constexpr (NCB == 4) { SBAR(); v_frag_read<NCB, 1>(fb, vb_); }     \
            LWAIT0(); \
            if constexpr (NCB == 4) { pv_mma2(o[0], o[1], fa, fb, pa0, pa1, pa2, pa3); SBAR(); v_frag_read<NCB, 2>(fa, vb_); v_frag_read<NCB, 3>(fb, vb_); \
                LWAIT0(); pv_mma2(o[2], o[NCB - 1], fa, fb, pa0, pa1, pa2, pa3); } \
            else { pv_mma2(o[0], o[1], fa, fb, pa0, pa1, pa2, pa3); } } } while (0)
#define VSEG(j) do { rowmax_adjust(S0, S1, m2, negm, alpha, (j) == 0); RESC(alpha); l_reg = l_reg * alpha + exp_pack(S0, S1, pa0, pa1, pa2, pa3); } while (0)
    __syncthreads();
    SLOAD(SE, 0); SLOAD(SO, 64); asm volatile("s_waitcnt vmcnt(0)" ::: "memory");
    SWRITE(0, 0, SE); SWRITE(SHM_K, SHM_V, SO);
    SLOAD(SE, 2 * 64); SLOAD(SO, 3 * 64);
    __syncthreads();
    { int g_ = g; asm volatile("" : "+s"(g_)); if (g_ == 1) __syncthreads(); }
    for (int j = 0; j < NT; j += 2) {
        SBAR(); MSEG(j); SBAR();
        __syncthreads();
        SBAR(); VSEG(j);
        SWAIT(); if (j + 2 < NT) SWRITE(((j + 2) % 3) * SHM_K, ((j + 2) & 3) * SHM_V, SE);
        if (!(MLA && PROBE_NOLOAD)) { const int tn = (j + 4 < NT) ? j + 4 : NT - 1; SLOAD(SE, tn * 64); } SBAR();
        __syncthreads();
        SBAR(); MSEG(j + 1); SBAR();
        __syncthreads();
        SBAR(); VSEG(j + 1);
        SWAIT(); if (j + 3 < NT) SWRITE(((j + 3) % 3) * SHM_K, ((j + 3) & 3) * SHM_V, SO);
        if (!(MLA && PROBE_NOLOAD)) { const int tn = (j + 5 < NT) ? j + 5 : NT - 1; SLOAD(SO, tn * 64); } SBAR();
        __syncthreads();
    }
    SBAR(); MSEG(NT); SBAR();
    { int g_ = g; asm volatile("" : "+s"(g_)); if (g_ == 0) __syncthreads(); }
#undef MSEG
#undef VSEG
    asm volatile("s_waitcnt vmcnt(0)" ::: "memory");
    if (hi == 0) li_l[r32] = l_reg; asm volatile("s_waitcnt lgkmcnt(0)" ::: "memory");
#pragma unroll
    for (int r = 0; r < 16; ++r) { const float rl = __builtin_amdgcn_rcpf(li_l[crow(r, hi)]);
#pragma unroll
        for (int d = 0; d < NCB; ++d) o[d][r] *= rl; }
#undef SLOAD
#undef SWRITE
#undef SWAIT
#undef RESC
}
}
typedef float2 cs_t;
__device__ __forceinline__ void store8(bf16_t* p, f32x4 v0, f32x4 v1) {
    u32x4 w; w.x = cvtpk(v0[0], v0[1]); w.y = cvtpk(v0[2], v0[3]); w.z = cvtpk(v1[0], v1[1]); w.w = cvtpk(v1[2], v1[3]);
    *(u32x4*)p = w;
}
__device__ __forceinline__ float dot8(f32x4 v0, f32x4 v1) { return (v0[0] * v0[0] + v0[1] * v0[1]) + (v0[2] * v0[2] + v0[3] * v0[3]) + (v1[0] * v1[0] + v1[1] * v1[1]) + (v1[2] * v1[2] + v1[3] * v1[3]); }
__device__ __forceinline__ void rope64(f32x4& v0, f32x4& v1, const cs_t* __restrict__ CS16, int gr, int gc, int wc, int fq, bool apply) {
    f32x4 p0, p1; const int ix = (lane_id_v() ^ 32) << 2;
#pragma unroll
    for (int j = 0; j < 4; ++j) { p0[j] = shfli(v0[j], ix); p1[j] = shfli(v1[j], ix); }
    if (apply) {
        const int pos = (wc & 1) ? gc : gr; const cs_t* t = CS16 + pos * 16 + 8 * (fq & 1);
        const float sg = (fq < 2) ? -1.f : 1.f;
#pragma unroll
        for (int j = 0; j < 4; ++j) { const cs_t a = t[j], b = t[4 + j];
            v0[j] = v0[j] * a.x + sg * p0[j] * a.y; v1[j] = v1[j] * b.x + sg * p1[j] * b.y; }
    }
}
__device__ __forceinline__ void rope32(f32x4& v0, f32x4& v1, const cs_t* __restrict__ CS8, int gr, int gc, int g, bool apply) {
    f32x4 p0, p1; const int ix = (lane_id_v() ^ 16) << 2;
#pragma unroll
    for (int j = 0; j < 4; ++j) { p0[j] = shfli(v0[j], ix); p1[j] = shfli(v1[j], ix); }
    if (apply) {
        const int pos = (g >= 2) ? gc : gr; const cs_t* t = CS8 + pos * 8;
        const float sg = (g & 1) ? 1.f : -1.f;
#pragma unroll
        for (int j = 0; j < 4; ++j) { const cs_t a = t[j], b = t[4 + j];
            v0[j] = v0[j] * a.x + sg * p0[j] * a.y; v1[j] = v1[j] * b.x + sg * p1[j] * b.y; }
    }
}
#define EPI_ARGS const pg8::f32x4 (&acc)[2][2][4][2], const pg8::Unit& u, int wr, int wc, int fr, int fq
#define EPI_RECOMPUTE { const int l_ = lane_id_v(); fr = l_ & 15; fq = l_ >> 4; }

struct EpiP1 {
    static constexpr bool PERM = true, AFTER_DRAIN = false;
    bf16_t *CKV, *CQ, *KMLA, *GA, *DQ, *DK, *DV, *GD, *MG; float *SSKV, *SSQ; const cs_t *CS16, *CS8; bool do_stats;
    __device__ __forceinline__ void operator()(EPI_ARGS) const {
        EPI_RECOMPUTE
        const int pm = u.pm, pn = u.pn; const bool lat = pm < 256;
        if (!lat && !(pn == 0 || pn == 2 || (pn >= 7 && pn <= 10))) return;
        const int row0 = pm * 256 + wr * 64 + fr;
        const int kv0 = (lat ? (pm >> 5) * SKV + CTX + (pm & 31) * 256 : (pm - 256) * SKV) + wr * 64 + fr;
        const int lcw = wc * 32 + 8 * fq;
#pragma unroll
        for (int ai = 0; ai < 2; ++ai)
#pragma unroll
            for (int m = 0; m < 4; ++m) {
                __builtin_amdgcn_sched_barrier(0); const int row = opq(row0 + ai * 128 + m * 16), kvrow = kv0 + (row - row0);
                const int s = row & (SEQ - 1), gr = s >> 6, gc = s & 63;
                float ssq = 0.f;
#pragma unroll
                for (int bj = 0; bj < 2; ++bj) {
                    f32x4 v0 = acc[ai][bj][m][0], v1 = acc[ai][bj][m][1]; const int lc = bj * 128 + lcw;
                    if (pn == 0) { ssq += dot8(v0, v1); store8(CKV + (size_t)kvrow * 256 + lc, v0, v1); }
                    else if (pn == 1) { ssq += dot8(v0, v1); store8(CQ + (size_t)row * 384 + lc, v0, v1); }
                    else if (pn == 2) {
                        if (bj == 0) { if (lat) { ssq += dot8(v0, v1); store8(CQ + (size_t)row * 384 + 256 + lc, v0, v1); } }
                        else if (wc == 0) { rope32(v0, v1, CS8, gr, gc, fq, lat);
#pragma unroll
                            for (int h = 0; h < 8; ++h) store8(KMLA + (size_t)kvrow * 768 + h * 96 + 64 + 8 * fq, v0, v1); }
                    }
                    else if (pn <= 4 || pn == 11 || pn == 12) {
#pragma unroll
                        for (int j = 0; j < 4; ++j) { v0[j] = v0[j] * sigmoid_fast(v0[j]); v1[j] = v1[j] * sigmoid_fast(v1[j]); }
                        bf16_t* dst = (pn <= 4) ? GA + (size_t)row * 512 + (pn - 3) * 256 + lc : GD + (size_t)row * 512 + (pn - 11) * 256 + lc;
                        store8(dst, v0, v1);
                    }
                    else if (pn <= 6) { v0 = v0 * 0.18033688011112042f; v1 = v1 * 0.18033688011112042f;
                        rope64(v0, v1, CS16, gr, gc, wc, fq, true); store8(DQ + (size_t)row * 512 + (pn - 5) * 256 + lc, v0, v1); }
                    else if (pn <= 8) { rope64(v0, v1, CS16, gr, gc, wc, fq, lat); store8(DK + (size_t)kvrow * 512 + (pn - 7) * 256 + lc, v0, v1); }
                    else if (pn <= 10) { store8(DV + (size_t)kvrow * 512 + (pn - 9) * 256 + lc, v0, v1); }
                    else {
#pragma unroll
                        for (int j = 0; j < 4; ++j) { v0[j] = sigmoid_fast(v0[j]); v1[j] = sigmoid_fast(v1[j]); }
                        store8(MG + (size_t)row * 2048 + (pn - 13) * 256 + lc, v0, v1);
                    }
                }
                if (pn <= 2) {
                    ssq += shflx(ssq, 16); ssq += shflx(ssq, 32);
                    if (fq == 0) { if (pn == 0) SSKV[(size_t)kvrow * 4 + wc] = ssq; else if (lat) SSQ[(size_t)row * 8 + (pn - 1) * 4 + wc] = ssq; }
                }
            }
    }
};
struct EpiQ {
    static constexpr bool PERM = true, AFTER_DRAIN = false;
    bf16_t* QMLA; const float* SSQ; const cs_t* CS8;
    __device__ __forceinline__ void operator()(EPI_ARGS) const {
        EPI_RECOMPUTE
        const int row0 = u.pm * 256 + wr * 64 + fr;
#pragma unroll
        for (int ai = 0; ai < 2; ++ai)
#pragma unroll
            for (int m = 0; m < 4; ++m) {
                __builtin_amdgcn_sched_barrier(0); const int row = opq(row0 + ai * 128 + m * 16); const int s = row & (SEQ - 1), gr = s >> 6, gc = s & 63;
                const f32x4 sa = *(const f32x4*)(SSQ + (size_t)row * 8), sb = *(const f32x4*)(SSQ + (size_t)row * 8 + 4);
                const float rs = 0.14724445f / sqrtf((((sa[0] + sa[1]) + (sa[2] + sa[3])) + ((sb[0] + sb[1]) + (sb[2] + sb[3]))) * (1.f / 384.f) + 1e-6f);
#pragma unroll
                for (int bj = 0; bj < 2; ++bj) {
                    f32x4 v0 = acc[ai][bj][m][0] * rs, v1 = acc[ai][bj][m][1] * rs;
                    const int c0 = u.pn * 256 + bj * 128 + wc * 32 + 8 * fq, d = c0 % 96;
                    rope32(v0, v1, CS8, gr, gc, (d - 64) >> 3, d >= 64);
                    store8(QMLA + (size_t)row * 768 + c0, v0, v1);
                }
            }
    }
};
struct EpiKV {
    static constexpr bool PERM = true, AFTER_DRAIN = false;
    bf16_t *KMLA, *VMLA; const float* SSKV;
    __device__ __forceinline__ void operator()(EPI_ARGS) const {
        EPI_RECOMPUTE
        const int row0 = u.pm * 256 + wr * 64 + fr;
#pragma unroll
        for (int ai = 0; ai < 2; ++ai)
#pragma unroll
            for (int m = 0; m < 4; ++m) {
                __builtin_amdgcn_sched_barrier(0); const int row = opq(row0 + ai * 128 + m * 16);
                const f32x4 sa = *(const f32x4*)(SSKV + (size_t)row * 4);
                const float rs = 1.f / sqrtf(((sa[0] + sa[1]) + (sa[2] + sa[3])) * (1.f / 256.f) + 1e-6f);
#pragma unroll
                for (int bj = 0; bj < 2; ++bj) {
                    const f32x4 v0 = acc[ai][bj][m][0] * rs, v1 = acc[ai][bj][m][1] * rs;
                    const int h = u.pn * 2 + bj, d = wc * 32 + 8 * fq;
                    if (wc < 2) store8(KMLA + (size_t)row * 768 + h * 96 + d, v0, v1);
                    else store8(VMLA + (size_t)row * 512 + h * 64 + (d - 64), v0, v1);
                }
            }
    }
};
template <bool ACCUM> struct EpiZ {
    static constexpr bool PERM = true, AFTER_DRAIN = false;
    bf16_t* Z; const bf16_t* MG;
    __device__ __forceinline__ void operator()(EPI_ARGS) const {
        EPI_RECOMPUTE
        const int row0 = u.pm * 256 + wr * 64 + fr;
#pragma unroll
        for (int ai = 0; ai < 2; ++ai)
#pragma unroll
            for (int m = 0; m < 4; ++m) {
                __builtin_amdgcn_sched_barrier(0); const int row = opq(row0 + ai * 128 + m * 16);
#pragma unroll
                for (int bj = 0; bj < 2; ++bj) {
                    f32x4 v0 = acc[ai][bj][m][0], v1 = acc[ai][bj][m][1];
                    const int c0 = u.pn * 256 + bj * 128 + wc * 32 + 8 * fq;
                    const u32x4 g = *(const u32x4*)(MG + (size_t)row * 2048 + c0);
                    v0[0] *= bflo(g.x); v0[1] *= bfhi(g.x); v0[2] *= bflo(g.y); v0[3] *= bfhi(g.y);
                    v1[0] *= bflo(g.z); v1[1] *= bfhi(g.z); v1[2] *= bflo(g.w); v1[3] *= bfhi(g.w);
                    bf16_t* zp = Z + (size_t)row * 1024 + c0;
                    if (ACCUM) { const u32x4 z = *(const u32x4*)zp;
                        v0[0] += bflo(z.x); v0[1] += bfhi(z.x); v0[2] += bflo(z.y); v0[3] += bfhi(z.y);
                        v1[0] += bflo(z.z); v1[1] += bfhi(z.z); v1[2] += bflo(z.w); v1[3] += bfhi(z.w); }
                    store8(zp, v0, v1);
                }
            }
    }
};
struct EpiOut {
    static constexpr bool PERM = true, AFTER_DRAIN = false;
    float* OUT; const float* X; const float* MOD;
    __device__ __forceinline__ void operator()(EPI_ARGS) const {
        EPI_RECOMPUTE
        const int row0 = u.pm * 256 + wr * 64 + fr; const float ALPHA = 1.189207115002721f;
        const float* gate = MOD + (size_t)(u.pm >> 5) * 3072 + 2048;
#pragma unroll
        for (int ai = 0; ai < 2; ++ai)
#pragma unroll
            for (int m = 0; m < 4; ++m) {
                __builtin_amdgcn_sched_barrier(0); const int row = opq(row0 + ai * 128 + m * 16);
#pragma unroll
                for (int bj = 0; bj < 2; ++bj) {
                    const int c0 = u.pn * 256 + bj * 128 + wc * 32 + 8 * fq;
                    const f32x4 x0 = *(const f32x4*)(X + (size_t)row * 1024 + c0), x1 = *(const f32x4*)(X + (size_t)row * 1024 + c0 + 4);
                    const f32x4 g0 = *(const f32x4*)(gate + c0), g1 = *(const f32x4*)(gate + c0 + 4);
                    *(f32x4*)(OUT + (size_t)row * 1024 + c0) = x0 * ALPHA + g0 * acc[ai][bj][m][0];
                    *(f32x4*)(OUT + (size_t)row * 1024 + c0 + 4) = x1 * ALPHA + g1 * acc[ai][bj][m][1];
                }
            }
    }
};
constexpr size_t MiB = 1u << 20;
constexpr size_t WS_BAR = 0, CTL_ZERO_BYTES = 16384;
constexpr size_t WS_SSKV = 0, WS_SSQ = 512 * 1024;
constexpr size_t WS_MOD = 1 * MiB, WS_CS16 = 1 * MiB + 128 * 1024, WS_CS8 = 1 * MiB + 192 * 1024;
constexpr size_t WS_WIN = 2 * MiB, WS_WUQ = 13 * MiB, WS_WUKV = 14 * MiB, WS_WOA = 15 * MiB, WS_WOB = 16 * MiB, WS_WOUT = 17 * MiB;
constexpr size_t WS_HBF = 32 * MiB;
constexpr size_t WS_VMLA = WS_HBF, WS_Z = WS_HBF;
constexpr size_t WS_KMLA = 164 * MiB;
constexpr size_t WS_GA = 263 * MiB;
constexpr size_t WS_DQ = 327 * MiB;
constexpr size_t WS_DK = 391 * MiB;
constexpr size_t WS_DV = 457 * MiB;
constexpr size_t WS_GD = 523 * MiB;
constexpr size_t WS_MG = 587 * MiB;
constexpr size_t WS_QMLA = 843 * MiB;
constexpr size_t WS_SSKVP = 939 * MiB, WS_SSQP = 941 * MiB;
constexpr size_t WS_END = 944 * MiB;
constexpr size_t OUT_XA = 96 * MiB, OUT_XD = 160 * MiB;
constexpr size_t OUT_CKV = 0, OUT_CQ = 33 * MiB;
constexpr int LDS_BYTES = 157760;

struct Args {
    const float *x, *c, *ctx, *c_ctx, *w_mod, *b_mod, *w_in, *q_norm, *kv_norm, *w_uq, *w_ukv, *dlam, *subln, *w_oa, *w_ob, *w_out, *ln_g, *ln_b;
    float* out; unsigned char* ws;
};

__device__ __forceinline__ void tr_item(const float* __restrict__ W, int K, int N, int srcn0, const float* __restrict__ ksc, bf16_t* WT, int dstn0, int k0, float* scr, int lane) {
#pragma unroll 8
    for (int i = 0; i < 32; ++i) { const int kk = 2 * i + (lane >> 5);
        float v = 0.f; if (srcn0 >= 0) { v = W[(size_t)(k0 + kk) * N + srcn0 + (lane & 31)]; if (ksc) v *= ksc[k0 + kk]; }
        scr[kk * 33 + (lane & 31)] = v; }
    asm volatile("s_waitcnt lgkmcnt(0)" ::: "memory");
    const int c = lane & 7;
#pragma unroll
    for (int j = 0; j < 4; ++j) { const int n = (lane >> 3) + 8 * j; const float* s = scr + (8 * c) * 33 + n;
        u32x4 o; o.x = cvtpk(s[0 * 33], s[1 * 33]); o.y = cvtpk(s[2 * 33], s[3 * 33]); o.z = cvtpk(s[4 * 33], s[5 * 33]); o.w = cvtpk(s[6 * 33], s[7 * 33]);
        *(u32x4*)(WT + (size_t)(dstn0 + n) * K + k0 + 8 * c) = o; }
    asm volatile("s_waitcnt lgkmcnt(0)" ::: "memory");
}

#define XB_TMO      128
#define XB_XCNT(j)  (256  + 64 * (j))
#define XB_XSUB(j)  (1280 + 64 * (j))
#define XB_XGEN(j)  (2304 + 64 * (j))
#define XB_TOP      3328
#define XB_TOPGEN   3392
#define XCD_BAR_WORDS 3456
#define XB_SPIN_CAP (1u << 18)

__device__ __forceinline__ unsigned xb_ld(unsigned* p)              { return __hip_atomic_load(p, __ATOMIC_RELAXED, __HIP_MEMORY_SCOPE_AGENT); }
__device__ __forceinline__ unsigned xb_add(unsigned* p, unsigned v) { return __hip_atomic_fetch_add(p, v, __ATOMIC_RELAXED, __HIP_MEMORY_SCOPE_AGENT); }
__device__ __forceinline__ unsigned xb_xcc_id() { return (unsigned)__builtin_amdgcn_s_getreg((3 << 11) | 20) & 0xFu; }
#define XB_SPIN(cond, bar) do { unsigned _sp = 0; while (cond) { __builtin_amdgcn_s_sleep(1); \
    if ((++_sp & 255u) == 0u) { if (xb_ld(&(bar)[XB_TMO])) break; if (_sp > XB_SPIN_CAP) { atomicAdd(&(bar)[XB_TMO], 1u); break; } } } } while (0)

struct XcdBarrier {
    unsigned* bar; unsigned x;
    volatile LAS unsigned* st;
};

__device__ __forceinline__ XcdBarrier xcd_barrier_post(unsigned* bar, volatile LAS unsigned* st) {
    XcdBarrier b; b.bar = bar; b.x = xb_xcc_id(); b.st = st;
    if (threadIdx.x == 0) (void)xb_add(&bar[XB_XCNT(b.x)], 1u);
    return b;
}
__device__ __forceinline__ void xcd_barrier_complete(unsigned* bar, unsigned x, unsigned& nloc, unsigned& nx) {
    const unsigned G = gridDim.x * gridDim.y * gridDim.z;
    unsigned sum, cnt, mine, sp = 0u;
    for (;;) {
        sum = 0u; cnt = 0u; mine = 0u;
#pragma unroll
        for (unsigned j = 0; j < 16; ++j) { const unsigned c = xb_ld(&bar[XB_XCNT(j)]); sum += c; cnt += (c > 0u) ? 1u : 0u; mine = (j == x) ? c : mine; }
        if (sum == G) break;
        __builtin_amdgcn_s_sleep(1);
        if ((++sp & 255u) == 0u) { if (xb_ld(&bar[XB_TMO])) break; if (sp > XB_SPIN_CAP) { atomicAdd(&bar[XB_TMO], 1u); break; } }
    }
    nloc = mine > 0u ? mine : 1u; nx = cnt > 0u ? cnt : 1u;
}

__device__ __forceinline__ void xcd_barrier(const XcdBarrier& b) {
    asm volatile("s_waitcnt vmcnt(0)" ::: "memory");
    __syncthreads();
    if (threadIdx.x == 0) {
        unsigned* bar = b.bar;
        __builtin_amdgcn_s_waitcnt(0);
        unsigned nloc = b.st[0], nx = b.st[1];
        if (nloc == 0u) { xcd_barrier_complete(bar, b.x, nloc, nx); b.st[0] = nloc; b.st[1] = nx; }
        const unsigned old = xb_add(&bar[XB_XSUB(b.x)], 1u);
        const unsigned gen = old / nloc;
        if (old + 1u == (gen + 1u) * nloc) {
            __builtin_amdgcn_fence(__ATOMIC_RELEASE, "agent");
            asm volatile("s_waitcnt vmcnt(0)" ::: "memory");
            const unsigned og = xb_add(&bar[XB_TOP], 1u);
            const unsigned tg = og / nx;
            if (og + 1u == (tg + 1u) * nx) xb_add(&bar[XB_TOPGEN], 1u);
            else XB_SPIN(xb_ld(&bar[XB_TOPGEN]) == tg, bar);
            __builtin_amdgcn_fence(__ATOMIC_ACQUIRE, "agent");
            xb_add(&bar[XB_XGEN(b.x)], 1u);
            asm volatile("s_waitcnt vmcnt(0)" ::: "memory");
        } else {
            XB_SPIN(xb_ld(&bar[XB_XGEN(b.x)]) == gen, bar);
            __builtin_amdgcn_fence(__ATOMIC_ACQUIRE, "agent");
            asm volatile("s_waitcnt vmcnt(0)" ::: "memory");
        }
    }
    __syncthreads();
}

__global__ void __launch_bounds__(512, 2) fwd_mega(Args a) {
    extern __shared__ __attribute__((aligned(16))) unsigned char lds[];
    cg::grid_group grid = cg::this_grid();
    const int wave = __builtin_amdgcn_readfirstlane((int)threadIdx.x >> 6);
#define LANE_TID const int lane = lane_id_v(), tid = wave * 64 + lane; (void)tid; (void)lane;
    const int G = gridDim.x, bid = blockIdx.x;
    const int gw = bid * 8 + wave, NGW = G * 8;
    unsigned char* ws = a.ws; unsigned char* ob = (unsigned char*)a.out;
    float* SSKV = (float*)(ws + WS_SSKVP); float* SSQ = (float*)(ws + WS_SSQP); float* MOD = (float*)(ws + WS_MOD);
    cs_t* CS16 = (cs_t*)(ws + WS_CS16); cs_t* CS8 = (cs_t*)(ws + WS_CS8);
    bf16_t* WIN = (bf16_t*)(ws + WS_WIN); bf16_t* WUQ = (bf16_t*)(ws + WS_WUQ); bf16_t* WUKV = (bf16_t*)(ws + WS_WUKV);
    bf16_t* WOA = (bf16_t*)(ws + WS_WOA); bf16_t* WOB = (bf16_t*)(ws + WS_WOB); bf16_t* WOUT = (bf16_t*)(ws + WS_WOUT);
    bf16_t* HBF = (bf16_t*)(ws + WS_HBF); bf16_t* VMLA = (bf16_t*)(ws + WS_VMLA); bf16_t* Z = (bf16_t*)(ws + WS_Z);
    bf16_t* KMLA = (bf16_t*)(ws + WS_KMLA); bf16_t* GA = (bf16_t*)(ws + WS_GA); bf16_t* DQ = (bf16_t*)(ws + WS_DQ); bf16_t* DK = (bf16_t*)(ws + WS_DK);
    bf16_t* DV = (bf16_t*)(ws + WS_DV); bf16_t* GD = (bf16_t*)(ws + WS_GD); bf16_t* MG = (bf16_t*)(ws + WS_MG); bf16_t* QMLA = (bf16_t*)(ws + WS_QMLA);
    bf16_t* CKV = (bf16_t*)(ob + OUT_CKV); bf16_t* CQ = (bf16_t*)(ob + OUT_CQ); bf16_t* XA = (bf16_t*)(ob + OUT_XA); bf16_t* XD = (bf16_t*)(ob + OUT_XD);
    PG8_LAS unsigned char* ldsp = (PG8_LAS unsigned char*)lds;
    { volatile LAS unsigned* stz = (volatile LAS unsigned*)(lds + 157696); if (threadIdx.x < 16) stz[threadIdx.x] = 0u; }
    __syncthreads();
    const XcdBarrier xbar = xcd_barrier_post((unsigned*)(ws + WS_BAR), (volatile LAS unsigned*)(lds + 157696));

#ifndef REP1
#define REP1 1
#endif
#ifndef REP2
#define REP2 1
#endif
#ifndef REP3A
#define REP3A 0
#endif
#ifndef REP3D
#define REP3D 0
#endif
#ifndef REP4A
#define REP4A 1
#endif
#ifndef REP4B
#define REP4B 1
#endif
#ifndef PHMASK
#define PHMASK 0xfff
#endif
    if (PHMASK & (1 << 0)) {
        LANE_TID
        float* A = (float*)lds; float* red = (float*)(lds + 36864);
        for (int cb = bid; cb < 96; cb += G) {
            __syncthreads();
            for (int i = tid; i < 9 * 1024; i += 512) { const int r = i >> 10, k = i & 1023; const float v = r < 8 ? a.c[r * 1024 + k] : a.c_ctx[k]; A[i] = v * sigmoidf_(v); }
            __syncthreads();
            const int cl = tid & 31, col = cb * 32 + cl, kq = tid >> 5;
            float acc[9];
#pragma unroll
            for (int r = 0; r < 9; ++r) acc[r] = 0.f;
#pragma unroll 4
            for (int kk = 0; kk < 64; ++kk) { const int k = kq * 64 + kk; const float w = a.w_mod[(size_t)k * 3072 + col];
#pragma unroll
                for (int r = 0; r < 9; ++r) acc[r] += A[r * 1024 + k] * w; }
#pragma unroll
            for (int r = 0; r < 9; ++r) red[(kq * 9 + r) * 32 + cl] = acc[r];
            __syncthreads();
            if (tid < 288) { const int r = tid >> 5; float s = 0.f;
                for (int q = 0; q < 16; ++q) s += red[(q * 9 + r) * 32 + cl];
                MOD[r * 3072 + col] = s + a.b_mod[col]; }
        }
        __syncthreads();
        float* scr = (float*)lds + wave * (64 * 33);
        constexpr int I_IN = 16 * 168, I_UQ = 6 * 24, I_UKV = 4 * 32, I_OA = 8 * 32, I_OB = 8 * 32, I_OUT = 16 * 32;
        constexpr int NITEMS = I_IN + I_UQ + I_UKV + I_OA + I_OB + I_OUT;
        for (int it = gw; it < NITEMS; it += NGW) {
            int r = it;
            if (r < I_IN) { const int kb = r / 168, nb = r % 168, d0 = nb * 32;
                const int s0 = d0 < 256 ? 384 + d0 : d0 < 640 ? d0 - 256 : d0 < 672 ? d0 : d0 < 768 ? -1 : d0 - 96;
                tr_item(a.w_in, 1024, 5280, s0, nullptr, WIN, d0, kb * 64, scr, lane); continue; } r -= I_IN;
            if (r < I_UQ) { tr_item(a.w_uq, 384, 768, (r % 24) * 32, a.q_norm, WUQ, (r % 24) * 32, (r / 24) * 64, scr, lane); continue; } r -= I_UQ;
            if (r < I_UKV) { tr_item(a.w_ukv, 256, 1024, (r % 32) * 32, a.kv_norm, WUKV, (r % 32) * 32, (r / 32) * 64, scr, lane); continue; } r -= I_UKV;
            if (r < I_OA) { tr_item(a.w_oa, 512, 1024, (r % 32) * 32, nullptr, WOA, (r % 32) * 32, (r / 32) * 64, scr, lane); continue; } r -= I_OA;
            if (r < I_OB) { tr_item(a.w_ob, 512, 1024, (r % 32) * 32, nullptr, WOB, (r % 32) * 32, (r / 32) * 64, scr, lane); continue; } r -= I_OB;
            tr_item(a.w_out, 1024, 1024, (r % 32) * 32, nullptr, WOUT, (r % 32) * 32, (r / 32) * 64, scr, lane);
        }
        if (bid == G - 1) {
            for (int i = tid; i < 128 * 16; i += 512) { const int pos = i >> 4, f = i & 15; const float inv = powf(10000.f, -(float)f / 16.f), ang = (float)pos * inv; CS16[i] = make_float2(cosf(ang), sinf(ang)); }
            for (int i = tid; i < 128 * 8; i += 512) { const int pos = i >> 3, f = i & 7; const float inv = powf(10000.f, -(float)f / 8.f), ang = (float)pos * inv; CS8[i] = make_float2(cosf(ang), sinf(ang)); }
        }
    }
    grid.sync();

    if (PHMASK & (1 << 1)) for (int m = gw; m < MALL; m += NGW) {
        LANE_TID
        const float* src; const float* mod;
        if (m < MLAT) { src = a.x + (size_t)m * 1024; mod = MOD + (size_t)(m >> 13) * 3072; } else { src = a.ctx + (size_t)(m - MLAT) * 1024; mod = MOD + 8 * 3072; }
#pragma unroll
        for (int j = 0; j < 4; ++j) { const int c4 = lane + 64 * j;
            const f32x4 v = ((const f32x4*)src)[c4], sh = ((const f32x4*)mod)[c4], sc = ((const f32x4*)(mod + 1024))[c4];
            const f32x4 h = v * (sc + 1.f) + sh; u32x2 w; w.x = cvtpk(h[0], h[1]); w.y = cvtpk(h[2], h[3]);
            *(u32x2*)(HBF + (size_t)m * 1024 + c4 * 4) = w; }
    }
    xcd_barrier(xbar);

    if (PHMASK & (1 << 2)) for (int rep = 0; rep < REP1; ++rep) {
        pg8::Gemm g{HBF, WIN, MALL, NINP, 1024}; pg8::StaticOrder S; S.init(MALL, NINP, G, bid);
        EpiP1 E{CKV, CQ, KMLA, GA, DQ, DK, DV, GD, MG, SSKV, SSQ, CS16, CS8, rep == 0};
        pg8::gemm_phase<EpiP1, pg8::StaticOrder, true, true>(ldsp, g, S, E, wave);
    }
    xcd_barrier(xbar);

    for (int rep = 0; rep < REP2; ++rep) {
    if (PHMASK & (1 << 3)) {
        pg8::Gemm g{CQ, WUQ, MLAT, 768, 384}; pg8::StaticOrder S; S.init(MLAT, 768, G, bid);
        EpiQ E{QMLA, SSQ, CS8};
        pg8::gemm_phase<EpiQ, pg8::StaticOrder, true, true>(ldsp, g, S, E, wave);
    }
    if (PHMASK & (1 << 4)) {
        pg8::Gemm g{CKV, WUKV, MALL, 1024, 256}; pg8::StaticOrder S; S.init(MALL, 1024, G, bid);
        EpiKV E{KMLA, VMLA, SSKV};
        pg8::gemm_phase<EpiKV, pg8::StaticOrder, true, true>(ldsp, g, S, E, wave);
    }
    }
    xcd_barrier(xbar);

    if (PHMASK & (3 << 5)) {
        float lam;
        { LANE_TID
        { const float s1 = wave_sum(a.dlam[lane] * a.dlam[64 + lane]), s2 = wave_sum(a.dlam[128 + lane] * a.dlam[192 + lane]); lam = __builtin_bit_cast(float, __builtin_amdgcn_readfirstlane(__builtin_bit_cast(int, __expf(s1) - __expf(s2) + 0.2f))); } }
        int grp;
        { LANE_TID
          int* tab = (int*)(lds + 92160); const int simd = (__builtin_amdgcn_s_getreg((1 << 11) | (4 << 6) | 4)) & 3;
          __syncthreads(); if (lane == 0) tab[wave] = simd; __syncthreads();
          int cnt = 0;
#pragma unroll
          for (int w = 0; w < 8; ++w) cnt += (w < wave && tab[w] == simd) ? 1 : 0;
          grp = __builtin_amdgcn_readfirstlane(cnt > 0 ? 1 : 0); asm volatile("" : "+s"(grp)); __syncthreads(); }
        const int nrounds = (NB * 12 * 32 + G - 1) / G;
        for (int rdx = 0; rdx < nrounds + REP3A * 8 + REP3D * 4; ++rdx) {
            const int rd = rdx < nrounds ? rdx : (rdx - nrounds < REP3A * 8 ? (rdx - nrounds) & 7 : 8 + ((rdx - nrounds - REP3A * 8) & 3));
            int b, hs, qb;
            { const int idx = rd * G + bid; if (idx >= NB * 12 * 32) break; b = idx & 7; qb = (idx >> 3) & 31; hs = idx >> 8; }
            const size_t qrow0 = (size_t)b * SEQ + qb * 256, krow0 = (size_t)b * SKV;
            __syncthreads();
            if (hs < 8) { if (PHMASK & (1 << 5)) {
                f32x16 o[2];
                att::attn_core<true>(QMLA + qrow0 * 768 + hs * 96, KMLA + krow0 * 768 + hs * 96, VMLA + krow0 * 512 + hs * 64, SKV, (char*)lds, o, wave, grp);
                LANE_TID
                const int r32 = lane & 31, hi = lane >> 5;
                char* T = (char*)lds + 92160 + wave * 8192; char* tw = T + hi * 512 + r32 * 2;
#pragma unroll
                for (int r = 0; r < 16; ++r)
#pragma unroll
                    for (int d0 = 0; d0 < 2; ++d0) *(bf16_t*)(tw + ((r & 3) + 8 * (r >> 2)) * 128 + d0 * 64) = (bf16_t)cvtpk(o[d0][r], o[d0][r]);
#pragma unroll
                for (int j = 0; j < 4; ++j) { const int id = j * 64 + lane, row = id >> 3, c8 = id & 7;
                    const u32x4 t = *(const u32x4*)(T + id * 16);
                    const size_t go = (qrow0 + wave * 32 + row) * 512 + hs * 64 + c8 * 8; const u32x4 g = *(const u32x4*)(GA + go);
                    u32x4 w; w.x = cvtpk(bflo(t.x) * bflo(g.x), bfhi(t.x) * bfhi(g.x)); w.y = cvtpk(bflo(t.y) * bflo(g.y), bfhi(t.y) * bfhi(g.y));
                    w.z = cvtpk(bflo(t.z) * bflo(g.z), bfhi(t.z) * bfhi(g.z)); w.w = cvtpk(bflo(t.w) * bflo(g.w), bfhi(t.w) * bfhi(g.w));
                    *(u32x4*)(XA + go) = w; }
            } } else if (PHMASK & (1 << 6)) {
                const int h = hs - 8;
                f32x16 o[4];
                att::attn_core<false>(DQ + qrow0 * 512 + h * 128, DK + krow0 * 512 + h * 128, DV + krow0 * 512 + h * 128, SKV, (char*)lds, o, wave, grp);
                { unsigned* stash = (unsigned*)(lds + 92160 + wave * 8192) + lane_id_v();
#pragma unroll
                for (int d0 = 0; d0 < 4; ++d0)
#pragma unroll
                    for (int r = 0; r < 16; r += 2) stash[(d0 * 8 + (r >> 1)) * 64] = cvtpk(o[d0][r], o[d0][r + 1]); }
                att::attn_core<false>(DQ + qrow0 * 512 + h * 128 + 64, DK + krow0 * 512 + h * 128 + 64, DV + krow0 * 512 + h * 128, SKV, (char*)lds, o, wave, grp);
                LANE_TID
                const int r32 = lane & 31, hi = lane >> 5;
                unsigned* stash = (unsigned*)(lds + 92160 + wave * 8192) + lane;
#pragma unroll
                for (int d0 = 0; d0 < 4; ++d0)
#pragma unroll
                    for (int r = 0; r < 16; r += 2) { const unsigned w = stash[(d0 * 8 + (r >> 1)) * 64];
                        o[d0][r] = bflo(w) - lam * o[d0][r]; o[d0][r + 1] = bfhi(w) - lam * o[d0][r + 1]; }
                asm volatile("s_waitcnt lgkmcnt(0)" ::: "memory"); SBAR();
                char* T = (char*)lds + 92160 + wave * 8192; char* tw = T + hi * 1024 + r32 * 2;
#pragma unroll
                for (int r = 0; r < 16; ++r)
#pragma unroll
                    for (int d0 = 0; d0 < 4; ++d0) *(bf16_t*)(tw + ((r & 3) + 8 * (r >> 2)) * 256 + d0 * 64) = (bf16_t)cvtpk(o[d0][r], o[d0][r]);
                const int c16 = lane & 15;
                const f32x4 sw0 = *(const f32x4*)(a.subln + c16 * 8), sw1 = *(const f32x4*)(a.subln + c16 * 8 + 4);
#pragma unroll
                for (int j = 0; j < 8; ++j) { const int id = j * 64 + lane, row = id >> 4;
                    const u32x4 t = *(const u32x4*)(T + id * 16);
                    float e[8] = {bflo(t.x), bfhi(t.x), bflo(t.y), bfhi(t.y), bflo(t.z), bfhi(t.z), bflo(t.w), bfhi(t.w)};
                    float ss = 0.f;
#pragma unroll
                    for (int k = 0; k < 8; ++k) ss += e[k] * e[k];
                    ss += shflx(ss, 1); ss += shflx(ss, 2); ss += shflx(ss, 4); ss += shflx(ss, 8);
                    const float rs = 0.8f / sqrtf(ss * (1.f / 128.f) + 1e-5f);
                    const size_t go = (qrow0 + wave * 32 + row) * 512 + h * 128 + c16 * 8; const u32x4 g = *(const u32x4*)(GD + go);
                    u32x4 w; w.x = cvtpk(e[0] * rs * sw0[0] * bflo(g.x), e[1] * rs * sw0[1] * bfhi(g.x)); w.y = cvtpk(e[2] * rs * sw0[2] * bflo(g.y), e[3] * rs * sw0[3] * bfhi(g.y));
                    w.z = cvtpk(e[4] * rs * sw1[0] * bflo(g.z), e[5] * rs * sw1[1] * bfhi(g.z)); w.w = cvtpk(e[6] * rs * sw1[2] * bflo(g.w), e[7] * rs * sw1[3] * bfhi(g.w));
                    *(u32x4*)(XD + go) = w; }
            }
        }
    }
    xcd_barrier(xbar);

    for (int rep = 0; rep < REP4A; ++rep) {
    if (PHMASK & (1 << 7)) {
        pg8::Gemm g{XA, WOA, MLAT, 1024, 512}; pg8::StaticOrder S; S.init(MLAT, 1024, G, bid);
        EpiZ<false> E{Z, MG};
        pg8::gemm_phase<EpiZ<false>, pg8::StaticOrder, true, true>(ldsp, g, S, E, wave);
    }
    if (PHMASK & (1 << 8)) {
        pg8::Gemm g{XD, WOB, MLAT, 1024, 512}; pg8::StaticOrder S; S.init(MLAT, 1024, G, bid);
        EpiZ<true> E{Z, MG + 1024};
        pg8::gemm_phase<EpiZ<true>, pg8::StaticOrder, true, true>(ldsp, g, S, E, wave);
    }
    }
    xcd_barrier(xbar);

    if (PHMASK & (1 << 9)) for (int rep = 0; rep < REP4B; ++rep) {
        pg8::Gemm g{Z, WOUT, MLAT, 1024, 1024}; pg8::StaticOrder S; S.init(MLAT, 1024, G, bid);
        EpiOut E{a.out, a.x, MOD};
        pg8::gemm_phase<EpiOut, pg8::StaticOrder, true, true>(ldsp, g, S, E, wave);
    }
    xcd_barrier(xbar);

    if (PHMASK & (1 << 10)) for (int m = gw; m < MLAT; m += NGW) {
        LANE_TID
        f32x4* rowp = (f32x4*)(a.out + (size_t)m * 1024) + lane;
        f32x4 v[4]; float s = 0.f;
#pragma unroll
        for (int j = 0; j < 4; ++j) { v[j] = rowp[64 * j]; s += (v[j][0] + v[j][1]) + (v[j][2] + v[j][3]); }
        const float mean = wave_sum(s) * (1.f / 1024.f); float s2 = 0.f;
#pragma unroll
        for (int j = 0; j < 4; ++j) { v[j] = v[j] - mean; s2 += (v[j][0] * v[j][0] + v[j][1] * v[j][1]) + (v[j][2] * v[j][2] + v[j][3] * v[j][3]); }
        const float rstd = 1.f / sqrtf(wave_sum(s2) * (1.f / 1024.f) + 1e-5f);
#pragma unroll
        for (int j = 0; j < 4; ++j) { const f32x4 g = ((const f32x4*)a.ln_g)[lane + 64 * j], bb = ((const f32x4*)a.ln_b)[lane + 64 * j]; rowp[64 * j] = v[j] * rstd * g + bb; }
    }
}

extern "C" void kernel_launch(void* const* d_in, const int* in_sizes, int n_in, void* d_out, int out_size, void* d_ws, size_t ws_size, hipStream_t stream) {
    static int grid = 0;
    if (grid == 0) {
        if (n_in != 18 || in_sizes[0] != MLAT * DM || out_size != MLAT * DM || ws_size < WS_END) {
            fprintf(stderr, "kernel_launch: shape/workspace mismatch: n_in %d in0 %d out %d ws %zu (need %zu)\n", n_in, n_in > 0 ? in_sizes[0] : -1, out_size, ws_size, (size_t)WS_END); grid = -1; return; }
        int dev = 0, cus = 0, per_cu = 0;
        hipGetDevice(&dev); hipDeviceGetAttribute(&cus, hipDeviceAttributeMultiprocessorCount, dev);
        if (hipFuncSetAttribute((const void*)fwd_mega, hipFuncAttributeMaxDynamicSharedMemorySize, LDS_BYTES) != hipSuccess) { fprintf(stderr, "kernel_launch: hipFuncSetAttribute failed\n"); grid = -1; return; }
        if (hipOccupancyMaxActiveBlocksPerMultiprocessor(&per_cu, (const void*)fwd_mega, 512, LDS_BYTES) != hipSuccess || per_cu < 1) { fprintf(stderr, "kernel_launch: occupancy query gave %d\n", per_cu); per_cu = 1; }
        (void)hipGetLastError();
        grid = cus * 1;
    }
    if (grid < 0) return;
    hipMemsetAsync((char*)d_ws + WS_BAR, 0, CTL_ZERO_BYTES, stream);
    Args a{};
    a.x = (const float*)d_in[0]; a.c = (const float*)d_in[1]; a.ctx = (const float*)d_in[2]; a.c_ctx = (const float*)d_in[3]; a.w_mod = (const float*)d_in[4]; a.b_mod = (const float*)d_in[5];
    a.w_in = (const float*)d_in[6]; a.q_norm = (const float*)d_in[7]; a.kv_norm = (const float*)d_in[8]; a.w_uq = (const float*)d_in[9]; a.w_ukv = (const float*)d_in[10];
    a.dlam = (const float*)d_in[11]; a.subln = (const float*)d_in[12]; a.w_oa = (const float*)d_in[13]; a.w_ob = (const float*)d_in[14]; a.w_out = (const float*)d_in[15];
    a.ln_g = (const float*)d_in[16]; a.ln_b = (const float*)d_in[17]; a.out = (float*)d_out; a.ws = (unsigned char*)d_ws;
    void* args[] = {&a};
    hipError_t e = hipLaunchCooperativeKernel((const void*)fwd_mega, dim3(grid), dim3(512), args, LDS_BYTES, stream);
    if (e != hipSuccess) fprintf(stderr, "kernel_launch: cooperative launch failed: %s (grid %d)\n", hipGetErrorString(e), grid);
}
```

```cpp
#include <hip/hip_runtime.h>
#include <hip/hip_cooperative_groups.h>
#include <cstdio>
#include <cstdint>
namespace cg = cooperative_groups;
__device__ __forceinline__ int opq(int v) { asm volatile("" : "+v"(v)); return v; }
__device__ __forceinline__ int lane_id_v() { int l; asm volatile("v_mbcnt_lo_u32_b32 %0, -1, 0\n\tv_mbcnt_hi_u32_b32 %0, -1, %0" : "=v"(l)); return l; }
__device__ __forceinline__ float shflx(float v, int mask) { return __builtin_bit_cast(float, __builtin_amdgcn_ds_bpermute((lane_id_v() ^ mask) << 2, __builtin_bit_cast(int, v))); }
__device__ __forceinline__ float shfli(float v, int idx4) { return __builtin_bit_cast(float, __builtin_amdgcn_ds_bpermute(idx4, __builtin_bit_cast(int, v))); }
namespace pg8 {
#define PG8_LAS __attribute__((address_space(3)))
typedef unsigned short bf16_t;
typedef short bf16x8 __attribute__((ext_vector_type(8)));
typedef float f32x4 __attribute__((ext_vector_type(4)));
typedef unsigned u32x4 __attribute__((ext_vector_type(4)));
constexpr int BM = 256, BK = 64, HALF = 128, HTB = HALF * BK * 2  , STAGE_BYTES = 8 * HTB, NXCD = 8, WGM = 8;

__host__ __device__ __forceinline__ int lds_byte(int r, int c) { const int st = (r >> 4) * 2 + (c >> 5), rr = r & 15, cc = c & 31, ob = rr * 64 + cc * 2; return st * 1024 + (ob ^ (((ob >> 9) & 1) << 5)); }
__host__ __device__ __forceinline__ void stage_rc(int b, int& R, int& C) { const int st = b / 1024, sb = b % 1024, swz = sb ^ (((sb >> 9) & 1) << 5); R = (st >> 1) * 16 + swz / 64; C = (st & 1) * 32 + (swz % 64) / 2; }
__host__ __device__ __forceinline__ int perm32(int rho) { const int n = rho >> 4, i = rho & 15; return 8 * (i >> 2) + 4 * n + (i & 3); }

struct Unit { int pm, pn; };
struct Gemm { const bf16_t* A; const bf16_t* Bt; int M, N, K; };

struct StaticOrder {
    int nM, nN, nwg, G, c;
    __host__ __device__ void init(int M, int N, int G_, int c_) { nM = M / BM; nN = N / BM; nwg = nM * nN; G = G_; c = c_; }
    __host__ __device__ bool next(int i, Unit& u) const {
        const long L = (long)i * G + c; if (L >= nwg) return false;
        int wgid = (int)L; { const int q = nwg / NXCD, r = nwg % NXCD, xcd = wgid % NXCD, off = wgid / NXCD; wgid = (xcd < r ? xcd * (q + 1) : r * (q + 1) + (xcd - r) * q) + off; }
        const int nig = WGM * nN, gid = wgid / nig, fm = gid * WGM, gsz = (nM - fm) < WGM ? (nM - fm) : WGM;
        u.pm = fm + ((wgid % nig) % gsz); u.pn = (wgid % nig) / gsz; return true;
    }
    __device__ __forceinline__ void a_ready(const Unit&) const {}
    __device__ __forceinline__ void done(const Unit&) const {}
};

template <class Epi, class Sched, bool ALIGN_EPI = false, bool SP2 = false>
__device__ __forceinline__ void gemm_phase(PG8_LAS unsigned char* lds, const Gemm g, const Sched& S, const Epi& E, const int wid  ) {
    const int lane = lane_id_v(), tid = wid * 64 + lane, wr = wid >> 2, wc = wid & 3, fr = lane & 15, fq = lane >> 4;
    const int K = g.K, nt = K / BK;
    unsigned voffA[2], voffB[2];
#pragma unroll
    for (int i = 0; i < 2; ++i) { int R, C; stage_rc(tid * 16 + i * 8192, R, C); const int Rb = Epi::PERM ? ((R & ~31) + perm32(R & 31)) : R;
        voffA[i] = (unsigned)(R * K + C) * 2u; voffB[i] = (unsigned)(Rb * K + C) * 2u; }
    const size_t kstep = (size_t)(BK * 2);
    const size_t hstep = (size_t)HALF * K * 2;
    const size_t tstep = 2 * hstep;
    const unsigned ldsw = (unsigned)wid * 1024u;
    const int aoff = lds_byte(wr * 64 + fr, fq * 8), boff = lds_byte(wc * 32 + fr, fq * 8);
#define PG8_SA(b, h) (((b) * 2 + (h)) * HTB)
#define PG8_SB(b, h) ((4 + (b) * 2 + (h)) * HTB)
#define PG8_STAGE(bufoff, gbase, voff) do { _Pragma("unroll") for (int _i = 0; _i < 2; ++_i) \
        __builtin_amdgcn_global_load_lds((const unsigned*)((const char*)(gbase) + (voff)[_i]), (PG8_LAS unsigned*)(lds + (bufoff) + ldsw + _i * 8192), 16, 0, 0); } while (0)
#define PG8_LDA(dst, b, h) do { _Pragma("unroll") for (int m = 0; m < 4; ++m) _Pragma("unroll") for (int k = 0; k < 2; ++k) dst[m][k] = *(const PG8_LAS bf16x8*)(lds + PG8_SA(b, h) + aoff + m * 2048 + k * 1024); } while (0)
#define PG8_LDB(dst, b, h) do { _Pragma("unroll") for (int n = 0; n < 2; ++n) _Pragma("unroll") for (int k = 0; k < 2; ++k) dst[n][k] = *(const PG8_LAS bf16x8*)(lds + PG8_SB(b, h) + boff + n * 2048 + k * 1024); } while (0)
#define PG8_MMA(ai, bj, At, Bt) do { __builtin_amdgcn_s_setprio(1); _Pragma("unroll") for (int m = 0; m < 4; ++m) _Pragma("unroll") for (int n = 0; n < 2; ++n) _Pragma("unroll") for (int k = 0; k < 2; ++k) \
        acc[ai][bj][m][n] = __builtin_amdgcn_mfma_f32_16x16x32_bf16(Bt[n][k], At[m][k], acc[ai][bj][m][n], 0, 0, 0); __builtin_amdgcn_s_setprio(0); } while (0)
#define PG8_WAIT_V(n) asm volatile("s_waitcnt vmcnt(" #n ")" ::: "memory")
#define PG8_WAIT_L(n) asm volatile("s_waitcnt lgkmcnt(" #n ")" ::: "memory")
#define PG8_BAR __builtin_amdgcn_s_barrier()
#define PG8_SCHED __builtin_amdgcn_sched_barrier(0)
    Unit cur, nxt; int ui = 0;
    if (!S.next(0, cur)) return;
    f32x4 acc[2][2][4][2];
#pragma unroll
    for (int a = 0; a < 2; ++a)
#pragma unroll
        for (int b = 0; b < 2; ++b)
#pragma unroll
            for (int m = 0; m < 4; ++m)
#pragma unroll
                for (int n = 0; n < 2; ++n) acc[a][b][m][n] = (f32x4){0.f, 0.f, 0.f, 0.f};
    bf16x8 At[4][2], B0[2][2], B1[2][2];
    const char* cA = (const char*)g.A + (size_t)cur.pm * tstep; const char* cB = (const char*)g.Bt + (size_t)cur.pn * tstep;
    S.a_ready(cur);
    if constexpr (SP2) {
        PG8_STAGE(PG8_SB(0, 0), cB, voffB); PG8_STAGE(PG8_SB(0, 1), cB + hstep, voffB); PG8_STAGE(PG8_SA(0, 0), cA, voffA); PG8_STAGE(PG8_SA(0, 1), cA + hstep, voffA);
        if (wr == 1) PG8_BAR;
        PG8_WAIT_V(2); PG8_BAR;
        PG8_STAGE(PG8_SB(1, 0), cB + kstep, voffB); PG8_STAGE(PG8_SA(1, 0), cA + kstep, voffA); PG8_STAGE(PG8_SB(1, 1), cB + hstep + kstep, voffB);
        PG8_WAIT_V(6); PG8_BAR;
    } else {
        PG8_STAGE(PG8_SB(0, 0), cB, voffB); PG8_STAGE(PG8_SA(0, 0), cA, voffA); PG8_STAGE(PG8_SB(0, 1), cB + hstep, voffB); PG8_STAGE(PG8_SA(0, 1), cA + hstep, voffA);
        if (wr == 1) PG8_BAR;
        PG8_WAIT_V(4); PG8_BAR;
        PG8_STAGE(PG8_SB(1, 0), cB + kstep, voffB); PG8_STAGE(PG8_SA(1, 0), cA + kstep, voffA); PG8_STAGE(PG8_SB(1, 1), cB + hstep + kstep, voffB);
        PG8_WAIT_V(6); PG8_BAR;
    }
    for (;;) {
        const bool has_next = S.next(ui + 1, nxt);
        const char* nA = has_next ? (const char*)g.A + (size_t)nxt.pm * tstep : cA; const char* nB = has_next ? (const char*)g.Bt + (size_t)nxt.pn * tstep : cB;
        for (int t = 0; t < nt; t += 2) {
            const bool last = (t == nt - 2);
            const char* a1 = cA + (size_t)(t + 1) * kstep;
            const char* a2 = last ? nA : cA + (size_t)(t + 2) * kstep; const char* b2 = last ? nB : cB + (size_t)(t + 2) * kstep;
            const char* a3 = a2 + kstep; const char* b3 = b2 + kstep;
            if (last && has_next) S.a_ready(nxt);
            if constexpr (SP2) {
            PG8_LDB(B0, 0, 0); PG8_LDB(B1, 0, 1); PG8_SCHED; PG8_LDA(At, 0, 0); PG8_STAGE(PG8_SA(1, 1), a1 + hstep, voffA);
            PG8_WAIT_V(8); PG8_WAIT_L(0); PG8_BAR; PG8_MMA(0, 0, At, B0); PG8_MMA(0, 1, At, B1); PG8_BAR; PG8_SCHED;
            PG8_LDA(At, 0, 1); PG8_STAGE(PG8_SB(0, 0), b2, voffB); PG8_STAGE(PG8_SB(0, 1), b2 + hstep, voffB); PG8_STAGE(PG8_SA(0, 0), a2, voffA);
            PG8_WAIT_V(8); PG8_WAIT_L(0); PG8_BAR; PG8_MMA(1, 0, At, B0); PG8_MMA(1, 1, At, B1); PG8_BAR; PG8_SCHED;
            PG8_LDB(B0, 1, 0); PG8_LDB(B1, 1, 1); PG8_SCHED; PG8_LDA(At, 1, 0); PG8_STAGE(PG8_SA(0, 1), a2 + hstep, voffA);
            PG8_WAIT_V(8); PG8_WAIT_L(0); PG8_BAR; PG8_MMA(0, 0, At, B0); PG8_MMA(0, 1, At, B1); PG8_BAR; PG8_SCHED;
            PG8_LDA(At, 1, 1); PG8_STAGE(PG8_SB(1, 0), b3, voffB); PG8_STAGE(PG8_SB(1, 1), b3 + hstep, voffB); PG8_STAGE(PG8_SA(1, 0), a3, voffA);
            PG8_WAIT_V(8); PG8_WAIT_L(0); PG8_BAR; PG8_MMA(1, 0, At, B0); PG8_MMA(1, 1, At, B1); PG8_BAR; PG8_SCHED;
            } else {
            PG8_LDB(B0, 0, 0); PG8_SCHED; PG8_LDA(At, 0, 0); PG8_STAGE(PG8_SA(1, 1), a1 + hstep, voffA);
            PG8_WAIT_L(8); PG8_BAR; PG8_WAIT_L(0); PG8_MMA(0, 0, At, B0); PG8_BAR; PG8_SCHED;
            PG8_LDB(B1, 0, 1); PG8_STAGE(PG8_SB(0, 0), b2, voffB);
            PG8_BAR; PG8_WAIT_L(0); PG8_MMA(0, 1, At, B1); PG8_BAR;
            PG8_LDA(At, 0, 1); PG8_STAGE(PG8_SA(0, 0), a2, voffA);
            PG8_BAR; PG8_WAIT_L(0); PG8_MMA(1, 0, At, B0); PG8_BAR; PG8_SCHED;
            PG8_STAGE(PG8_SB(0, 1), b2 + hstep, voffB);
            PG8_WAIT_V(6); PG8_BAR; PG8_MMA(1, 1, At, B1); PG8_BAR;
            PG8_LDB(B0, 1, 0); PG8_SCHED; PG8_LDA(At, 1, 0); PG8_STAGE(PG8_SA(0, 1), a2 + hstep, voffA);
            PG8_WAIT_L(8); PG8_BAR; PG8_WAIT_L(0); PG8_MMA(0, 0, At, B0); PG8_BAR; PG8_SCHED;
            PG8_LDB(B1, 1, 1); PG8_STAGE(PG8_SB(1, 0), b3, voffB);
            PG8_BAR; PG8_WAIT_L(0); PG8_MMA(0, 1, At, B1); PG8_BAR;
            PG8_LDA(At, 1, 1); PG8_STAGE(PG8_SA(1, 0), a3, voffA);
            PG8_BAR; PG8_WAIT_L(0); PG8_MMA(1, 0, At, B0); PG8_BAR; PG8_SCHED;
            PG8_STAGE(PG8_SB(1, 1), b3 + hstep, voffB);
            PG8_WAIT_V(6); PG8_BAR; PG8_MMA(1, 1, At, B1); PG8_BAR;
            }
        }
        if constexpr (ALIGN_EPI) { if (wr == 0) PG8_BAR; }
        if constexpr (!Epi::AFTER_DRAIN) { E(acc, cur, wr, wc, fr, fq); S.done(cur); }
        if (!has_next) break;
#pragma unroll
        for (int a = 0; a < 2; ++a)
#pragma unroll
            for (int b = 0; b < 2; ++b)
#pragma unroll
                for (int m = 0; m < 4; ++m)
#pragma unroll
                    for (int n = 0; n < 2; ++n) acc[a][b][m][n] = (f32x4){0.f, 0.f, 0.f, 0.f};
        cur = nxt; cA = nA; cB = nB; ++ui;
        if constexpr (ALIGN_EPI) { if (wr == 1) PG8_BAR; }
    }
    PG8_WAIT_V(0);
    if constexpr (!ALIGN_EPI) { if (wr == 0) PG8_BAR; }
    PG8_BAR;
    if constexpr (Epi::AFTER_DRAIN) { E.fused(acc, cur, wr, wc, fr, fq, lds, wid, lane); S.done(cur); }
#undef PG8_SA
#undef PG8_SB
#undef PG8_STAGE
#undef PG8_LDA
#undef PG8_LDB
#undef PG8_MMA
#undef PG8_WAIT_V
#undef PG8_WAIT_L
#undef PG8_BAR
#undef PG8_SCHED
}
}
constexpr int DM = 1024, NB = 8, SEQ = 8192, CTX = 256, SKV = SEQ + CTX;
constexpr int MLAT = NB * SEQ, MALL = MLAT + NB * CTX;
constexpr int NINP = 5376;
typedef unsigned short bf16_t;
typedef short bf16x8 __attribute__((ext_vector_type(8)));
typedef short s16x4 __attribute__((ext_vector_type(4)));
typedef float f32x16 __attribute__((ext_vector_type(16)));
typedef float f32x4 __attribute__((ext_vector_type(4)));
typedef unsigned u32x4 __attribute__((ext_vector_type(4)));
typedef unsigned u32x2 __attribute__((ext_vector_type(2)));
#define LAS __attribute__((address_space(3)))
#define SBAR() __builtin_amdgcn_sched_barrier(0)
typedef float f32x2_t __attribute__((ext_vector_type(2)));
typedef __bf16 bf16x2_t __attribute__((ext_vector_type(2)));
__device__ __forceinline__ unsigned cvtpk(float lo, float hi) { f32x2_t v = {lo, hi}; bf16x2_t b = __builtin_convertvector(v, bf16x2_t); return __builtin_bit_cast(unsigned, b); }
__device__ __forceinline__ unsigned cvtpk_a(float lo, float hi) { unsigned r; asm volatile("v_cvt_pk_bf16_f32 %0, %1, %2" : "=v"(r) : "v"(lo), "v"(hi)); return r; }
__device__ __forceinline__ unsigned f2bf(float f) { unsigned u = __builtin_bit_cast(unsigned, f); return (u + 0x7fffu + ((u >> 16) & 1u)) >> 16; }
__device__ __forceinline__ float bf2f(unsigned short b) { return __builtin_bit_cast(float, (unsigned)b << 16); }
__device__ __forceinline__ float bflo(unsigned w) { return __builtin_bit_cast(float, w << 16); }
__device__ __forceinline__ float bfhi(unsigned w) { return __builtin_bit_cast(float, w & 0xffff0000u); }
__device__ __forceinline__ float sigmoidf_(float v) { return 1.f / (1.f + __expf(-v)); }
__device__ __forceinline__ float sigmoid_fast(float v) { return __builtin_amdgcn_rcpf(1.f + __builtin_amdgcn_exp2f(-1.4426950408889634f * v)); }
__device__ __forceinline__ float wave_sum(float v) {
#pragma unroll
    for (int o = 1; o < 64; o <<= 1) v += shflx(v, o);
    return v;
}

namespace att {
#ifndef PROBE_NOLOAD
#define PROBE_NOLOAD 0
#endif
template <bool MLA> struct Cfg {
    static constexpr int DQK = MLA ? 96 : 64, DV = MLA ? 64 : 128, NQ = DQK / 16, NCB = DV / 32;
    static constexpr int KROWB = MLA ? 272 : 144;
    static constexpr int LDQ = MLA ? 768 : 512, LDK = MLA ? 768 : 512, LDV = 512;
    static constexpr int SHM_V = 64 * DV * 2, SHM_K = 64 * KROWB;
};
constexpr float THR = 8.f;
__device__ __forceinline__ int crow(int r, int hi) { return (r & 3) + 8 * (r >> 2) + 4 * hi; }
template <bool MLA> __device__ __forceinline__ int kswz(int row, int colB) { return row * Cfg<MLA>::KROWB + colB; }
__device__ __forceinline__ float max3f(float a, float b, float c) { return __builtin_fmaxf(__builtin_fmaxf(a, b), c); }
__device__ __forceinline__ void rowmax_adjust(f32x16& p0, f32x16& p1, float& m2, f32x16& negm, float& alpha, const bool first) {
    constexpr float THR2 = THR * 1.4426950408889634f;
    float pmax = max3f(p0[0], p0[1], p0[2]);
#pragma unroll
    for (int r = 3; r < 15; r += 2) pmax = max3f(pmax, p0[r], p0[r + 1]);
    pmax = max3f(pmax, p0[15], p1[0]);
#pragma unroll
    for (int r = 1; r < 15; r += 2) pmax = max3f(pmax, p1[r], p1[r + 1]);
    pmax = fmaxf(pmax, p1[15]);
    { auto rr = __builtin_amdgcn_permlane32_swap(__float_as_uint(pmax), __float_as_uint(pmax), false, false);
      pmax = fmaxf(__uint_as_float(rr[0]), __uint_as_float(rr[1])); }
    if (!first && __builtin_expect(__all(pmax <= THR2), 1)) { alpha = 1.f; }
    else {
        const float delta = first ? pmax : fmaxf(pmax, 0.f);
        alpha = first ? 1.f : __builtin_amdgcn_exp2f(-delta);
        m2 += delta;
#pragma unroll
        for (int r = 0; r < 16; ++r) { p0[r] -= delta; p1[r] -= delta; }
        const float nm = -m2;
#pragma unroll
        for (int r = 0; r < 16; ++r) asm volatile("v_mov_b32 %0, %1" : "+v"(negm[r]) : "v"(nm));
    }
}
__device__ __forceinline__ float exp_pack(f32x16& p0, f32x16& p1, bf16x8& pa0, bf16x8& pa1, bf16x8& pa2, bf16x8& pa3) {
#pragma unroll
    for (int r = 0; r < 16; ++r) p0[r] = __builtin_amdgcn_exp2f(p0[r]);
#pragma unroll
    for (int r = 0; r < 16; ++r) p1[r] = __builtin_amdgcn_exp2f(p1[r]);
    SBAR(); asm volatile("s_nop 1" ::: "memory"); SBAR();
#define PK4(P, BASE, OUT) do { unsigned a0 = cvtpk_a(P[BASE + 0], P[BASE + 1]), a1 = cvtpk_a(P[BASE + 2], P[BASE + 3]);   \
    unsigned b0 = cvtpk_a(P[BASE + 4], P[BASE + 5]), b1 = cvtpk_a(P[BASE + 6], P[BASE + 7]);                              \
    auto r0 = __builtin_amdgcn_permlane32_swap(a0, b0, false, false); auto r1 = __builtin_amdgcn_permlane32_swap(a1, b1, false, false); \
    u32x4 w = {r0[0], r1[0], r0[1], r1[1]}; OUT = *reinterpret_cast<bf16x8*>(&w); } while (0)
    PK4(p0, 0, pa0); PK4(p0, 8, pa1); PK4(p1, 0, pa2); PK4(p1, 8, pa3);
#undef PK4
    float ps0 = p0[0], ps1 = p1[0];
#pragma unroll
    for (int r = 1; r < 16; ++r) { ps0 += p0[r]; ps1 += p1[r]; }
    float ps = ps0 + ps1;
    { auto rr = __builtin_amdgcn_permlane32_swap(__float_as_uint(ps), __float_as_uint(ps), false, false);
      ps = __uint_as_float(rr[0]) + __uint_as_float(rr[1]); }
    return ps;
}
template <bool MLA> __device__ __forceinline__ void qkt(f32x16& p0, f32x16& p1, const char* Ks, const bf16x8* qr, const f32x16& negm, int r32, int hi) {
    constexpr int NQ = Cfg<MLA>::NQ;
    bf16x8 kf[2 * NQ];
#pragma unroll
    for (int d0 = 0; d0 < NQ; ++d0) { const int cb = (d0 * 16 + hi * 8) * 2;
        kf[2 * d0] = *reinterpret_cast<const bf16x8*>(Ks + kswz<MLA>(r32, cb));
        kf[2 * d0 + 1] = *reinterpret_cast<const bf16x8*>(Ks + kswz<MLA>(32 + r32, cb)); }
    SBAR();
    p0 = negm; p1 = negm;
#pragma unroll
    for (int d0 = 0; d0 < NQ; ++d0) {
        p0 = __builtin_amdgcn_mfma_f32_32x32x16_bf16(kf[2 * d0], qr[d0], p0, 0, 0, 0);
        p1 = __builtin_amdgcn_mfma_f32_32x32x16_bf16(kf[2 * d0 + 1], qr[d0], p1, 0, 0, 0); }
}
template <int NCB> __device__ __forceinline__ int v_st(int k, int c) { const int kk = (k & ~0xC) | ((k & 4) << 1) | ((k & 8) >> 1); return ((kk >> 3) * NCB + (c >> 5)) * 512 + ((kk & 7) * 32 + (c & 31)) * 2; }
__device__ __forceinline__ int v_rd_base(int lane) { return ((lane & 3) << 3) | (((lane >> 2) & 3) << 6) | (((lane >> 4) & 1) << 5) | (((lane >> 5) & 1) << 8); }
template <int NCB> constexpr int v_rd_off(int d0, int ks, int half) { return d0 * 512 + (ks * 2 + half) * NCB * 512; }
template <int OFF> __device__ __forceinline__ s16x4 tr_read(int vb) {
    s16x4 r; asm volatile("ds_read_b64_tr_b16 %0, %1 offset:%2" : "=&v"(r) : "v"(vb), "i"(OFF) : "memory"); return r;
}
template <int NCB, int D0> __device__ __forceinline__ void pv_one(f32x16& od, int vb, bf16x8 pa0, bf16x8 pa1, bf16x8 pa2, bf16x8 pa3) {
    const s16x4 l0 = tr_read<v_rd_off<NCB>(D0, 0, 0)>(vb), h0 = tr_read<v_rd_off<NCB>(D0, 0, 1)>(vb), l1 = tr_read<v_rd_off<NCB>(D0, 1, 0)>(vb), h1 = tr_read<v_rd_off<NCB>(D0, 1, 1)>(vb);
    const s16x4 l2 = tr_read<v_rd_off<NCB>(D0, 2, 0)>(vb), h2 = tr_read<v_rd_off<NCB>(D0, 2, 1)>(vb), l3 = tr_read<v_rd_off<NCB>(D0, 3, 0)>(vb), h3 = tr_read<v_rd_off<NCB>(D0, 3, 1)>(vb);
    asm volatile("s_waitcnt lgkmcnt(0)" ::: "memory"); SBAR();
#define PK(L, H) (bf16x8){L[0], L[1], L[2], L[3], H[0], H[1], H[2], H[3]}
    od = __builtin_amdgcn_mfma_f32_32x32x16_bf16(pa0, PK(l0, h0), od, 0, 0, 0);
    od = __builtin_amdgcn_mfma_f32_32x32x16_bf16(pa1, PK(l1, h1), od, 0, 0, 0);
    od = __builtin_amdgcn_mfma_f32_32x32x16_bf16(pa2, PK(l2, h2), od, 0, 0, 0);
    od = __builtin_amdgcn_mfma_f32_32x32x16_bf16(pa3, PK(l3, h3), od, 0, 0, 0);
#undef PK
}
template <int NCB> __device__ __forceinline__ void pv_all(f32x16* o, int vb, bf16x8 pa0, bf16x8 pa1, bf16x8 pa2, bf16x8 pa3) {
    pv_one<NCB, 0>(o[0], vb, pa0, pa1, pa2, pa3); pv_one<NCB, 1>(o[1], vb, pa0, pa1, pa2, pa3);
    if constexpr (NCB == 4) { pv_one<NCB, 2>(o[2], vb, pa0, pa1, pa2, pa3); pv_one<NCB, 3>(o[3], vb, pa0, pa1, pa2, pa3); }
}

template <int NCB, int D0> __device__ __forceinline__ void v_frag_read(s16x4 (&f)[8], int vb) {
    f[0] = tr_read<v_rd_off<NCB>(D0, 0, 0)>(vb); f[1] = tr_read<v_rd_off<NCB>(D0, 0, 1)>(vb); f[2] = tr_read<v_rd_off<NCB>(D0, 1, 0)>(vb); f[3] = tr_read<v_rd_off<NCB>(D0, 1, 1)>(vb);
    f[4] = tr_read<v_rd_off<NCB>(D0, 2, 0)>(vb); f[5] = tr_read<v_rd_off<NCB>(D0, 2, 1)>(vb); f[6] = tr_read<v_rd_off<NCB>(D0, 3, 0)>(vb); f[7] = tr_read<v_rd_off<NCB>(D0, 3, 1)>(vb);
}
__device__ __forceinline__ void pv_mma(f32x16& od, const s16x4 (&f)[8], bf16x8 pa0, bf16x8 pa1, bf16x8 pa2, bf16x8 pa3) {
#define PK(L, H) (bf16x8){L[0], L[1], L[2], L[3], H[0], H[1], H[2], H[3]}
    od = __builtin_amdgcn_mfma_f32_32x32x16_bf16(pa0, PK(f[0], f[1]), od, 0, 0, 0);
    od = __builtin_amdgcn_mfma_f32_32x32x16_bf16(pa1, PK(f[2], f[3]), od, 0, 0, 0);
    od = __builtin_amdgcn_mfma_f32_32x32x16_bf16(pa2, PK(f[4], f[5]), od, 0, 0, 0);
    od = __builtin_amdgcn_mfma_f32_32x32x16_bf16(pa3, PK(f[6], f[7]), od, 0, 0, 0);
#undef PK
}
__device__ __forceinline__ void pv_mma2(f32x16& oa, f32x16& ob, const s16x4 (&f)[8], const s16x4 (&h)[8], bf16x8 pa0, bf16x8 pa1, bf16x8 pa2, bf16x8 pa3) {
#define PK(L, H) (bf16x8){L[0], L[1], L[2], L[3], H[0], H[1], H[2], H[3]}
    oa = __builtin_amdgcn_mfma_f32_32x32x16_bf16(pa0, PK(f[0], f[1]), oa, 0, 0, 0); ob = __builtin_amdgcn_mfma_f32_32x32x16_bf16(pa0, PK(h[0], h[1]), ob, 0, 0, 0);
    oa = __builtin_amdgcn_mfma_f32_32x32x16_bf16(pa1, PK(f[2], f[3]), oa, 0, 0, 0); ob = __builtin_amdgcn_mfma_f32_32x32x16_bf16(pa1, PK(h[2], h[3]), ob, 0, 0, 0);
    oa = __builtin_amdgcn_mfma_f32_32x32x16_bf16(pa2, PK(f[4], f[5]), oa, 0, 0, 0); ob = __builtin_amdgcn_mfma_f32_32x32x16_bf16(pa2, PK(h[4], h[5]), ob, 0, 0, 0);
    oa = __builtin_amdgcn_mfma_f32_32x32x16_bf16(pa3, PK(f[6], f[7]), oa, 0, 0, 0); ob = __builtin_amdgcn_mfma_f32_32x32x16_bf16(pa3, PK(h[6], h[7]), ob, 0, 0, 0);
#undef PK
}
#define LWAIT0() do { asm volatile("s_waitcnt lgkmcnt(0)" ::: "memory"); SBAR(); } while (0)
template <bool MLA>
__device__ __forceinline__ void attn_core(const bf16_t* __restrict__ Qb, const bf16_t* __restrict__ Kh, const bf16_t* __restrict__ Vh, int seq, char* lds,
                                          f32x16 (&o)[Cfg<MLA>::NCB], const int wid  , const int g  ) {
    using CF = Cfg<MLA>;
    constexpr int NQ = CF::NQ, NCB = CF::NCB, SHM_V = CF::SHM_V, SHM_K = CF::SHM_K, LDQ = CF::LDQ, LDK = CF::LDK, LDV = CF::LDV;
    const int lane = lane_id_v(), tid = wid * 64 + lane, r32 = lane & 31, hi = lane >> 5;
    char* V_lds = lds; char* K_lds = lds + 4 * SHM_V;
    float* wsp = (float*)(lds + 93184) + wid * 64; float* li_l = wsp; float* al_l = wsp + 32;
    float m2 = 0.f, l_reg = 0.f; f32x16 negm = f32x16{}; bf16x8 qr[NQ];
#pragma unroll
    for (int d = 0; d < NCB; ++d) o[d] = f32x16{};
    const bf16_t* Qw = Qb + (long)(wid * 32 + r32) * LDQ + hi * 8;
#pragma unroll
    for (int d0 = 0; d0 < NQ; ++d0) qr[d0] = *reinterpret_cast<const bf16x8*>(Qw + d0 * 16);
    const int vr0 = MLA ? (tid >> 3) : (tid >> 4), vc0 = MLA ? (tid & 7) * 8 : (tid & 15) * 8;
    const int vst0 = v_st<NCB>(vr0, vc0), vst1 = v_st<NCB>(32 + vr0, vc0);
    const int kcA = tid, krA = MLA ? (kcA / 12) : (tid >> 3), kcolA = MLA ? (kcA % 12) * 8 : (tid & 7) * 8;
    const int kcB = 512 + (tid & 255), krB = kcB / 12, kcolB = (kcB % 12) * 8;
    const int kstA = kswz<MLA>(krA, kcolA * 2), kstB = kswz<MLA>(krB, kcolB * 2);
    const int vb0 = (int)(uintptr_t)V_lds + v_rd_base(lane);
    struct { bf16x8 a, b, c; } sr_[2];
    const unsigned goA = MLA ? (unsigned)(vr0 * LDV + vc0) * 2u : (unsigned)(vr0 * LDV + vc0) * 2u;
    const unsigned goB = MLA ? (unsigned)(krA * LDK + kcolA) * 2u : (unsigned)((32 + vr0) * LDV + vc0) * 2u;
    const unsigned goC = MLA ? (unsigned)(krB * LDK + kcolB) * 2u : (unsigned)(krA * LDK + kcolA) * 2u;
#define SLOAD(i, k0) do { const char* kt_ = (const char*)(Kh + (size_t)(k0) * LDK); const char* vt_ = (const char*)(Vh + (size_t)(k0) * LDV); \
    if constexpr (MLA) { \
        sr_[i].a = *reinterpret_cast<const bf16x8*>(vt_ + goA); sr_[i].b = *reinterpret_cast<const bf16x8*>(kt_ + goB); sr_[i].c = *reinterpret_cast<const bf16x8*>(kt_ + goC); \
    } else { \
        sr_[i].a = *reinterpret_cast<const bf16x8*>(vt_ + goA); sr_[i].b = *reinterpret_cast<const bf16x8*>(vt_ + goB); sr_[i].c = *reinterpret_cast<const bf16x8*>(kt_ + goC); } } while (0)
#define SWRITE(ko, vo, i) do { if constexpr (MLA) { \
        *(bf16x8*)(V_lds + (vo) + vst0) = sr_[i].a; \
        *(bf16x8*)(K_lds + (ko) + kstA) = sr_[i].b; \
        if (wid < 4) *(bf16x8*)(K_lds + (ko) + kstB) = sr_[i].c; \
    } else { \
        *(bf16x8*)(V_lds + (vo) + vst0) = sr_[i].a; \
        *(bf16x8*)(V_lds + (vo) + vst1) = sr_[i].b; \
        *(bf16x8*)(K_lds + (ko) + kstA) = sr_[i].c; } } while (0)
#define SWAIT() asm volatile("s_waitcnt vmcnt(3)" ::: "memory")
#define RESC(a) do { if (__any((a) < 1.f)) { if (hi == 0) al_l[r32] = (a); asm volatile("s_waitcnt lgkmcnt(0)" ::: "memory"); \
    _Pragma("unroll") for (int r = 0; r < 16; ++r) { const float al_ = al_l[crow(r, hi)]; _Pragma("unroll") for (int d = 0; d < NCB; ++d) o[d][r] *= al_; } } } while (0)
    f32x16 S0, S1; float alpha = 1.f; bf16x8 pa0, pa1, pa2, pa3; const int NT = seq / 64;
    constexpr int SE = 0, SO = 1;
#define MSEG(j) do { const int j_ = (j); const bool doqk = j_ < NT, dopv = j_ > 0; \
        const char* Ks_ = K_lds + (j_ % 3) * SHM_K; const int vb_ = vb0 + ((j_ - 1) & 3) * SHM_V; \
        bf16x8 kf[2 * NQ]; s16x4 fa[8], fb[8]; \
        if (doqk) { _Pragma("unroll") for (int d0 = 0; d0 < NQ; ++d0) { const int cb = (d0 * 16 + hi * 8) * 2; \
            kf[2 * d0] = *reinterpret_cast<const bf16x8*>(Ks_ + kswz<MLA>(r32, cb)); kf[2 * d0 + 1] = *reinterpret_cast<const bf16x8*>(Ks_ + kswz<MLA>(32 + r32, cb)); } } \
        if (dopv) { v_frag_read<NCB, 0>(fa, vb_); if constexpr (NCB == 2) v_frag_read<NCB, 1>(fb, vb_); }     \
        SBAR(); \
        if (doqk) { S0 = negm; S1 = negm; _Pragma("unroll") for (int d0 = 0; d0 < NQ; ++d0) { \
            S0 = __builtin_amdgcn_mfma_f32_32x32x16_bf16(kf[2 * d0], qr[d0], S0, 0, 0, 0); S1 = __builtin_amdgcn_mfma_f32_32x32x16_bf16(kf[2 * d0 + 1], qr[d0], S1, 0, 0, 0); } } \
        if (dopv) { if constexpr (NCB == 4) { SBAR(); v_frag_read<NCB, 1>(fb, vb_); }     \
            LWAIT0(); \
            if constexpr (NCB == 4) { pv_mma2(o[0], o[1], fa, fb, pa0, pa1, pa2, pa3); SBAR(); v_frag_read<NCB, 2>(fa, vb_); v_frag_read<NCB, 3>(fb, vb_); \
                LWAIT0(); pv_mma2(o[2], o[NCB - 1], fa, fb, pa0, pa1, pa2, pa3); } \
            else { pv_mma2(o[0], o[1], fa, fb, pa0, pa1, pa2, pa3); } } } while (0)
#define VSEG(j) do { rowmax_adjust(S0, S1, m2, negm, alpha, (j) == 0); RESC(alpha); l_reg = l_reg * alpha + exp_pack(S0, S1, pa0, pa1, pa2, pa3); } while (0)
    __syncthreads();
    SLOAD(SE, 0); SLOAD(SO, 64); asm volatile("s_waitcnt vmcnt(0)" ::: "memory");
    SWRITE(0, 0, SE); SWRITE(SHM_K, SHM_V, SO);
    SLOAD(SE, 2 * 64); SLOAD(SO, 3 * 64);
    __syncthreads();
    { int g_ = g; asm volatile("" : "+s"(g_)); if (g_ == 1) __syncthreads(); }
    for (int j = 0; j < NT; j += 2) {
        SBAR(); MSEG(j); SBAR();
        __syncthreads();
        SBAR(); VSEG(j);
        SWAIT(); if (j + 2 < NT) SWRITE(((j + 2) % 3) * SHM_K, ((j + 2) & 3) * SHM_V, SE);
        if (!(MLA && PROBE_NOLOAD)) { const int tn = (j + 4 < NT) ? j + 4 : NT - 1; SLOAD(SE, tn * 64); } SBAR();
        __syncthreads();
        SBAR(); MSEG(j + 1); SBAR();
        __syncthreads();
        SBAR(); VSEG(j + 1);
        SWAIT(); if (j + 3 < NT) SWRITE(((j + 3) % 3) * SHM_K, ((j + 3) & 3) * SHM_V, SO);
        if (!(MLA && PROBE_NOLOAD)) { const int tn = (j + 5 < NT) ? j + 5 : NT - 1; SLOAD(SO, tn * 64); } SBAR();
        __syncthreads();
    }
    SBAR(); MSEG(NT); SBAR();
    { int g_ = g; asm volatile("" : "+s"(g_)); if (g_ == 0) __syncthreads(); }
#undef MSEG
#undef VSEG
    asm volatile("s_waitcnt vmcnt(0)" ::: "memory");
    if (hi == 0) li_l[r32] = l_reg; asm volatile("s_waitcnt lgkmcnt(0)" ::: "memory");
#pragma unroll
    for (int r = 0; r < 16; ++r) { const float rl = __builtin_amdgcn_rcpf(li_l[crow(r, hi)]);
#pragma unroll
        for (int d = 0; d < NCB; ++d) o[d][r] *= rl; }
#undef SLOAD
#undef SWRITE
#undef SWAIT
#undef RESC
}
}
typedef float2 cs_t;
__device__ __forceinline__ void store8(bf16_t* p, f32x4 v0, f32x4 v1) {
    u32x4 w; w.x = cvtpk(v0[0], v0[1]); w.y = cvtpk(v0[2], v0[3]); w.z = cvtpk(v1[0], v1[1]); w.w = cvtpk(v1[2], v1[3]);
    *(u32x4*)p = w;
}
__device__ __forceinline__ float dot8(f32x4 v0, f32x4 v1) { return (v0[0] * v0[0] + v0[1] * v0[1]) + (v0[2] * v0[2] + v0[3] * v0[3]) + (v1[0] * v1[0] + v1[1] * v1[1]) + (v1[2] * v1[2] + v1[3] * v1[3]); }
__device__ __forceinline__ void rope64(f32x4& v0, f32x4& v1, const cs_t* __restrict__ CS16, int gr, int gc, int wc, int fq, bool apply) {
    f32x4 p0, p1; const int ix = (lane_id_v() ^ 32) << 2;
#pragma unroll
    for (int j = 0; j < 4; ++j) { p0[j] = shfli(v0[j], ix); p1[j] = shfli(v1[j], ix); }
    if (apply) {
        const int pos = (wc & 1) ? gc : gr; const cs_t* t = CS16 + pos * 16 + 8 * (fq & 1);
        const float sg = (fq < 2) ? -1.f : 1.f;
#pragma unroll
        for (int j = 0; j < 4; ++j) { const cs_t a = t[j], b = t[4 + j];
            v0[j] = v0[j] * a.x + sg * p0[j] * a.y; v1[j] = v1[j] * b.x + sg * p1[j] * b.y; }
    }
}
__device__ __forceinline__ void rope32(f32x4& v0, f32x4& v1, const cs_t* __restrict__ CS8, int gr, int gc, int g, bool apply) {
    f32x4 p0, p1; const int ix = (lane_id_v() ^ 16) << 2;
#pragma unroll
    for (int j = 0; j < 4; ++j) { p0[j] = shfli(v0[j], ix); p1[j] = shfli(v1[j], ix); }
    if (apply) {
        const int pos = (g >= 2) ? gc : gr; const cs_t* t = CS8 + pos * 8;
        const float sg = (g & 1) ? 1.f : -1.f;
#pragma unroll
        for (int j = 0; j < 4; ++j) { const cs_t a = t[j], b = t[4 + j];
            v0[j] = v0[j] * a.x + sg * p0[j] * a.y; v1[j] = v1[j] * b.x + sg * p1[j] * b.y; }
    }
}
#define EPI_ARGS const pg8::f32x4 (&acc)[2][2][4][2], const pg8::Unit& u, int wr, int wc, int fr, int fq
#define EPI_RECOMPUTE { const int l_ = lane_id_v(); fr = l_ & 15; fq = l_ >> 4; }

struct EpiP1 {
    static constexpr bool PERM = true, AFTER_DRAIN = false;
    bf16_t *CKV, *CQ, *KMLA, *GA, *DQ, *DK, *DV, *GD, *MG; float *SSKV, *SSQ; const cs_t *CS16, *CS8; bool do_stats;
    __device__ __forceinline__ void operator()(EPI_ARGS) const {
        EPI_RECOMPUTE
        const int pm = u.pm, pn = u.pn; const bool lat = pm < 256;
        if (!lat && !(pn == 0 || pn == 2 || (pn >= 7 && pn <= 10))) return;
        const int row0 = pm * 256 + wr * 64 + fr;
        const int kv0 = (lat ? (pm >> 5) * SKV + CTX + (pm & 31) * 256 : (pm - 256) * SKV) + wr * 64 + fr;
        const int lcw = wc * 32 + 8 * fq;
#pragma unroll
        for (int ai = 0; ai < 2; ++ai)
#pragma unroll
            for (int m = 0; m < 4; ++m) {
                __builtin_amdgcn_sched_barrier(0); const int row = opq(row0 + ai * 128 + m * 16), kvrow = kv0 + (row - row0);
                const int s = row & (SEQ - 1), gr = s >> 6, gc = s & 63;
                float ssq = 0.f;
#pragma unroll
                for (int bj = 0; bj < 2; ++bj) {
                    f32x4 v0 = acc[ai][bj][m][0], v1 = acc[ai][bj][m][1]; const int lc = bj * 128 + lcw;
                    if (pn == 0) { ssq += dot8(v0, v1); store8(CKV + (size_t)kvrow * 256 + lc, v0, v1); }
                    else if (pn == 1) { ssq += dot8(v0, v1); store8(CQ + (size_t)row * 384 + lc, v0, v1); }
                    else if (pn == 2) {
                        if (bj == 0) { if (lat) { ssq += dot8(v0, v1); store8(CQ + (size_t)row * 384 + 256 + lc, v0, v1); } }
                        else if (wc == 0) { rope32(v0, v1, CS8, gr, gc, fq, lat);
#pragma unroll
                            for (int h = 0; h < 8; ++h) store8(KMLA + (size_t)kvrow * 768 + h * 96 + 64 + 8 * fq, v0, v1); }
                    }
                    else if (pn <= 4 || pn == 11 || pn == 12) {
#pragma unroll
                        for (int j = 0; j < 4; ++j) { v0[j] = v0[j] * sigmoid_fast(v0[j]); v1[j] = v1[j] * sigmoid_fast(v1[j]); }
                        bf16_t* dst = (pn <= 4) ? GA + (size_t)row * 512 + (pn - 3) * 256 + lc : GD + (size_t)row * 512 + (pn - 11) * 256 + lc;
                        store8(dst, v0, v1);
                    }
                    else if (pn <= 6) { v0 = v0 * 0.18033688011112042f; v1 = v1 * 0.18033688011112042f;
                        rope64(v0, v1, CS16, gr, gc, wc, fq, true); store8(DQ + (size_t)row * 512 + (pn - 5) * 256 + lc, v0, v1); }
                    else if (pn <= 8) { rope64(v0, v1, CS16, gr, gc, wc, fq, lat); store8(DK + (size_t)kvrow * 512 + (pn - 7) * 256 + lc, v0, v1); }
                    else if (pn <= 10) { store8(DV + (size_t)kvrow * 512 + (pn - 9) * 256 + lc, v0, v1); }
                    else {
#pragma unroll
                        for (int j = 0; j < 4; ++j) { v0[j] = sigmoid_fast(v0[j]); v1[j] = sigmoid_fast(v1[j]); }
                        store8(MG + (size_t)row * 2048 + (pn - 13) * 256 + lc, v0, v1);
                    }
                }
                if (pn <= 2) {
                    ssq += shflx(ssq, 16); ssq += shflx(ssq, 32);
                    if (fq == 0) { if (pn == 0) SSKV[(size_t)kvrow * 4 + wc] = ssq; else if (lat) SSQ[(size_t)row * 8 + (pn - 1) * 4 + wc] = ssq; }
                }
            }
    }
};
struct EpiQ {
    static constexpr bool PERM = true, AFTER_DRAIN = false;
    bf16_t* QMLA; const float* SSQ; const cs_t* CS8;
    __device__ __forceinline__ void operator()(EPI_ARGS) const {
        EPI_RECOMPUTE
        const int row0 = u.pm * 256 + wr * 64 + fr;
#pragma unroll
        for (int ai = 0; ai < 2; ++ai)
#pragma unroll
            for (int m = 0; m < 4; ++m) {
                __builtin_amdgcn_sched_barrier(0); const int row = opq(row0 + ai * 128 + m * 16); const int s = row & (SEQ - 1), gr = s >> 6, gc = s & 63;
                const f32x4 sa = *(const f32x4*)(SSQ + (size_t)row * 8), sb = *(const f32x4*)(SSQ + (size_t)row * 8 + 4);
                const float rs = 0.14724445f / sqrtf((((sa[0] + sa[1]) + (sa[2] + sa[3])) + ((sb[0] + sb[1]) + (sb[2] + sb[3]))) * (1.f / 384.f) + 1e-6f);
#pragma unroll
                for (int bj = 0; bj < 2; ++bj) {
                    f32x4 v0 = acc[ai][bj][m][0] * rs, v1 = acc[ai][bj][m][1] * rs;
                    const int c0 = u.pn * 256 + bj * 128 + wc * 32 + 8 * fq, d = c0 % 96;
                    rope32(v0, v1, CS8, gr, gc, (d - 64) >> 3, d >= 64);
                    store8(QMLA + (size_t)row * 768 + c0, v0, v1);
                }
            }
    }
};
struct EpiKV {
    static constexpr bool PERM = true, AFTER_DRAIN = false;
    bf16_t *KMLA, *VMLA; const float* SSKV;
    __device__ __forceinline__ void operator()(EPI_ARGS) const {
        EPI_RECOMPUTE
        const int row0 = u.pm * 256 + wr * 64 + fr;
#pragma unroll
        for (int ai = 0; ai < 2; ++ai)
#pragma unroll
            for (int m = 0; m < 4; ++m) {
                __builtin_amdgcn_sched_barrier(0); const int row = opq(row0 + ai * 128 + m * 16);
                const f32x4 sa = *(const f32x4*)(SSKV + (size_t)row * 4);
                const float rs = 1.f / sqrtf(((sa[0] + sa[1]) + (sa[2] + sa[3])) * (1.f / 256.f) + 1e-6f);
#pragma unroll
                for (int bj = 0; bj < 2; ++bj) {
                    const f32x4 v0 = acc[ai][bj][m][0] * rs, v1 = acc[ai][bj][m][1] * rs;
                    const int h = u.pn * 2 + bj, d = wc * 32 + 8 * fq;
                    if (wc < 2) store8(KMLA + (size_t)row * 768 + h * 96 + d, v0, v1);
                    else store8(VMLA + (size_t)row * 512 + h * 64 + (d - 64), v0, v1);
                }
            }
    }
};
template <bool ACCUM> struct EpiZ {
    static constexpr bool PERM = true, AFTER_DRAIN = false;
    bf16_t* Z; const bf16_t* MG;
    __device__ __forceinline__ void operator()(EPI_ARGS) const {
        EPI_RECOMPUTE
        const int row0 = u.pm * 256 + wr * 64 + fr;
#pragma unroll
        for (int ai = 0; ai < 2; ++ai)
#pragma unroll
            for (int m = 0; m < 4; ++m) {
                __builtin_amdgcn_sched_barrier(0); const int row = opq(row0 + ai * 128 + m * 16);
#pragma unroll
                for (int bj = 0; bj < 2; ++bj) {
                    f32x4 v0 = acc[ai][bj][m][0], v1 = acc[ai][bj][m][1];
                    const int c0 = u.pn * 256 + bj * 128 + wc * 32 + 8 * fq;
                    const u32x4 g = *(const u32x4*)(MG + (size_t)row * 2048 + c0);
                    v0[0] *= bflo(g.x); v0[1] *= bfhi(g.x); v0[2] *= bflo(g.y); v0[3] *= bfhi(g.y);
                    v1[0] *= bflo(g.z); v1[1] *= bfhi(g.z); v1[2] *= bflo(g.w); v1[3] *= bfhi(g.w);
                    bf16_t* zp = Z + (size_t)row * 1024 + c0;
                    if (ACCUM) { const u32x4 z = *(const u32x4*)zp;
                        v0[0] += bflo(z.x); v0[1] += bfhi(z.x); v0[2] += bflo(z.y); v0[3] += bfhi(z.y);
                        v1[0] += bflo(z.z); v1[1] += bfhi(z.z); v1[2] += bflo(z.w); v1[3] += bfhi(z.w); }
                    store8(zp, v0, v1);
                }
            }
    }
};
struct EpiOut {
    static constexpr bool PERM = true, AFTER_DRAIN = false;
    float* OUT; const float* X; const float* MOD;
    __device__ __forceinline__ void operator()(EPI_ARGS) const {
        EPI_RECOMPUTE
        const int row0 = u.pm * 256 + wr * 64 + fr; const float ALPHA = 1.189207115002721f;
        const float* gate = MOD + (size_t)(u.pm >> 5) * 3072 + 2048;
#pragma unroll
        for (int ai = 0; ai < 2; ++ai)
#pragma unroll
            for (int m = 0; m < 4; ++m) {
                __builtin_amdgcn_sched_barrier(0); const int row = opq(row0 + ai * 128 + m * 16);
#pragma unroll
                for (int bj = 0; bj < 2; ++bj) {
                    const int c0 = u.pn * 256 + bj * 128 + wc * 32 + 8 * fq;
                    const f32x4 x0 = *(const f32x4*)(X + (size_t)row * 1024 + c0), x1 = *(const f32x4*)(X + (size_t)row * 1024 + c0 + 4);
                    const f32x4 g0 = *(const f32x4*)(gate + c0), g1 = *(const f32x4*)(gate + c0 + 4);
                    *(f32x4*)(OUT + (size_t)row * 1024 + c0) = x0 * ALPHA + g0 * acc[ai][bj][m][0];
                    *(f32x4*)(OUT + (size_t)row * 1024 + c0 + 4) = x1 * ALPHA + g1 * acc[ai][bj][m][1];
                }
            }
    }
};
constexpr size_t MiB = 1u << 20;
constexpr size_t WS_BAR = 0, CTL_ZERO_BYTES = 16384;
constexpr size_t WS_SSKV = 0, WS_SSQ = 512 * 1024;
constexpr size_t WS_MOD = 1 * MiB, WS_CS16 = 1 * MiB + 128 * 1024, WS_CS8 = 1 * MiB + 192 * 1024;
constexpr size_t WS_WIN = 2 * MiB, WS_WUQ = 13 * MiB, WS_WUKV = 14 * MiB, WS_WOA = 15 * MiB, WS_WOB = 16 * MiB, WS_WOUT = 17 * MiB;
constexpr size_t WS_HBF = 32 * MiB;
constexpr size_t WS_VMLA = WS_HBF, WS_Z = WS_HBF;
constexpr size_t WS_KMLA = 164 * MiB;
constexpr size_t WS_GA = 263 * MiB;
constexpr size_t WS_DQ = 327 * MiB;
constexpr size_t WS_DK = 391 * MiB;
constexpr size_t WS_DV = 457 * MiB;
constexpr size_t WS_GD = 523 * MiB;
constexpr size_t WS_MG = 587 * MiB;
constexpr size_t WS_QMLA = 843 * MiB;
constexpr size_t WS_SSKVP = 939 * MiB, WS_SSQP = 941 * MiB;
constexpr size_t WS_END = 944 * MiB;
constexpr size_t OUT_XA = 96 * MiB, OUT_XD = 160 * MiB;
constexpr size_t OUT_CKV = 0, OUT_CQ = 33 * MiB;
constexpr int LDS_BYTES = 160832;

struct Args {
    const float *x, *c, *ctx, *c_ctx, *w_mod, *b_mod, *w_in, *q_norm, *kv_norm, *w_uq, *w_ukv, *dlam, *subln, *w_oa, *w_ob, *w_out, *ln_g, *ln_b;
    float* out; unsigned char* ws;
};

__device__ __forceinline__ void tr_item(const float* __restrict__ W, int K, int N, int srcn0, const float* __restrict__ ksc, bf16_t* WT, int dstn0, int k0, float* scr, int lane) {
#pragma unroll 8
    for (int i = 0; i < 32; ++i) { const int kk = 2 * i + (lane >> 5);
        float v = 0.f; if (srcn0 >= 0) { v = W[(size_t)(k0 + kk) * N + srcn0 + (lane & 31)]; if (ksc) v *= ksc[k0 + kk]; }
        scr[kk * 33 + (lane & 31)] = v; }
    asm volatile("s_waitcnt lgkmcnt(0)" ::: "memory");
    const int c = lane & 7;
#pragma unroll
    for (int j = 0; j < 4; ++j) { const int n = (lane >> 3) + 8 * j; const float* s = scr + (8 * c) * 33 + n;
        u32x4 o; o.x = cvtpk(s[0 * 33], s[1 * 33]); o.y = cvtpk(s[2 * 33], s[3 * 33]); o.z = cvtpk(s[4 * 33], s[5 * 33]); o.w = cvtpk(s[6 * 33], s[7 * 33]);
        *(u32x4*)(WT + (size_t)(dstn0 + n) * K + k0 + 8 * c) = o; }
    asm volatile("s_waitcnt lgkmcnt(0)" ::: "memory");
}

#define XB_TMO      128
#define XB_XCNT(j)  (256  + 64 * (j))
#define XB_XSUB(j)  (1280 + 64 * (j))
#define XB_XGEN(j)  (2304 + 64 * (j))
#define XB_TOP      3328
#define XB_TOPGEN   3392
#define XCD_BAR_WORDS 3456
#define XB_SPIN_CAP (1u << 18)

__device__ __forceinline__ unsigned xb_ld(unsigned* p)              { return __hip_atomic_load(p, __ATOMIC_RELAXED, __HIP_MEMORY_SCOPE_AGENT); }
__device__ __forceinline__ unsigned xb_add(unsigned* p, unsigned v) { return __hip_atomic_fetch_add(p, v, __ATOMIC_RELAXED, __HIP_MEMORY_SCOPE_AGENT); }
__device__ __forceinline__ unsigned xb_xcc_id() { return (unsigned)__builtin_amdgcn_s_getreg((3 << 11) | 20) & 0xFu; }
#define XB_SPIN(cond, bar) do { unsigned _sp = 0; while (cond) { __builtin_amdgcn_s_sleep(1); \
    if ((++_sp & 255u) == 0u) { if (xb_ld(&(bar)[XB_TMO])) break; if (_sp > XB_SPIN_CAP) { atomicAdd(&(bar)[XB_TMO], 1u); break; } } } } while (0)

struct XcdBarrier {
    unsigned* bar; unsigned x;
    volatile LAS unsigned* st;
};

__device__ __forceinline__ XcdBarrier xcd_barrier_post(unsigned* bar, volatile LAS unsigned* st) {
    XcdBarrier b; b.bar = bar; b.x = xb_xcc_id(); b.st = st;
    if (threadIdx.x == 0) (void)xb_add(&bar[XB_XCNT(b.x)], 1u);
    return b;
}
__device__ __forceinline__ void xcd_barrier_complete(unsigned* bar, unsigned x, unsigned& nloc, unsigned& nx) {
    const unsigned G = gridDim.x * gridDim.y * gridDim.z;
    unsigned sum, cnt, mine, sp = 0u;
    for (;;) {
        sum = 0u; cnt = 0u; mine = 0u;
#pragma unroll
        for (unsigned j = 0; j < 16; ++j) { const unsigned c = xb_ld(&bar[XB_XCNT(j)]); sum += c; cnt += (c > 0u) ? 1u : 0u; mine = (j == x) ? c : mine; }
        if (sum == G) break;
        __builtin_amdgcn_s_sleep(1);
        if ((++sp & 255u) == 0u) { if (xb_ld(&bar[XB_TMO])) break; if (sp > XB_SPIN_CAP) { atomicAdd(&bar[XB_TMO], 1u); break; } }
    }
    nloc = mine > 0u ? mine : 1u; nx = cnt > 0u ? cnt : 1u;
}

__device__ __forceinline__ void xcd_barrier(const XcdBarrier& b) {
    asm volatile("s_waitcnt vmcnt(0)" ::: "memory");
    __syncthreads();
    if (threadIdx.x == 0) {
        unsigned* bar = b.bar;
        __builtin_amdgcn_s_waitcnt(0);
        unsigned nloc = b.st[0], nx = b.st[1];
        if (nloc == 0u) { xcd_barrier_complete(bar, b.x, nloc, nx); b.st[0] = nloc; b.st[1] = nx; }
        const unsigned old = xb_add(&bar[XB_XSUB(b.x)], 1u);
        const unsigned gen = old / nloc;
        if (old + 1u == (gen + 1u) * nloc) {
            __builtin_amdgcn_fence(__ATOMIC_RELEASE, "agent");
            asm volatile("s_waitcnt vmcnt(0)" ::: "memory");
            const unsigned og = xb_add(&bar[XB_TOP], 1u);
            const unsigned tg = og / nx;
            if (og + 1u == (tg + 1u) * nx) xb_add(&bar[XB_TOPGEN], 1u);
            else XB_SPIN(xb_ld(&bar[XB_TOPGEN]) == tg, bar);
            __builtin_amdgcn_fence(__ATOMIC_ACQUIRE, "agent");
            xb_add(&bar[XB_XGEN(b.x)], 1u);
            asm volatile("s_waitcnt vmcnt(0)" ::: "memory");
        } else {
            XB_SPIN(xb_ld(&bar[XB_XGEN(b.x)]) == gen, bar);
            __builtin_amdgcn_fence(__ATOMIC_ACQUIRE, "agent");
            asm volatile("s_waitcnt vmcnt(0)" ::: "memory");
        }
    }
    __syncthreads();
}

__global__ void __launch_bounds__(512, 2) fwd_mega(Args a) {
    extern __shared__ __attribute__((aligned(16))) unsigned char lds[];
    cg::grid_group grid = cg::this_grid();
    const int wave = __builtin_amdgcn_readfirstlane((int)threadIdx.x >> 6);
#define LANE_TID const int lane = lane_id_v(), tid = wave * 64 + lane; (void)tid; (void)lane;
    const int G = gridDim.x, bid = blockIdx.x;
    const int gw = bid * 8 + wave, NGW = G * 8;
    unsigned char* ws = a.ws; unsigned char* ob = (unsigned char*)a.out;
    float* SSKV = (float*)(ws + WS_SSKVP); float* SSQ = (float*)(ws + WS_SSQP); float* MOD = (float*)(ws + WS_MOD);
    cs_t* CS16 = (cs_t*)(ws + WS_CS16); cs_t* CS8 = (cs_t*)(ws + WS_CS8);
    bf16_t* WIN = (bf16_t*)(ws + WS_WIN); bf16_t* WUQ = (bf16_t*)(ws + WS_WUQ); bf16_t* WUKV = (bf16_t*)(ws + WS_WUKV);
    bf16_t* WOA = (bf16_t*)(ws + WS_WOA); bf16_t* WOB = (bf16_t*)(ws + WS_WOB); bf16_t* WOUT = (bf16_t*)(ws + WS_WOUT);
    bf16_t* HBF = (bf16_t*)(ws + WS_HBF); bf16_t* VMLA = (bf16_t*)(ws + WS_VMLA); bf16_t* Z = (bf16_t*)(ws + WS_Z);
    bf16_t* KMLA = (bf16_t*)(ws + WS_KMLA); bf16_t* GA = (bf16_t*)(ws + WS_GA); bf16_t* DQ = (bf16_t*)(ws + WS_DQ); bf16_t* DK = (bf16_t*)(ws + WS_DK);
    bf16_t* DV = (bf16_t*)(ws + WS_DV); bf16_t* GD = (bf16_t*)(ws + WS_GD); bf16_t* MG = (bf16_t*)(ws + WS_MG); bf16_t* QMLA = (bf16_t*)(ws + WS_QMLA);
    bf16_t* CKV = (bf16_t*)(ob + OUT_CKV); bf16_t* CQ = (bf16_t*)(ob + OUT_CQ); bf16_t* XA = (bf16_t*)(ob + OUT_XA); bf16_t* XD = (bf16_t*)(ob + OUT_XD);
    PG8_LAS unsigned char* ldsp = (PG8_LAS unsigned char*)lds;
    { volatile LAS unsigned* stz = (volatile LAS unsigned*)(lds + 160768); if (threadIdx.x < 16) stz[threadIdx.x] = 0u; }
    __syncthreads();
    const XcdBarrier xbar = xcd_barrier_post((unsigned*)(ws + WS_BAR), (volatile LAS unsigned*)(lds + 160768));

#ifndef REP1
#define REP1 1
#endif
#ifndef REP2
#define REP2 1
#endif
#ifndef REP3A
#define REP3A 0
#endif
#ifndef REP3D
#define REP3D 0
#endif
#ifndef REP4A
#define REP4A 1
#endif
#ifndef REP4B
#define REP4B 1
#endif
#ifndef PHMASK
#define PHMASK 0xfff
#endif
    if (PHMASK & (1 << 0)) {
        LANE_TID
        float* A = (float*)lds; float* red = (float*)(lds + 36864);
        for (int cb = bid; cb < 96; cb += G) {
            __syncthreads();
            for (int i = tid; i < 9 * 1024; i += 512) { const int r = i >> 10, k = i & 1023; const float v = r < 8 ? a.c[r * 1024 + k] : a.c_ctx[k]; A[i] = v * sigmoidf_(v); }
            __syncthreads();
            const int cl = tid & 31, col = cb * 32 + cl, kq = tid >> 5;
            float acc[9];
#pragma unroll
            for (int r = 0; r < 9; ++r) acc[r] = 0.f;
#pragma unroll 4
            for (int kk = 0; kk < 64; ++kk) { const int k = kq * 64 + kk; const float w = a.w_mod[(size_t)k * 3072 + col];
#pragma unroll
                for (int r = 0; r < 9; ++r) acc[r] += A[r * 1024 + k] * w; }
#pragma unroll
            for (int r = 0; r < 9; ++r) red[(kq * 9 + r) * 32 + cl] = acc[r];
            __syncthreads();
            if (tid < 288) { const int r = tid >> 5; float s = 0.f;
                for (int q = 0; q < 16; ++q) s += red[(q * 9 + r) * 32 + cl];
                MOD[r * 3072 + col] = s + a.b_mod[col]; }
        }
        __syncthreads();
        float* scr = (float*)lds + wave * (64 * 33);
        constexpr int I_IN = 16 * 168, I_UQ = 6 * 24, I_UKV = 4 * 32, I_OA = 8 * 32, I_OB = 8 * 32, I_OUT = 16 * 32;
        constexpr int NITEMS = I_IN + I_UQ + I_UKV + I_OA + I_OB + I_OUT;
        for (int it = gw; it < NITEMS; it += NGW) {
            int r = it;
            if (r < I_IN) { const int kb = r / 168, nb = r % 168, d0 = nb * 32;
                const int s0 = d0 < 256 ? 384 + d0 : d0 < 640 ? d0 - 256 : d0 < 672 ? d0 : d0 < 768 ? -1 : d0 - 96;
                tr_item(a.w_in, 1024, 5280, s0, nullptr, WIN, d0, kb * 64, scr, lane); continue; } r -= I_IN;
            if (r < I_UQ) { tr_item(a.w_uq, 384, 768, (r % 24) * 32, a.q_norm, WUQ, (r % 24) * 32, (r / 24) * 64, scr, lane); continue; } r -= I_UQ;
            if (r < I_UKV) { tr_item(a.w_ukv, 256, 1024, (r % 32) * 32, a.kv_norm, WUKV, (r % 32) * 32, (r / 32) * 64, scr, lane); continue; } r -= I_UKV;
            if (r < I_OA) { tr_item(a.w_oa, 512, 1024, (r % 32) * 32, nullptr, WOA, (r % 32) * 32, (r / 32) * 64, scr, lane); continue; } r -= I_OA;
            if (r < I_OB) { tr_item(a.w_ob, 512, 1024, (r % 32) * 32, nullptr, WOB, (r % 32) * 32, (r / 32) * 64, scr, lane); continue; } r -= I_OB;
            tr_item(a.w_out, 1024, 1024, (r % 32) * 32, nullptr, WOUT, (r % 32) * 32, (r / 32) * 64, scr, lane);
        }
        if (bid == G - 1) {
            for (int i = tid; i < 128 * 16; i += 512) { const int pos = i >> 4, f = i & 15; const float inv = powf(10000.f, -(float)f / 16.f), ang = (float)pos * inv; CS16[i] = make_float2(cosf(ang), sinf(ang)); }
            for (int i = tid; i < 128 * 8; i += 512) { const int pos = i >> 3, f = i & 7; const float inv = powf(10000.f, -(float)f / 8.f), ang = (float)pos * inv; CS8[i] = make_float2(cosf(ang), sinf(ang)); }
        }
    }
    grid.sync();

    if (PHMASK & (1 << 1)) for (int m = gw; m < MALL; m += NGW) {
        LANE_TID
        const float* src; const float* mod;
        if (m < MLAT) { src = a.x + (size_t)m * 1024; mod = MOD + (size_t)(m >> 13) * 3072; } else { src = a.ctx + (size_t)(m - MLAT) * 1024; mod = MOD + 8 * 3072; }
#pragma unroll
        for (int j = 0; j < 4; ++j) { const int c4 = lane + 64 * j;
            const f32x4 v = ((const f32x4*)src)[c4], sh = ((const f32x4*)mod)[c4], sc = ((const f32x4*)(mod + 1024))[c4];
            const f32x4 h = v * (sc + 1.f) + sh; u32x2 w; w.x = cvtpk(h[0], h[1]); w.y = cvtpk(h[2], h[3]);
            *(u32x2*)(HBF + (size_t)m * 1024 + c4 * 4) = w; }
    }
    xcd_barrier(xbar);

    if (PHMASK & (1 << 2)) for (int rep = 0; rep < REP1; ++rep) {
        pg8::Gemm g{HBF, WIN, MALL, NINP, 1024}; pg8::StaticOrder S; S.init(MALL, NINP, G, bid);
        EpiP1 E{CKV, CQ, KMLA, GA, DQ, DK, DV, GD, MG, SSKV, SSQ, CS16, CS8, rep == 0};
        pg8::gemm_phase<EpiP1, pg8::StaticOrder, true, true>(ldsp, g, S, E, wave);
    }
    xcd_barrier(xbar);

    for (int rep = 0; rep < REP2; ++rep) {
    if (PHMASK & (1 << 3)) {
        pg8::Gemm g{CQ, WUQ, MLAT, 768, 384}; pg8::StaticOrder S; S.init(MLAT, 768, G, bid);
        EpiQ E{QMLA, SSQ, CS8};
        pg8::gemm_phase<EpiQ, pg8::StaticOrder, true, true>(ldsp, g, S, E, wave);
    }
    if (PHMASK & (1 << 4)) {
        pg8::Gemm g{CKV, WUKV, MALL, 1024, 256}; pg8::StaticOrder S; S.init(MALL, 1024, G, bid);
        EpiKV E{KMLA, VMLA, SSKV};
        pg8::gemm_phase<EpiKV, pg8::StaticOrder, true, true>(ldsp, g, S, E, wave);
    }
    }
    xcd_barrier(xbar);

    if (PHMASK & (3 << 5)) {
        float lam;
        { LANE_TID
        { const float s1 = wave_sum(a.dlam[lane] * a.dlam[64 + lane]), s2 = wave_sum(a.dlam[128 + lane] * a.dlam[192 + lane]); lam = __builtin_bit_cast(float, __builtin_amdgcn_readfirstlane(__builtin_bit_cast(int, __expf(s1) - __expf(s2) + 0.2f))); } }
        int grp;
        { LANE_TID
          int* tab = (int*)(lds + 95232); const int simd = (__builtin_amdgcn_s_getreg((1 << 11) | (4 << 6) | 4)) & 3;
          __syncthreads(); if (lane == 0) tab[wave] = simd; __syncthreads();
          int cnt = 0;
#pragma unroll
          for (int w = 0; w < 8; ++w) cnt += (w < wave && tab[w] == simd) ? 1 : 0;
          grp = __builtin_amdgcn_readfirstlane(cnt > 0 ? 1 : 0); asm volatile("" : "+s"(grp)); __syncthreads(); }
        const int nrounds = (NB * 12 * 32 + G - 1) / G;
        for (int rdx = 0; rdx < nrounds + REP3A * 8 + REP3D * 4; ++rdx) {
            const int rd = rdx < nrounds ? rdx : (rdx - nrounds < REP3A * 8 ? (rdx - nrounds) & 7 : 8 + ((rdx - nrounds - REP3A * 8) & 3));
            int b, hs, qb;
            { const int idx = rd * G + bid; if (idx >= NB * 12 * 32) break; b = idx & 7; qb = (idx >> 3) & 31; hs = idx >> 8; }
            const size_t qrow0 = (size_t)b * SEQ + qb * 256, krow0 = (size_t)b * SKV;
            __syncthreads();
            if (hs < 8) { if (PHMASK & (1 << 5)) {
                f32x16 o[2];
                att::attn_core<true>(QMLA + qrow0 * 768 + hs * 96, KMLA + krow0 * 768 + hs * 96, VMLA + krow0 * 512 + hs * 64, SKV, (char*)lds, o, wave, grp);
                LANE_TID
                const int r32 = lane & 31, hi = lane >> 5;
                char* T = (char*)lds + 95232 + wave * 8192; char* tw = T + hi * 512 + r32 * 2;
#pragma unroll
                for (int r = 0; r < 16; ++r)
#pragma unroll
                    for (int d0 = 0; d0 < 2; ++d0) *(bf16_t*)(tw + ((r & 3) + 8 * (r >> 2)) * 128 + d0 * 64) = (bf16_t)cvtpk(o[d0][r], o[d0][r]);
#pragma unroll
                for (int j = 0; j < 4; ++j) { const int id = j * 64 + lane, row = id >> 3, c8 = id & 7;
                    const u32x4 t = *(const u32x4*)(T + id * 16);
                    const size_t go = (qrow0 + wave * 32 + row) * 512 + hs * 64 + c8 * 8; const u32x4 g = *(const u32x4*)(GA + go);
                    u32x4 w; w.x = cvtpk(bflo(t.x) * bflo(g.x), bfhi(t.x) * bfhi(g.x)); w.y = cvtpk(bflo(t.y) * bflo(g.y), bfhi(t.y) * bfhi(g.y));
                    w.z = cvtpk(bflo(t.z) * bflo(g.z), bfhi(t.z) * bfhi(g.z)); w.w = cvtpk(bflo(t.w) * bflo(g.w), bfhi(t.w) * bfhi(g.w));
                    *(u32x4*)(XA + go) = w; }
            } } else if (PHMASK & (1 << 6)) {
                const int h = hs - 8;
                f32x16 o[4];
                att::attn_core<false>(DQ + qrow0 * 512 + h * 128, DK + krow0 * 512 + h * 128, DV + krow0 * 512 + h * 128, SKV, (char*)lds, o, wave, grp);
                { unsigned* stash = (unsigned*)(lds + 95232 + wave * 8192) + lane_id_v();
#pragma unroll
                for (int d0 = 0; d0 < 4; ++d0)
#pragma unroll
                    for (int r = 0; r < 16; r += 2) stash[(d0 * 8 + (r >> 1)) * 64] = cvtpk(o[d0][r], o[d0][r + 1]); }
                att::attn_core<false>(DQ + qrow0 * 512 + h * 128 + 64, DK + krow0 * 512 + h * 128 + 64, DV + krow0 * 512 + h * 128, SKV, (char*)lds, o, wave, grp);
                LANE_TID
                const int r32 = lane & 31, hi = lane >> 5;
                unsigned* stash = (unsigned*)(lds + 95232 + wave * 8192) + lane;
#pragma unroll
                for (int d0 = 0; d0 < 4; ++d0)
#pragma unroll
                    for (int r = 0; r < 16; r += 2) { const unsigned w = stash[(d0 * 8 + (r >> 1)) * 64];
                        o[d0][r] = bflo(w) - lam * o[d0][r]; o[d0][r + 1] = bfhi(w) - lam * o[d0][r + 1]; }
                asm volatile("s_waitcnt lgkmcnt(0)" ::: "memory"); SBAR();
                char* T = (char*)lds + 95232 + wave * 8192; char* tw = T + hi * 1024 + r32 * 2;
#pragma unroll
                for (int r = 0; r < 16; ++r)
#pragma unroll
                    for (int d0 = 0; d0 < 4; ++d0) *(bf16_t*)(tw + ((r & 3) + 8 * (r >> 2)) * 256 + d0 * 64) = (bf16_t)cvtpk(o[d0][r], o[d0][r]);
                const int c16 = lane & 15;
                const f32x4 sw0 = *(const f32x4*)(a.subln + c16 * 8), sw1 = *(const f32x4*)(a.subln + c16 * 8 + 4);
#pragma unroll
                for (int j = 0; j < 8; ++j) { const int id = j * 64 + lane, row = id >> 4;
                    const u32x4 t = *(const u32x4*)(T + id * 16);
                    float e[8] = {bflo(t.x), bfhi(t.x), bflo(t.y), bfhi(t.y), bflo(t.z), bfhi(t.z), bflo(t.w), bfhi(t.w)};
                    float ss = 0.f;
#pragma unroll
                    for (int k = 0; k < 8; ++k) ss += e[k] * e[k];
                    ss += shflx(ss, 1); ss += shflx(ss, 2); ss += shflx(ss, 4); ss += shflx(ss, 8);
                    const float rs = 0.8f / sqrtf(ss * (1.f / 128.f) + 1e-5f);
                    const size_t go = (qrow0 + wave * 32 + row) * 512 + h * 128 + c16 * 8; const u32x4 g = *(const u32x4*)(GD + go);
                    u32x4 w; w.x = cvtpk(e[0] * rs * sw0[0] * bflo(g.x), e[1] * rs * sw0[1] * bfhi(g.x)); w.y = cvtpk(e[2] * rs * sw0[2] * bflo(g.y), e[3] * rs * sw0[3] * bfhi(g.y));
                    w.z = cvtpk(e[4] * rs * sw1[0] * bflo(g.z), e[5] * rs * sw1[1] * bfhi(g.z)); w.w = cvtpk(e[6] * rs * sw1[2] * bflo(g.w), e[7] * rs * sw1[3] * bfhi(g.w));
                    *(u32x4*)(XD + go) = w; }
            }
        }
    }
    xcd_barrier(xbar);

    for (int rep = 0; rep < REP4A; ++rep) {
    if (PHMASK & (1 << 7)) {
        pg8::Gemm g{XA, WOA, MLAT, 1024, 512}; pg8::StaticOrder S; S.init(MLAT, 1024, G, bid);
        EpiZ<false> E{Z, MG};
        pg8::gemm_phase<EpiZ<false>, pg8::StaticOrder, true, true>(ldsp, g, S, E, wave);
    }
    if (PHMASK & (1 << 8)) {
        pg8::Gemm g{XD, WOB, MLAT, 1024, 512}; pg8::StaticOrder S; S.init(MLAT, 1024, G, bid);
        EpiZ<true> E{Z, MG + 1024};
        pg8::gemm_phase<EpiZ<true>, pg8::StaticOrder, true, true>(ldsp, g, S, E, wave);
    }
    }
    xcd_barrier(xbar);

    if (PHMASK & (1 << 9)) for (int rep = 0; rep < REP4B; ++rep) {
        pg8::Gemm g{Z, WOUT, MLAT, 1024, 1024}; pg8::StaticOrder S; S.init(MLAT, 1024, G, bid);
        EpiOut E{a.out, a.x, MOD};
        pg8::gemm_phase<EpiOut, pg8::StaticOrder, true, true>(ldsp, g, S, E, wave);
    }
    xcd_barrier(xbar);

    if (PHMASK & (1 << 10)) for (int m = gw; m < MLAT; m += NGW) {
        LANE_TID
        f32x4* rowp = (f32x4*)(a.out + (size_t)m * 1024) + lane;
        f32x4 v[4]; float s = 0.f;
#pragma unroll
        for (int j = 0; j < 4; ++j) { v[j] = rowp[64 * j]; s += (v[j][0] + v[j][1]) + (v[j][2] + v[j][3]); }
        const float mean = wave_sum(s) * (1.f / 1024.f); float s2 = 0.f;
#pragma unroll
        for (int j = 0; j < 4; ++j) { v[j] = v[j] - mean; s2 += (v[j][0] * v[j][0] + v[j][1] * v[j][1]) + (v[j][2] * v[j][2] + v[j][3] * v[j][3]); }
        const float rstd = 1.f / sqrtf(wave_sum(s2) * (1.f / 1024.f) + 1e-5f);
#pragma unroll
        for (int j = 0; j < 4; ++j) { const f32x4 g = ((const f32x4*)a.ln_g)[lane + 64 * j], bb = ((const f32x4*)a.ln_b)[lane + 64 * j]; rowp[64 * j] = v[j] * rstd * g + bb; }
    }
}

extern "C" void kernel_launch(void* const* d_in, const int* in_sizes, int n_in, void* d_out, int out_size, void* d_ws, size_t ws_size, hipStream_t stream) {
    static int grid = 0;
    if (grid == 0) {
        if (n_in != 18 || in_sizes[0] != MLAT * DM || out_size != MLAT * DM || ws_size < WS_END) {
            fprintf(stderr, "kernel_launch: shape/workspace mismatch: n_in %d in0 %d out %d ws %zu (need %zu)\n", n_in, n_in > 0 ? in_sizes[0] : -1, out_size, ws_size, (size_t)WS_END); grid = -1; return; }
        int dev = 0, cus = 0, per_cu = 0;
        hipGetDevice(&dev); hipDeviceGetAttribute(&cus, hipDeviceAttributeMultiprocessorCount, dev);
        if (hipFuncSetAttribute((const void*)fwd_mega, hipFuncAttributeMaxDynamicSharedMemorySize, LDS_BYTES) != hipSuccess) { fprintf(stderr, "kernel_launch: hipFuncSetAttribute failed\n"); grid = -1; return; }
        if (hipOccupancyMaxActiveBlocksPerMultiprocessor(&per_cu, (const void*)fwd_mega, 512, LDS_BYTES) != hipSuccess || per_cu < 1) { fprintf(stderr, "kernel_launch: occupancy query gave %d\n", per_cu); per_cu = 1; }
        (void)hipGetLastError();
        grid = cus * 1;
    }
    if (grid < 0) return;
    hipMemsetAsync((char*)d_ws + WS_BAR, 0, CTL_ZERO_BYTES, stream);
    Args a{};
    a.x = (const float*)d_in[0]; a.c = (const float*)d_in[1]; a.ctx = (const float*)d_in[2]; a.c_ctx = (const float*)d_in[3]; a.w_mod = (const float*)d_in[4]; a.b_mod = (const float*)d_in[5];
    a.w_in = (const float*)d_in[6]; a.q_norm = (const float*)d_in[7]; a.kv_norm = (const float*)d_in[8]; a.w_uq = (const float*)d_in[9]; a.w_ukv = (const float*)d_in[10];
    a.dlam = (const float*)d_in[11]; a.subln = (const float*)d_in[12]; a.w_oa = (const float*)d_in[13]; a.w_ob = (const float*)d_in[14]; a.w_out = (const float*)d_in[15];
    a.ln_g = (const float*)d_in[16]; a.ln_b = (const float*)d_in[17]; a.out = (float*)d_out; a.ws = (unsigned char*)d_ws;
    void* args[] = {&a};
    hipError_t e = hipLaunchCooperativeKernel((const void*)fwd_mega, dim3(grid), dim3(512), args, LDS_BYTES, stream);
    if (e != hipSuccess) fprintf(stderr, "kernel_launch: cooperative launch failed: %s (grid %d)\n", hipGetErrorString(e), grid);
}
```

```cpp
#include <hip/hip_runtime.h>
#include <hip/hip_cooperative_groups.h>
#include <cstdio>
#include <cstdint>
namespace cg = cooperative_groups;
__device__ __forceinline__ int opq(int v) { asm volatile("" : "+v"(v)); return v; }
__device__ __forceinline__ int lane_id_v() { int l; asm volatile("v_mbcnt_lo_u32_b32 %0, -1, 0\n\tv_mbcnt_hi_u32_b32 %0, -1, %0" : "=v"(l)); return l; }
__device__ __forceinline__ float shflx(float v, int mask) { return __builtin_bit_cast(float, __builtin_amdgcn_ds_bpermute((lane_id_v() ^ mask) << 2, __builtin_bit_cast(int, v))); }
__device__ __forceinline__ float shfli(float v, int idx4) { return __builtin_bit_cast(float, __builtin_amdgcn_ds_bpermute(idx4, __builtin_bit_cast(int, v))); }
namespace pg8 {
#define PG8_LAS __attribute__((address_space(3)))
typedef unsigned short bf16_t;
typedef short bf16x8 __attribute__((ext_vector_type(8)));
typedef float f32x4 __attribute__((ext_vector_type(4)));
typedef unsigned u32x4 __attribute__((ext_vector_type(4)));
constexpr int BM = 256, BK = 64, HALF = 128, HTB = HALF * BK * 2  , STAGE_BYTES = 8 * HTB, NXCD = 8, WGM = 8;

__host__ __device__ __forceinline__ int lds_byte(int r, int c) { const int st = (r >> 4) * 2 + (c >> 5), rr = r & 15, cc = c & 31, ob = rr * 64 + cc * 2; return st * 1024 + (ob ^ (((ob >> 9) & 1) << 5)); }
__host__ __device__ __forceinline__ void stage_rc(int b, int& R, int& C) { const int st = b / 1024, sb = b % 1024, swz = sb ^ (((sb >> 9) & 1) << 5); R = (st >> 1) * 16 + swz / 64; C = (st & 1) * 32 + (swz % 64) / 2; }
__host__ __device__ __forceinline__ int perm32(int rho) { const int n = rho >> 4, i = rho & 15; return 8 * (i >> 2) + 4 * n + (i & 3); }

struct Unit { int pm, pn; };
struct Gemm { const bf16_t* A; const bf16_t* Bt; int M, N, K; };

struct StaticOrder {
    int nM, nN, nwg, G, c;
    __host__ __device__ void init(int M, int N, int G_, int c_) { nM = M / BM; nN = N / BM; nwg = nM * nN; G = G_; c = c_; }
    __host__ __device__ bool next(int i, Unit& u) const {
        const long L = (long)i * G + c; if (L >= nwg) return false;
        int wgid = (int)L; { const int q = nwg / NXCD, r = nwg % NXCD, xcd = wgid % NXCD, off = wgid / NXCD; wgid = (xcd < r ? xcd * (q + 1) : r * (q + 1) + (xcd - r) * q) + off; }
        const int nig = WGM * nN, gid = wgid / nig, fm = gid * WGM, gsz = (nM - fm) < WGM ? (nM - fm) : WGM;
        u.pm = fm + ((wgid % nig) % gsz); u.pn = (wgid % nig) / gsz; return true;
    }
    __device__ __forceinline__ void a_ready(const Unit&) const {}
    __device__ __forceinline__ void done(const Unit&) const {}
};

template <class Epi, class Sched, bool ALIGN_EPI = false, bool SP2 = false>
__device__ __forceinline__ void gemm_phase(PG8_LAS unsigned char* lds, const Gemm g, const Sched& S, const Epi& E, const int wid  ) {
    const int lane = lane_id_v(), tid = wid * 64 + lane, wr = wid >> 2, wc = wid & 3, fr = lane & 15, fq = lane >> 4;
    const int K = g.K, nt = K / BK;
    unsigned voffA[2], voffB[2];
#pragma unroll
    for (int i = 0; i < 2; ++i) { int R, C; stage_rc(tid * 16 + i * 8192, R, C); const int Rb = Epi::PERM ? ((R & ~31) + perm32(R & 31)) : R;
        voffA[i] = (unsigned)(R * K + C) * 2u; voffB[i] = (unsigned)(Rb * K + C) * 2u; }
    const size_t kstep = (size_t)(BK * 2);
    const size_t hstep = (size_t)HALF * K * 2;
    const size_t tstep = 2 * hstep;
    const unsigned ldsw = (unsigned)wid * 1024u;
    const int aoff = lds_byte(wr * 64 + fr, fq * 8), boff = lds_byte(wc * 32 + fr, fq * 8);
#define PG8_SA(b, h) (((b) * 2 + (h)) * HTB)
#define PG8_SB(b, h) ((4 + (b) * 2 + (h)) * HTB)
#define PG8_STAGE(bufoff, gbase, voff) do { _Pragma("unroll") for (int _i = 0; _i < 2; ++_i) \
        __builtin_amdgcn_global_load_lds((const unsigned*)((const char*)(gbase) + (voff)[_i]), (PG8_LAS unsigned*)(lds + (bufoff) + ldsw + _i * 8192), 16, 0, 0); } while (0)
#define PG8_LDA(dst, b, h) do { _Pragma("unroll") for (int m = 0; m < 4; ++m) _Pragma("unroll") for (int k = 0; k < 2; ++k) dst[m][k] = *(const PG8_LAS bf16x8*)(lds + PG8_SA(b, h) + aoff + m * 2048 + k * 1024); } while (0)
#define PG8_LDB(dst, b, h) do { _Pragma("unroll") for (int n = 0; n < 2; ++n) _Pragma("unroll") for (int k = 0; k < 2; ++k) dst[n][k] = *(const PG8_LAS bf16x8*)(lds + PG8_SB(b, h) + boff + n * 2048 + k * 1024); } while (0)
#define PG8_MMA(ai, bj, At, Bt) do { __builtin_amdgcn_s_setprio(1); _Pragma("unroll") for (int m = 0; m < 4; ++m) _Pragma("unroll") for (int n = 0; n < 2; ++n) _Pragma("unroll") for (int k = 0; k < 2; ++k) \
        acc[ai][bj][m][n] = __builtin_amdgcn_mfma_f32_16x16x32_bf16(Bt[n][k], At[m][k], acc[ai][bj][m][n], 0, 0, 0); __builtin_amdgcn_s_setprio(0); } while (0)
#define PG8_WAIT_V(n) asm volatile("s_waitcnt vmcnt(" #n ")" ::: "memory")
#define PG8_WAIT_L(n) asm volatile("s_waitcnt lgkmcnt(" #n ")" ::: "memory")
#define PG8_BAR __builtin_amdgcn_s_barrier()
#define PG8_SCHED __builtin_amdgcn_sched_barrier(0)
    Unit cur, nxt; int ui = 0;
    if (!S.next(0, cur)) return;
    f32x4 acc[2][2][4][2];
#pragma unroll
    for (int a = 0; a < 2; ++a)
#pragma unroll
        for (int b = 0; b < 2; ++b)
#pragma unroll
            for (int m = 0; m < 4; ++m)
#pragma unroll
                for (int n = 0; n < 2; ++n) acc[a][b][m][n] = (f32x4){0.f, 0.f, 0.f, 0.f};
    bf16x8 At[4][2], B0[2][2], B1[2][2];
    const char* cA = (const char*)g.A + (size_t)cur.pm * tstep; const char* cB = (const char*)g.Bt + (size_t)cur.pn * tstep;
    S.a_ready(cur);
    if constexpr (SP2) {
        PG8_STAGE(PG8_SB(0, 0), cB, voffB); PG8_STAGE(PG8_SB(0, 1), cB + hstep, voffB); PG8_STAGE(PG8_SA(0, 0), cA, voffA); PG8_STAGE(PG8_SA(0, 1), cA + hstep, voffA);
        if (wr == 1) PG8_BAR;
        PG8_WAIT_V(2); PG8_BAR;
        PG8_STAGE(PG8_SB(1, 0), cB + kstep, voffB); PG8_STAGE(PG8_SA(1, 0), cA + kstep, voffA); PG8_STAGE(PG8_SB(1, 1), cB + hstep + kstep, voffB);
        PG8_WAIT_V(6); PG8_BAR;
    } else {
        PG8_STAGE(PG8_SB(0, 0), cB, voffB); PG8_STAGE(PG8_SA(0, 0), cA, voffA); PG8_STAGE(PG8_SB(0, 1), cB + hstep, voffB); PG8_STAGE(PG8_SA(0, 1), cA + hstep, voffA);
        if (wr == 1) PG8_BAR;
        PG8_WAIT_V(4); PG8_BAR;
        PG8_STAGE(PG8_SB(1, 0), cB + kstep, voffB); PG8_STAGE(PG8_SA(1, 0), cA + kstep, voffA); PG8_STAGE(PG8_SB(1, 1), cB + hstep + kstep, voffB);
        PG8_WAIT_V(6); PG8_BAR;
    }
    for (;;) {
        const bool has_next = S.next(ui + 1, nxt);
        const char* nA = has_next ? (const char*)g.A + (size_t)nxt.pm * tstep : cA; const char* nB = has_next ? (const char*)g.Bt + (size_t)nxt.pn * tstep : cB;
        for (int t = 0; t < nt; t += 2) {
            const bool last = (t == nt - 2);
            const char* a1 = cA + (size_t)(t + 1) * kstep;
            const char* a2 = last ? nA : cA + (size_t)(t + 2) * kstep; const char* b2 = last ? nB : cB + (size_t)(t + 2) * kstep;
            const char* a3 = a2 + kstep; const char* b3 = b2 + kstep;
            if (last && has_next) S.a_ready(nxt);
            if constexpr (SP2) {
            PG8_LDB(B0, 0, 0); PG8_LDB(B1, 0, 1); PG8_SCHED; PG8_LDA(At, 0, 0); PG8_STAGE(PG8_SA(1, 1), a1 + hstep, voffA);
            PG8_WAIT_V(8); PG8_WAIT_L(0); PG8_BAR; PG8_MMA(0, 0, At, B0); PG8_MMA(0, 1, At, B1); PG8_BAR; PG8_SCHED;
            PG8_LDA(At, 0, 1); PG8_STAGE(PG8_SB(0, 0), b2, voffB); PG8_STAGE(PG8_SB(0, 1), b2 + hstep, voffB); PG8_STAGE(PG8_SA(0, 0), a2, voffA);
            PG8_WAIT_V(8); PG8_WAIT_L(0); PG8_BAR; PG8_MMA(1, 0, At, B0); PG8_MMA(1, 1, At, B1); PG8_BAR; PG8_SCHED;
            PG8_LDB(B0, 1, 0); PG8_LDB(B1, 1, 1); PG8_SCHED; PG8_LDA(At, 1, 0); PG8_STAGE(PG8_SA(0, 1), a2 + hstep, voffA);
            PG8_WAIT_V(8); PG8_WAIT_L(0); PG8_BAR; PG8_MMA(0, 0, At, B0); PG8_MMA(0, 1, At, B1); PG8_BAR; PG8_SCHED;
            PG8_LDA(At, 1, 1); PG8_STAGE(PG8_SB(1, 0), b3, voffB); PG8_STAGE(PG8_SB(1, 1), b3 + hstep, voffB); PG8_STAGE(PG8_SA(1, 0), a3, voffA);
            PG8_WAIT_V(8); PG8_WAIT_L(0); PG8_BAR; PG8_MMA(1, 0, At, B0); PG8_MMA(1, 1, At, B1); PG8_BAR; PG8_SCHED;
            } else {
            PG8_LDB(B0, 0, 0); PG8_SCHED; PG8_LDA(At, 0, 0); PG8_STAGE(PG8_SA(1, 1), a1 + hstep, voffA);
            PG8_WAIT_L(8); PG8_BAR; PG8_WAIT_L(0); PG8_MMA(0, 0, At, B0); PG8_BAR; PG8_SCHED;
            PG8_LDB(B1, 0, 1); PG8_STAGE(PG8_SB(0, 0), b2, voffB);
            PG8_BAR; PG8_WAIT_L(0); PG8_MMA(0, 1, At, B1); PG8_BAR;
            PG8_LDA(At, 0, 1); PG8_STAGE(PG8_SA(0, 0), a2, voffA);
            PG8_BAR; PG8_WAIT_L(0); PG8_MMA(1, 0, At, B0); PG8_BAR; PG8_SCHED;
            PG8_STAGE(PG8_SB(0, 1), b2 + hstep, voffB);
            PG8_WAIT_V(6); PG8_BAR; PG8_MMA(1, 1, At, B1); PG8_BAR;
            PG8_LDB(B0, 1, 0); PG8_SCHED; PG8_LDA(At, 1, 0); PG8_STAGE(PG8_SA(0, 1), a2 + hstep, voffA);
            PG8_WAIT_L(8); PG8_BAR; PG8_WAIT_L(0); PG8_MMA(0, 0, At, B0); PG8_BAR; PG8_SCHED;
            PG8_LDB(B1, 1, 1); PG8_STAGE(PG8_SB(1, 0), b3, voffB);
            PG8_BAR; PG8_WAIT_L(0); PG8_MMA(0, 1, At, B1); PG8_BAR;
            PG8_LDA(At, 1, 1); PG8_STAGE(PG8_SA(1, 0), a3, voffA);
            PG8_BAR; PG8_WAIT_L(0); PG8_MMA(1, 0, At, B0); PG8_BAR; PG8_SCHED;
            PG8_STAGE(PG8_SB(1, 1), b3 + hstep, voffB);
            PG8_WAIT_V(6); PG8_BAR; PG8_MMA(1, 1, At, B1); PG8_BAR;
            }
        }
        if constexpr (ALIGN_EPI) { if (wr == 0) PG8_BAR; }
        if constexpr (!Epi::AFTER_DRAIN) { E(acc, cur, wr, wc, fr, fq); S.done(cur); }
        if (!has_next) break;
#pragma unroll
        for (int a = 0; a < 2; ++a)
#pragma unroll
            for (int b = 0; b < 2; ++b)
#pragma unroll
                for (int m = 0; m < 4; ++m)
#pragma unroll
                    for (int n = 0; n < 2; ++n) acc[a][b][m][n] = (f32x4){0.f, 0.f, 0.f, 0.f};
        cur = nxt; cA = nA; cB = nB; ++ui;
        if constexpr (ALIGN_EPI) { if (wr == 1) PG8_BAR; }
    }
    PG8_WAIT_V(0);
    if constexpr (!ALIGN_EPI) { if (wr == 0) PG8_BAR; }
    PG8_BAR;
    if constexpr (Epi::AFTER_DRAIN) { E.fused(acc, cur, wr, wc, fr, fq, lds, wid, lane); S.done(cur); }
#undef PG8_SA
#undef PG8_SB
#undef PG8_STAGE
#undef PG8_LDA
#undef PG8_LDB
#undef PG8_MMA
#undef PG8_WAIT_V
#undef PG8_WAIT_L
#undef PG8_BAR
#undef PG8_SCHED
}
}
constexpr int DM = 1024, NB = 8, SEQ = 8192, CTX = 256, SKV = SEQ + CTX;
constexpr int MLAT = NB * SEQ, MALL = MLAT + NB * CTX;
constexpr int NINP = 5376;
typedef unsigned short bf16_t;
typedef short bf16x8 __attribute__((ext_vector_type(8)));
typedef short s16x4 __attribute__((ext_vector_type(4)));
typedef float f32x16 __attribute__((ext_vector_type(16)));
typedef float f32x4 __attribute__((ext_vector_type(4)));
typedef unsigned u32x4 __attribute__((ext_vector_type(4)));
typedef unsigned u32x2 __attribute__((ext_vector_type(2)));
#define LAS __attribute__((address_space(3)))
#define SBAR() __builtin_amdgcn_sched_barrier(0)
typedef float f32x2_t __attribute__((ext_vector_type(2)));
typedef __bf16 bf16x2_t __attribute__((ext_vector_type(2)));
__device__ __forceinline__ unsigned cvtpk(float lo, float hi) { f32x2_t v = {lo, hi}; bf16x2_t b = __builtin_convertvector(v, bf16x2_t); return __builtin_bit_cast(unsigned, b); }
__device__ __forceinline__ unsigned cvtpk_a(float lo, float hi) { unsigned r; asm volatile("v_cvt_pk_bf16_f32 %0, %1, %2" : "=v"(r) : "v"(lo), "v"(hi)); return r; }
__device__ __forceinline__ unsigned f2bf(float f) { unsigned u = __builtin_bit_cast(unsigned, f); return (u + 0x7fffu + ((u >> 16) & 1u)) >> 16; }
__device__ __forceinline__ float bf2f(unsigned short b) { return __builtin_bit_cast(float, (unsigned)b << 16); }
__device__ __forceinline__ float bflo(unsigned w) { return __builtin_bit_cast(float, w << 16); }
__device__ __forceinline__ float bfhi(unsigned w) { return __builtin_bit_cast(float, w & 0xffff0000u); }
__device__ __forceinline__ float sigmoidf_(float v) { return 1.f / (1.f + __expf(-v)); }
__device__ __forceinline__ float sigmoid_fast(float v) { return __builtin_amdgcn_rcpf(1.f + __builtin_amdgcn_exp2f(-1.4426950408889634f * v)); }
__device__ __forceinline__ float wave_sum(float v) {
#pragma unroll
    for (int o = 1; o < 64; o <<= 1) v += shflx(v, o);
    return v;
}

namespace att {
#ifndef PROBE_NOLOAD
#define PROBE_NOLOAD 0
#endif
template <bool MLA> struct Cfg {
    static constexpr int DQK = MLA ? 96 : 64, DV = MLA ? 64 : 128, NQ = DQK / 16, NCB = DV / 32;
    static constexpr int KROWB = MLA ? 272 : 144;
    static constexpr int LDQ = MLA ? 768 : 512, LDK = MLA ? 768 : 512, LDV = 512;
    static constexpr int SHM_V = 64 * DV * 2, SHM_K = 64 * KROWB;
};
constexpr float THR = 8.f;
__device__ __forceinline__ int crow(int r, int hi) { return (r & 3) + 8 * (r >> 2) + 4 * hi; }
template <bool MLA> __device__ __forceinline__ int kswz(int row, int colB) { return row * Cfg<MLA>::KROWB + colB; }
__device__ __forceinline__ float max3f(float a, float b, float c) { return __builtin_fmaxf(__builtin_fmaxf(a, b), c); }
__device__ __forceinline__ void rowmax_adjust(f32x16& p0, f32x16& p1, float& m2, f32x16& negm, float& alpha, const bool first) {
    constexpr float THR2 = THR * 1.4426950408889634f;
    float pmax = max3f(p0[0], p0[1], p0[2]);
#pragma unroll
    for (int r = 3; r < 15; r += 2) pmax = max3f(pmax, p0[r], p0[r + 1]);
    pmax = max3f(pmax, p0[15], p1[0]);
#pragma unroll
    for (int r = 1; r < 15; r += 2) pmax = max3f(pmax, p1[r], p1[r + 1]);
    pmax = fmaxf(pmax, p1[15]);
    { auto rr = __builtin_amdgcn_permlane32_swap(__float_as_uint(pmax), __float_as_uint(pmax), false, false);
      pmax = fmaxf(__uint_as_float(rr[0]), __uint_as_float(rr[1])); }
    if (!first && __builtin_expect(__all(pmax <= THR2), 1)) { alpha = 1.f; }
    else {
        const float delta = first ? pmax : fmaxf(pmax, 0.f);
        alpha = first ? 1.f : __builtin_amdgcn_exp2f(-delta);
        m2 += delta;
#pragma unroll
        for (int r = 0; r < 16; ++r) { p0[r] -= delta; p1[r] -= delta; }
        const float nm = -m2;
#pragma unroll
        for (int r = 0; r < 16; ++r) asm volatile("v_mov_b32 %0, %1" : "+v"(negm[r]) : "v"(nm));
    }
}
__device__ __forceinline__ float exp_pack(f32x16& p0, f32x16& p1, bf16x8& pa0, bf16x8& pa1, bf16x8& pa2, bf16x8& pa3) {
#pragma unroll
    for (int r = 0; r < 16; ++r) p0[r] = __builtin_amdgcn_exp2f(p0[r]);
#pragma unroll
    for (int r = 0; r < 16; ++r) p1[r] = __builtin_amdgcn_exp2f(p1[r]);
    SBAR(); asm volatile("s_nop 1" ::: "memory"); SBAR();
#define PK4(P, BASE, OUT) do { u32x4 w = {cvtpk_a(P[BASE + 0], P[BASE + 1]), cvtpk_a(P[BASE + 2], P[BASE + 3]), cvtpk_a(P[BASE + 4], P[BASE + 5]), cvtpk_a(P[BASE + 6], P[BASE + 7])}; \
    OUT = *reinterpret_cast<bf16x8*>(&w); } while (0)
    PK4(p0, 0, pa0); PK4(p0, 8, pa1); PK4(p1, 0, pa2); PK4(p1, 8, pa3);
#undef PK4
    float ps0 = p0[0], ps1 = p1[0];
#pragma unroll
    for (int r = 1; r < 16; ++r) { ps0 += p0[r]; ps1 += p1[r]; }
    float ps = ps0 + ps1;
    { auto rr = __builtin_amdgcn_permlane32_swap(__float_as_uint(ps), __float_as_uint(ps), false, false);
      ps = __uint_as_float(rr[0]) + __uint_as_float(rr[1]); }
    return ps;
}
template <bool MLA> __device__ __forceinline__ void qkt(f32x16& p0, f32x16& p1, const char* Ks, const bf16x8* qr, const f32x16& negm, int r32, int hi) {
    constexpr int NQ = Cfg<MLA>::NQ;
    bf16x8 kf[2 * NQ];
#pragma unroll
    for (int d0 = 0; d0 < NQ; ++d0) { const int cb = (d0 * 16 + hi * 8) * 2;
        kf[2 * d0] = *reinterpret_cast<const bf16x8*>(Ks + kswz<MLA>(r32, cb));
        kf[2 * d0 + 1] = *reinterpret_cast<const bf16x8*>(Ks + kswz<MLA>(32 + r32, cb)); }
    SBAR();
    p0 = negm; p1 = negm;
#pragma unroll
    for (int d0 = 0; d0 < NQ; ++d0) {
        p0 = __builtin_amdgcn_mfma_f32_32x32x16_bf16(kf[2 * d0], qr[d0], p0, 0, 0, 0);
        p1 = __builtin_amdgcn_mfma_f32_32x32x16_bf16(kf[2 * d0 + 1], qr[d0], p1, 0, 0, 0); }
}
template <int NCB> __device__ __forceinline__ int v_st(int k, int c) { const int kk = k;     return ((kk >> 3) * NCB + (c >> 5)) * 512 + ((kk & 7) * 32 + (c & 31)) * 2; }
__device__ __forceinline__ int v_rd_base(int lane) { return ((lane & 3) << 3) | (((lane >> 2) & 3) << 6) | (((lane >> 4) & 1) << 5) | (((lane >> 5) & 1) << 8); }
template <int NCB> constexpr int v_rd_off(int d0, int ks, int half) { return d0 * 512 + (ks * 2 + half) * NCB * 512; }
template <int OFF> __device__ __forceinline__ s16x4 tr_read(int vb) {
    s16x4 r; asm volatile("ds_read_b64_tr_b16 %0, %1 offset:%2" : "=&v"(r) : "v"(vb), "i"(OFF) : "memory"); return r;
}
template <int NCB, int D0> __device__ __forceinline__ void pv_one(f32x16& od, int vb, bf16x8 pa0, bf16x8 pa1, bf16x8 pa2, bf16x8 pa3) {
    const s16x4 l0 = tr_read<v_rd_off<NCB>(D0, 0, 0)>(vb), h0 = tr_read<v_rd_off<NCB>(D0, 0, 1)>(vb), l1 = tr_read<v_rd_off<NCB>(D0, 1, 0)>(vb), h1 = tr_read<v_rd_off<NCB>(D0, 1, 1)>(vb);
    const s16x4 l2 = tr_read<v_rd_off<NCB>(D0, 2, 0)>(vb), h2 = tr_read<v_rd_off<NCB>(D0, 2, 1)>(vb), l3 = tr_read<v_rd_off<NCB>(D0, 3, 0)>(vb), h3 = tr_read<v_rd_off<NCB>(D0, 3, 1)>(vb);
    asm volatile("s_waitcnt lgkmcnt(0)" ::: "memory"); SBAR();
#define PK(L, H) (bf16x8){L[0], L[1], L[2], L[3], H[0], H[1], H[2], H[3]}
    od = __builtin_amdgcn_mfma_f32_32x32x16_bf16(pa0, PK(l0, h0), od, 0, 0, 0);
    od = __builtin_amdgcn_mfma_f32_32x32x16_bf16(pa1, PK(l1, h1), od, 0, 0, 0);
    od = __builtin_amdgcn_mfma_f32_32x32x16_bf16(pa2, PK(l2, h2), od, 0, 0, 0);
    od = __builtin_amdgcn_mfma_f32_32x32x16_bf16(pa3, PK(l3, h3), od, 0, 0, 0);
#undef PK
}
template <int NCB> __device__ __forceinline__ void pv_all(f32x16* o, int vb, bf16x8 pa0, bf16x8 pa1, bf16x8 pa2, bf16x8 pa3) {
    pv_one<NCB, 0>(o[0], vb, pa0, pa1, pa2, pa3); pv_one<NCB, 1>(o[1], vb, pa0, pa1, pa2, pa3);
    if constexpr (NCB == 4) { pv_one<NCB, 2>(o[2], vb, pa0, pa1, pa2, pa3); pv_one<NCB, 3>(o[3], vb, pa0, pa1, pa2, pa3); }
}

template <int NCB, int D0> __device__ __forceinline__ void v_frag_read(s16x4 (&f)[8], int vb) {
    f[0] = tr_read<v_rd_off<NCB>(D0, 0, 0)>(vb); f[1] = tr_read<v_rd_off<NCB>(D0, 0, 1)>(vb); f[2] = tr_read<v_rd_off<NCB>(D0, 1, 0)>(vb); f[3] = tr_read<v_rd_off<NCB>(D0, 1, 1)>(vb);
    f[4] = tr_read<v_rd_off<NCB>(D0, 2, 0)>(vb); f[5] = tr_read<v_rd_off<NCB>(D0, 2, 1)>(vb); f[6] = tr_read<v_rd_off<NCB>(D0, 3, 0)>(vb); f[7] = tr_read<v_rd_off<NCB>(D0, 3, 1)>(vb);
}
__device__ __forceinline__ void pv_mma(f32x16& od, const s16x4 (&f)[8], bf16x8 pa0, bf16x8 pa1, bf16x8 pa2, bf16x8 pa3) {
#define PK(L, H) (bf16x8){L[0], L[1], L[2], L[3], H[0], H[1], H[2], H[3]}
    od = __builtin_amdgcn_mfma_f32_32x32x16_bf16(pa0, PK(f[0], f[1]), od, 0, 0, 0);
    od = __builtin_amdgcn_mfma_f32_32x32x16_bf16(pa1, PK(f[2], f[3]), od, 0, 0, 0);
    od = __builtin_amdgcn_mfma_f32_32x32x16_bf16(pa2, PK(f[4], f[5]), od, 0, 0, 0);
    od = __builtin_amdgcn_mfma_f32_32x32x16_bf16(pa3, PK(f[6], f[7]), od, 0, 0, 0);
#undef PK
}
__device__ __forceinline__ void pv_mma2(f32x16& oa, f32x16& ob, const s16x4 (&f)[8], const s16x4 (&h)[8], bf16x8 pa0, bf16x8 pa1, bf16x8 pa2, bf16x8 pa3) {
#define PK(L, H) (bf16x8){L[0], L[1], L[2], L[3], H[0], H[1], H[2], H[3]}
    oa = __builtin_amdgcn_mfma_f32_32x32x16_bf16(pa0, PK(f[0], f[1]), oa, 0, 0, 0); ob = __builtin_amdgcn_mfma_f32_32x32x16_bf16(pa0, PK(h[0], h[1]), ob, 0, 0, 0);
    oa = __builtin_amdgcn_mfma_f32_32x32x16_bf16(pa1, PK(f[2], f[3]), oa, 0, 0, 0); ob = __builtin_amdgcn_mfma_f32_32x32x16_bf16(pa1, PK(h[2], h[3]), ob, 0, 0, 0);
    oa = __builtin_amdgcn_mfma_f32_32x32x16_bf16(pa2, PK(f[4], f[5]), oa, 0, 0, 0); ob = __builtin_amdgcn_mfma_f32_32x32x16_bf16(pa2, PK(h[4], h[5]), ob, 0, 0, 0);
    oa = __builtin_amdgcn_mfma_f32_32x32x16_bf16(pa3, PK(f[6], f[7]), oa, 0, 0, 0); ob = __builtin_amdgcn_mfma_f32_32x32x16_bf16(pa3, PK(h[6], h[7]), ob, 0, 0, 0);
#undef PK
}
#define LWAIT0() do { asm volatile("s_waitcnt lgkmcnt(0)" ::: "memory"); SBAR(); } while (0)
template <bool MLA>
__device__ __forceinline__ void attn_core(const bf16_t* __restrict__ Qb, const bf16_t* __restrict__ Kh, const bf16_t* __restrict__ Vh, int seq, char* lds,
                                          f32x16 (&o)[Cfg<MLA>::NCB], const int wid  , const int g  ) {
    using CF = Cfg<MLA>;
    constexpr int NQ = CF::NQ, NCB = CF::NCB, SHM_V = CF::SHM_V, SHM_K = CF::SHM_K, LDQ = CF::LDQ, LDK = CF::LDK, LDV = CF::LDV;
    const int lane = lane_id_v(), tid = wid * 64 + lane, r32 = lane & 31, hi = lane >> 5;
    char* V_lds = lds; char* K_lds = lds + 4 * SHM_V;
    float* wsp = (float*)(lds + 93184) + wid * 64; float* li_l = wsp; float* al_l = wsp + 32;
    float m2 = 0.f, l_reg = 0.f; f32x16 negm = f32x16{}; bf16x8 qr[NQ];
#pragma unroll
    for (int d = 0; d < NCB; ++d) o[d] = f32x16{};
    const bf16_t* Qw = Qb + (long)(wid * 32 + r32) * LDQ + hi * 8;
#pragma unroll
    for (int d0 = 0; d0 < NQ; ++d0) qr[d0] = *reinterpret_cast<const bf16x8*>(Qw + d0 * 16);
    const int vr0 = MLA ? (tid >> 3) : (tid >> 4), vc0 = MLA ? (tid & 7) * 8 : (tid & 15) * 8;
    const int vst0 = v_st<NCB>(vr0, vc0), vst1 = v_st<NCB>(32 + vr0, vc0);
    const int kcA = tid, krA = MLA ? (kcA / 12) : (tid >> 3), kcolA = MLA ? (kcA % 12) * 8 : (tid & 7) * 8;
    const int kcB = 512 + (tid & 255), krB = kcB / 12, kcolB = (kcB % 12) * 8;
    const int kstA = kswz<MLA>(krA, kcolA * 2), kstB = kswz<MLA>(krB, kcolB * 2);
    const int vb0 = (int)(uintptr_t)V_lds + v_rd_base(lane);
    struct { bf16x8 a, b, c; } sr_[2];
    const unsigned goA = MLA ? (unsigned)(vr0 * LDV + vc0) * 2u : (unsigned)(vr0 * LDV + vc0) * 2u;
    const unsigned goB = MLA ? (unsigned)(krA * LDK + kcolA) * 2u : (unsigned)((32 + vr0) * LDV + vc0) * 2u;
    const unsigned goC = MLA ? (unsigned)(krB * LDK + kcolB) * 2u : (unsigned)(krA * LDK + kcolA) * 2u;
#define SLOAD(i, k0) do { const char* kt_ = (const char*)(Kh + (size_t)(k0) * LDK); const char* vt_ = (const char*)(Vh + (size_t)(k0) * LDV); \
    if constexpr (MLA) { \
        sr_[i].a = *reinterpret_cast<const bf16x8*>(vt_ + goA); sr_[i].b = *reinterpret_cast<const bf16x8*>(kt_ + goB); sr_[i].c = *reinterpret_cast<const bf16x8*>(kt_ + goC); \
    } else { \
        sr_[i].a = *reinterpret_cast<const bf16x8*>(vt_ + goA); sr_[i].b = *reinterpret_cast<const bf16x8*>(vt_ + goB); sr_[i].c = *reinterpret_cast<const bf16x8*>(kt_ + goC); } } while (0)
#define SWRITE(ko, vo, i) do { if constexpr (MLA) { \
        *(bf16x8*)(V_lds + (vo) + vst0) = sr_[i].a; \
        *(bf16x8*)(K_lds + (ko) + kstA) = sr_[i].b; \
        if (wid < 4) *(bf16x8*)(K_lds + (ko) + kstB) = sr_[i].c; \
    } else { \
        *(bf16x8*)(V_lds + (vo) + vst0) = sr_[i].a; \
        *(bf16x8*)(V_lds + (vo) + vst1) = sr_[i].b; \
        *(bf16x8*)(K_lds + (ko) + kstA) = sr_[i].c; } } while (0)
#define SWAIT() asm volatile("s_waitcnt vmcnt(3)" ::: "memory")
#define RESC(a) do { if (__any((a) < 1.f)) { if (hi == 0) al_l[r32] = (a); asm volatile("s_waitcnt lgkmcnt(0)" ::: "memory"); \
    _Pragma("unroll") for (int r = 0; r < 16; ++r) { const float al_ = al_l[crow(r, hi)]; _Pragma("unroll") for (int d = 0; d < NCB; ++d) o[d][r] *= al_; } } } while (0)
    f32x16 S0, S1; float alpha = 1.f; bf16x8 pa0, pa1, pa2, pa3; const int NT = seq / 64;
    constexpr int SE = 0, SO = 1;
#define MSEG(j) do { const int j_ = (j); const bool doqk = j_ < NT, dopv = j_ > 0; \
        const char* Ks_ = K_lds + (j_ % 3) * SHM_K; const int vb_ = vb0 + ((j_ - 1) & 3) * SHM_V; \
        bf16x8 kf[2 * NQ]; s16x4 fa[8], fb[8]; \
        if (doqk) { _Pragma("unroll") for (int d0 = 0; d0 < NQ; ++d0) { const int cb = (d0 * 16 + hi * 8) * 2; \
            kf[2 * d0] = *reinterpret_cast<const bf16x8*>(Ks_ + kswz<MLA>(r32, cb)); kf[2 * d0 + 1] = *reinterpret_cast<const bf16x8*>(Ks_ + kswz<MLA>(32 + r32, cb)); } } \
        if (dopv) { v_frag_read<NCB, 0>(fa, vb_); if constexpr (NCB == 2) v_frag_read<NCB, 1>(fb, vb_); }     \
        SBAR(); \
        if (doqk) { S0 = negm; S1 = negm; _Pragma("unroll") for (int d0 = 0; d0 < NQ; ++d0) { \
            S0 = __builtin_amdgcn_mfma_f32_32x32x16_bf16(kf[2 * d0], qr[d0], S0, 0, 0, 0); S1 = __builtin_amdgcn_mfma_f32_32x32x16_bf16(kf[2 * d0 + 1], qr[d0], S1, 0, 0, 0); } } \
        if (dopv) { if constexpr (NCB == 4) { SBAR(); v_frag_read<NCB, 1>(fb, vb_); }     \
            LWAIT0(); \
            if constexpr (NCB == 4) { pv_mma2(o[0], o[1], fa, fb, pa0, pa1, pa2, pa3); SBAR(); v_frag_read<NCB, 2>(fa, vb_); v_frag_read<NCB, 3>(fb, vb_); \
                LWAIT0(); pv_mma2(o[2], o[NCB - 1], fa, fb, pa0, pa1, pa2, pa3); } \
            else { pv_mma2(o[0], o[1], fa, fb, pa0, pa1, pa2, pa3); } } } while (0)
#define VSEG(j) do { rowmax_adjust(S0, S1, m2, negm, alpha, (j) == 0); RESC(alpha); l_reg = l_reg * alpha + exp_pack(S0, S1, pa0, pa1, pa2, pa3); } while (0)
    __syncthreads();
    SLOAD(SE, 0); SLOAD(SO, 64); asm volatile("s_waitcnt vmcnt(0)" ::: "memory");
    SWRITE(0, 0, SE); SWRITE(SHM_K, SHM_V, SO);
    SLOAD(SE, 2 * 64); SLOAD(SO, 3 * 64);
    __syncthreads();
    { int g_ = g; asm volatile("" : "+s"(g_)); if (g_ == 1) __syncthreads(); }
    for (int j = 0; j < NT; j += 2) {
        SBAR(); MSEG(j); SBAR();
        __syncthreads();
        SBAR(); VSEG(j);
        SWAIT(); if (j + 2 < NT) SWRITE(((j + 2) % 3) * SHM_K, ((j + 2) & 3) * SHM_V, SE);
        if (!(MLA && PROBE_NOLOAD)) { const int tn = (j + 4 < NT) ? j + 4 : NT - 1; SLOAD(SE, tn * 64); } SBAR();
        __syncthreads();
        SBAR(); MSEG(j + 1); SBAR();
        __syncthreads();
        SBAR(); VSEG(j + 1);
        SWAIT(); if (j + 3 < NT) SWRITE(((j + 3) % 3) * SHM_K, ((j + 3) & 3) * SHM_V, SO);
        if (!(MLA && PROBE_NOLOAD)) { const int tn = (j + 5 < NT) ? j + 5 : NT - 1; SLOAD(SO, tn * 64); } SBAR();
        __syncthreads();
    }
    SBAR(); MSEG(NT); SBAR();
    { int g_ = g; asm volatile("" : "+s"(g_)); if (g_ == 0) __syncthreads(); }
#undef MSEG
#undef VSEG
    asm volatile("s_waitcnt vmcnt(0)" ::: "memory");
    if (hi == 0) li_l[r32] = l_reg; asm volatile("s_waitcnt lgkmcnt(0)" ::: "memory");
#pragma unroll
    for (int r = 0; r < 16; ++r) { const float rl = __builtin_amdgcn_rcpf(li_l[crow(r, hi)]);
#pragma unroll
        for (int d = 0; d < NCB; ++d) o[d][r] *= rl; }
#undef SLOAD
#undef SWRITE
#undef SWAIT
#undef RESC
}
}
typedef float2 cs_t;
__device__ __forceinline__ void store8(bf16_t* p, f32x4 v0, f32x4 v1) {
    u32x4 w; w.x = cvtpk(v0[0], v0[1]); w.y = cvtpk(v0[2], v0[3]); w.z = cvtpk(v1[0], v1[1]); w.w = cvtpk(v1[2], v1[3]);
    *(u32x4*)p = w;
}
__device__ __forceinline__ float dot8(f32x4 v0, f32x4 v1) { return (v0[0] * v0[0] + v0[1] * v0[1]) + (v0[2] * v0[2] + v0[3] * v0[3]) + (v1[0] * v1[0] + v1[1] * v1[1]) + (v1[2] * v1[2] + v1[3] * v1[3]); }
__device__ __forceinline__ void rope64(f32x4& v0, f32x4& v1, const cs_t* __restrict__ CS16, int gr, int gc, int wc, int fq, bool apply) {
    f32x4 p0, p1; const int ix = (lane_id_v() ^ 32) << 2;
#pragma unroll
    for (int j = 0; j < 4; ++j) { p0[j] = shfli(v0[j], ix); p1[j] = shfli(v1[j], ix); }
    if (apply) {
        const int pos = (wc & 1) ? gc : gr; const cs_t* t = CS16 + pos * 16 + 8 * (fq & 1);
        const float sg = (fq < 2) ? -1.f : 1.f;
#pragma unroll
        for (int j = 0; j < 4; ++j) { const cs_t a = t[j], b = t[4 + j];
            v0[j] = v0[j] * a.x + sg * p0[j] * a.y; v1[j] = v1[j] * b.x + sg * p1[j] * b.y; }
    }
}
__device__ __forceinline__ void rope32(f32x4& v0, f32x4& v1, const cs_t* __restrict__ CS8, int gr, int gc, int g, bool apply) {
    f32x4 p0, p1; const int ix = (lane_id_v() ^ 16) << 2;
#pragma unroll
    for (int j = 0; j < 4; ++j) { p0[j] = shfli(v0[j], ix); p1[j] = shfli(v1[j], ix); }
    if (apply) {
        const int pos = (g >= 2) ? gc : gr; const cs_t* t = CS8 + pos * 8;
        const float sg = (g & 1) ? 1.f : -1.f;
#pragma unroll
        for (int j = 0; j < 4; ++j) { const cs_t a = t[j], b = t[4 + j];
            v0[j] = v0[j] * a.x + sg * p0[j] * a.y; v1[j] = v1[j] * b.x + sg * p1[j] * b.y; }
    }
}
#define EPI_ARGS const pg8::f32x4 (&acc)[2][2][4][2], const pg8::Unit& u, int wr, int wc, int fr, int fq
#define EPI_RECOMPUTE { const int l_ = lane_id_v(); fr = l_ & 15; fq = l_ >> 4; }

struct EpiP1 {
    static constexpr bool PERM = true, AFTER_DRAIN = false;
    bf16_t *CKV, *CQ, *KMLA, *GA, *DQ, *DK, *DV, *GD, *MG; float *SSKV, *SSQ; const cs_t *CS16, *CS8; bool do_stats;
    __device__ __forceinline__ void operator()(EPI_ARGS) const {
        EPI_RECOMPUTE
        const int pm = u.pm, pn = u.pn; const bool lat = pm < 256;
        if (!lat && !(pn == 0 || pn == 2 || (pn >= 7 && pn <= 10))) return;
        const int row0 = pm * 256 + wr * 64 + fr;
        const int kv0 = (lat ? (pm >> 5) * SKV + CTX + (pm & 31) * 256 : (pm - 256) * SKV) + wr * 64 + fr;
        const int lcw = wc * 32 + 8 * fq;
#pragma unroll
        for (int ai = 0; ai < 2; ++ai)
#pragma unroll
            for (int m = 0; m < 4; ++m) {
                __builtin_amdgcn_sched_barrier(0); const int row = opq(row0 + ai * 128 + m * 16), kvrow = kv0 + (row - row0);
                const int s = row & (SEQ - 1), gr = s >> 6, gc = s & 63;
                float ssq = 0.f;
#pragma unroll
                for (int bj = 0; bj < 2; ++bj) {
                    f32x4 v0 = acc[ai][bj][m][0], v1 = acc[ai][bj][m][1]; const int lc = bj * 128 + lcw;
                    if (pn == 0) { ssq += dot8(v0, v1); store8(CKV + (size_t)kvrow * 256 + lc, v0, v1); }
                    else if (pn == 1) { ssq += dot8(v0, v1); store8(CQ + (size_t)row * 384 + lc, v0, v1); }
                    else if (pn == 2) {
                        if (bj == 0) { if (lat) { ssq += dot8(v0, v1); store8(CQ + (size_t)row * 384 + 256 + lc, v0, v1); } }
                        else if (wc == 0) { rope32(v0, v1, CS8, gr, gc, fq, lat);
#pragma unroll
                            for (int h = 0; h < 8; ++h) store8(KMLA + (size_t)kvrow * 768 + h * 96 + 64 + 8 * fq, v0, v1); }
                    }
                    else if (pn <= 4 || pn == 11 || pn == 12) {
#pragma unroll
                        for (int j = 0; j < 4; ++j) { v0[j] = v0[j] * sigmoid_fast(v0[j]); v1[j] = v1[j] * sigmoid_fast(v1[j]); }
                        bf16_t* dst = (pn <= 4) ? GA + (size_t)row * 512 + (pn - 3) * 256 + lc : GD + (size_t)row * 512 + (pn - 11) * 256 + lc;
                        store8(dst, v0, v1);
                    }
                    else if (pn <= 6) { v0 = v0 * 0.18033688011112042f; v1 = v1 * 0.18033688011112042f;
                        rope64(v0, v1, CS16, gr, gc, wc, fq, true); store8(DQ + (size_t)row * 512 + (pn - 5) * 256 + lc, v0, v1); }
                    else if (pn <= 8) { rope64(v0, v1, CS16, gr, gc, wc, fq, lat); store8(DK + (size_t)kvrow * 512 + (pn - 7) * 256 + lc, v0, v1); }
                    else if (pn <= 10) { store8(DV + (size_t)kvrow * 512 + (pn - 9) * 256 + lc, v0, v1); }
                    else {
#pragma unroll
                        for (int j = 0; j < 4; ++j) { v0[j] = sigmoid_fast(v0[j]); v1[j] = sigmoid_fast(v1[j]); }
                        store8(MG + (size_t)row * 2048 + (pn - 13) * 256 + lc, v0, v1);
                    }
                }
                if (pn <= 2) {
                    ssq += shflx(ssq, 16); ssq += shflx(ssq, 32);
                    if (fq == 0) { if (pn == 0) SSKV[(size_t)kvrow * 4 + wc] = ssq; else if (lat) SSQ[(size_t)row * 8 + (pn - 1) * 4 + wc] = ssq; }
                }
            }
    }
};
struct EpiQ {
    static constexpr bool PERM = true, AFTER_DRAIN = false;
    bf16_t* QMLA; const float* SSQ; const cs_t* CS8;
    __device__ __forceinline__ void operator()(EPI_ARGS) const {
        EPI_RECOMPUTE
        const int row0 = u.pm * 256 + wr * 64 + fr;
#pragma unroll
        for (int ai = 0; ai < 2; ++ai)
#pragma unroll
            for (int m = 0; m < 4; ++m) {
                __builtin_amdgcn_sched_barrier(0); const int row = opq(row0 + ai * 128 + m * 16); const int s = row & (SEQ - 1), gr = s >> 6, gc = s & 63;
                const f32x4 sa = *(const f32x4*)(SSQ + (size_t)row * 8), sb = *(const f32x4*)(SSQ + (size_t)row * 8 + 4);
                const float rs = 0.14724445f / sqrtf((((sa[0] + sa[1]) + (sa[2] + sa[3])) + ((sb[0] + sb[1]) + (sb[2] + sb[3]))) * (1.f / 384.f) + 1e-6f);
#pragma unroll
                for (int bj = 0; bj < 2; ++bj) {
                    f32x4 v0 = acc[ai][bj][m][0] * rs, v1 = acc[ai][bj][m][1] * rs;
                    const int c0 = u.pn * 256 + bj * 128 + wc * 32 + 8 * fq, d = c0 % 96;
                    rope32(v0, v1, CS8, gr, gc, (d - 64) >> 3, d >= 64);
                    store8(QMLA + (size_t)row * 768 + c0, v0, v1);
                }
            }
    }
};
struct EpiKV {
    static constexpr bool PERM = true, AFTER_DRAIN = false;
    bf16_t *KMLA, *VMLA; const float* SSKV;
    __device__ __forceinline__ void operator()(EPI_ARGS) const {
        EPI_RECOMPUTE
        const int row0 = u.pm * 256 + wr * 64 + fr;
#pragma unroll
        for (int ai = 0; ai < 2; ++ai)
#pragma unroll
            for (int m = 0; m < 4; ++m) {
                __builtin_amdgcn_sched_barrier(0); const int row = opq(row0 + ai * 128 + m * 16);
                const f32x4 sa = *(const f32x4*)(SSKV + (size_t)row * 4);
                const float rs = 1.f / sqrtf(((sa[0] + sa[1]) + (sa[2] + sa[3])) * (1.f / 256.f) + 1e-6f);
#pragma unroll
                for (int bj = 0; bj < 2; ++bj) {
                    const f32x4 v0 = acc[ai][bj][m][0] * rs, v1 = acc[ai][bj][m][1] * rs;
                    const int h = u.pn * 2 + bj, d = wc * 32 + 8 * fq;
                    if (wc < 2) store8(KMLA + (size_t)row * 768 + h * 96 + d, v0, v1);
                    else store8(VMLA + (size_t)row * 512 + h * 64 + (d - 64), v0, v1);
                }
            }
    }
};
template <bool ACCUM> struct EpiZ {
    static constexpr bool PERM = true, AFTER_DRAIN = false;
    bf16_t* Z; const bf16_t* MG;
    __device__ __forceinline__ void operator()(EPI_ARGS) const {
        EPI_RECOMPUTE
        const int row0 = u.pm * 256 + wr * 64 + fr;
#pragma unroll
        for (int ai = 0; ai < 2; ++ai)
#pragma unroll
            for (int m = 0; m < 4; ++m) {
                __builtin_amdgcn_sched_barrier(0); const int row = opq(row0 + ai * 128 + m * 16);
#pragma unroll
                for (int bj = 0; bj < 2; ++bj) {
                    f32x4 v0 = acc[ai][bj][m][0], v1 = acc[ai][bj][m][1];
                    const int c0 = u.pn * 256 + bj * 128 + wc * 32 + 8 * fq;
                    const u32x4 g = *(const u32x4*)(MG + (size_t)row * 2048 + c0);
                    v0[0] *= bflo(g.x); v0[1] *= bfhi(g.x); v0[2] *= bflo(g.y); v0[3] *= bfhi(g.y);
                    v1[0] *= bflo(g.z); v1[1] *= bfhi(g.z); v1[2] *= bflo(g.w); v1[3] *= bfhi(g.w);
                    bf16_t* zp = Z + (size_t)row * 1024 + c0;
                    if (ACCUM) { const u32x4 z = *(const u32x4*)zp;
                        v0[0] += bflo(z.x); v0[1] += bfhi(z.x); v0[2] += bflo(z.y); v0[3] += bfhi(z.y);
                        v1[0] += bflo(z.z); v1[1] += bfhi(z.z); v1[2] += bflo(z.w); v1[3] += bfhi(z.w); }
                    store8(zp, v0, v1);
                }
            }
    }
};
struct EpiOut {
    static constexpr bool PERM = true, AFTER_DRAIN = false;
    float* OUT; const float* X; const float* MOD;
    __device__ __forceinline__ void operator()(EPI_ARGS) const {
        EPI_RECOMPUTE
        const int row0 = u.pm * 256 + wr * 64 + fr; const float ALPHA = 1.189207115002721f;
        const float* gate = MOD + (size_t)(u.pm >> 5) * 3072 + 2048;
#pragma unroll
        for (int ai = 0; ai < 2; ++ai)
#pragma unroll
            for (int m = 0; m < 4; ++m) {
                __builtin_amdgcn_sched_barrier(0); const int row = opq(row0 + ai * 128 + m * 16);
#pragma unroll
                for (int bj = 0; bj < 2; ++bj) {
                    const int c0 = u.pn * 256 + bj * 128 + wc * 32 + 8 * fq;
                    const f32x4 x0 = *(const f32x4*)(X + (size_t)row * 1024 + c0), x1 = *(const f32x4*)(X + (size_t)row * 1024 + c0 + 4);
                    const f32x4 g0 = *(const f32x4*)(gate + c0), g1 = *(const f32x4*)(gate + c0 + 4);
                    *(f32x4*)(OUT + (size_t)row * 1024 + c0) = x0 * ALPHA + g0 * acc[ai][bj][m][0];
                    *(f32x4*)(OUT + (size_t)row * 1024 + c0 + 4) = x1 * ALPHA + g1 * acc[ai][bj][m][1];
                }
            }
    }
};
constexpr size_t MiB = 1u << 20;
constexpr size_t WS_BAR = 0, CTL_ZERO_BYTES = 16384;
constexpr size_t WS_SSKV = 0, WS_SSQ = 512 * 1024;
constexpr size_t WS_MOD = 1 * MiB, WS_CS16 = 1 * MiB + 128 * 1024, WS_CS8 = 1 * MiB + 192 * 1024;
constexpr size_t WS_WIN = 2 * MiB, WS_WUQ = 13 * MiB, WS_WUKV = 14 * MiB, WS_WOA = 15 * MiB, WS_WOB = 16 * MiB, WS_WOUT = 17 * MiB;
constexpr size_t WS_HBF = 32 * MiB;
constexpr size_t WS_VMLA = WS_HBF, WS_Z = WS_HBF;
constexpr size_t WS_KMLA = 164 * MiB;
constexpr size_t WS_GA = 263 * MiB;
constexpr size_t WS_DQ = 327 * MiB;
constexpr size_t WS_DK = 391 * MiB;
constexpr size_t WS_DV = 457 * MiB;
constexpr size_t WS_GD = 523 * MiB;
constexpr size_t WS_MG = 587 * MiB;
constexpr size_t WS_QMLA = 843 * MiB;
constexpr size_t WS_SSKVP = 939 * MiB, WS_SSQP = 941 * MiB;
constexpr size_t WS_END = 944 * MiB;
constexpr size_t OUT_XA = 96 * MiB, OUT_XD = 160 * MiB;
constexpr size_t OUT_CKV = 0, OUT_CQ = 33 * MiB;
constexpr int LDS_BYTES = 160832;

struct Args {
    const float *x, *c, *ctx, *c_ctx, *w_mod, *b_mod, *w_in, *q_norm, *kv_norm, *w_uq, *w_ukv, *dlam, *subln, *w_oa, *w_ob, *w_out, *ln_g, *ln_b;
    float* out; unsigned char* ws;
};

__device__ __forceinline__ void tr_item(const float* __restrict__ W, int K, int N, int srcn0, const float* __restrict__ ksc, bf16_t* WT, int dstn0, int k0, float* scr, int lane) {
#pragma unroll 8
    for (int i = 0; i < 32; ++i) { const int kk = 2 * i + (lane >> 5);
        float v = 0.f; if (srcn0 >= 0) { v = W[(size_t)(k0 + kk) * N + srcn0 + (lane & 31)]; if (ksc) v *= ksc[k0 + kk]; }
        scr[kk * 33 + (lane & 31)] = v; }
    asm volatile("s_waitcnt lgkmcnt(0)" ::: "memory");
    const int c = lane & 7;
#pragma unroll
    for (int j = 0; j < 4; ++j) { const int n = (lane >> 3) + 8 * j; const float* s = scr + (8 * c) * 33 + n;
        u32x4 o; o.x = cvtpk(s[0 * 33], s[1 * 33]); o.y = cvtpk(s[2 * 33], s[3 * 33]); o.z = cvtpk(s[4 * 33], s[5 * 33]); o.w = cvtpk(s[6 * 33], s[7 * 33]);
        *(u32x4*)(WT + (size_t)(dstn0 + n) * K + k0 + 8 * c) = o; }
    asm volatile("s_waitcnt lgkmcnt(0)" ::: "memory");
}

#define XB_TMO      128
#define XB_XCNT(j)  (256  + 64 * (j))
#define XB_XSUB(j)  (1280 + 64 * (j))
#define XB_XGEN(j)  (2304 + 64 * (j))
#define XB_TOP      3328
#define XB_TOPGEN   3392
#define XCD_BAR_WORDS 3456
#define XB_SPIN_CAP (1u << 18)

__device__ __forceinline__ unsigned xb_ld(unsigned* p)              { return __hip_atomic_load(p, __ATOMIC_RELAXED, __HIP_MEMORY_SCOPE_AGENT); }
__device__ __forceinline__ unsigned xb_add(unsigned* p, unsigned v) { return __hip_atomic_fetch_add(p, v, __ATOMIC_RELAXED, __HIP_MEMORY_SCOPE_AGENT); }
__device__ __forceinline__ unsigned xb_xcc_id() { return (unsigned)__builtin_amdgcn_s_getreg((3 << 11) | 20) & 0xFu; }
#define XB_SPIN(cond, bar) do { unsigned _sp = 0; while (cond) { __builtin_amdgcn_s_sleep(1); \
    if ((++_sp & 255u) == 0u) { if (xb_ld(&(bar)[XB_TMO])) break; if (_sp > XB_SPIN_CAP) { atomicAdd(&(bar)[XB_TMO], 1u); break; } } } } while (0)

struct XcdBarrier {
    unsigned* bar; unsigned x;
    volatile LAS unsigned* st;
};

__device__ __forceinline__ XcdBarrier xcd_barrier_post(unsigned* bar, volatile LAS unsigned* st) {
    XcdBarrier b; b.bar = bar; b.x = xb_xcc_id(); b.st = st;
    if (threadIdx.x == 0) (void)xb_add(&bar[XB_XCNT(b.x)], 1u);
    return b;
}
__device__ __forceinline__ void xcd_barrier_complete(unsigned* bar, unsigned x, unsigned& nloc, unsigned& nx) {
    const unsigned G = gridDim.x * gridDim.y * gridDim.z;
    unsigned sum, cnt, mine, sp = 0u;
    for (;;) {
        sum = 0u; cnt = 0u; mine = 0u;
#pragma unroll
        for (unsigned j = 0; j < 16; ++j) { const unsigned c = xb_ld(&bar[XB_XCNT(j)]); sum += c; cnt += (c > 0u) ? 1u : 0u; mine = (j == x) ? c : mine; }
        if (sum == G) break;
        __builtin_amdgcn_s_sleep(1);
        if ((++sp & 255u) == 0u) { if (xb_ld(&bar[XB_TMO])) break; if (sp > XB_SPIN_CAP) { atomicAdd(&bar[XB_TMO], 1u); break; } }
    }
    nloc = mine > 0u ? mine : 1u; nx = cnt > 0u ? cnt : 1u;
}

__device__ __forceinline__ void xcd_barrier(const XcdBarrier& b) {
    asm volatile("s_waitcnt vmcnt(0)" ::: "memory");
    __syncthreads();
    if (threadIdx.x == 0) {
        unsigned* bar = b.bar;
        __builtin_amdgcn_s_waitcnt(0);
        unsigned nloc = b.st[0], nx = b.st[1];
        if (nloc == 0u) { xcd_barrier_complete(bar, b.x, nloc, nx); b.st[0] = nloc; b.st[1] = nx; }
        const unsigned old = xb_add(&bar[XB_XSUB(b.x)], 1u);
        const unsigned gen = old / nloc;
        if (old + 1u == (gen + 1u) * nloc) {
            __builtin_amdgcn_fence(__ATOMIC_RELEASE, "agent");
            asm volatile("s_waitcnt vmcnt(0)" ::: "memory");
            const unsigned og = xb_add(&bar[XB_TOP], 1u);
            const unsigned tg = og / nx;
            if (og + 1u == (tg + 1u) * nx) xb_add(&bar[XB_TOPGEN], 1u);
            else XB_SPIN(xb_ld(&bar[XB_TOPGEN]) == tg, bar);
            __builtin_amdgcn_fence(__ATOMIC_ACQUIRE, "agent");
            xb_add(&bar[XB_XGEN(b.x)], 1u);
            asm volatile("s_waitcnt vmcnt(0)" ::: "memory");
        } else {
            XB_SPIN(xb_ld(&bar[XB_XGEN(b.x)]) == gen, bar);
            __builtin_amdgcn_fence(__ATOMIC_ACQUIRE, "agent");
            asm volatile("s_waitcnt vmcnt(0)" ::: "memory");
        }
    }
    __syncthreads();
}

__global__ void __launch_bounds__(512, 2) fwd_mega(Args a) {
    extern __shared__ __attribute__((aligned(16))) unsigned char lds[];
    cg::grid_group grid = cg::this_grid();
    const int wave = __builtin_amdgcn_readfirstlane((int)threadIdx.x >> 6);
#define LANE_TID const int lane = lane_id_v(), tid = wave * 64 + lane; (void)tid; (void)lane;
    const int G = gridDim.x, bid = blockIdx.x;
    const int gw = bid * 8 + wave, NGW = G * 8;
    unsigned char* ws = a.ws; unsigned char* ob = (unsigned char*)a.out;
    float* SSKV = (float*)(ws + WS_SSKVP); float* SSQ = (float*)(ws + WS_SSQP); float* MOD = (float*)(ws + WS_MOD);
    cs_t* CS16 = (cs_t*)(ws + WS_CS16); cs_t* CS8 = (cs_t*)(ws + WS_CS8);
    bf16_t* WIN = (bf16_t*)(ws + WS_WIN); bf16_t* WUQ = (bf16_t*)(ws + WS_WUQ); bf16_t* WUKV = (bf16_t*)(ws + WS_WUKV);
    bf16_t* WOA = (bf16_t*)(ws + WS_WOA); bf16_t* WOB = (bf16_t*)(ws + WS_WOB); bf16_t* WOUT = (bf16_t*)(ws + WS_WOUT);
    bf16_t* HBF = (bf16_t*)(ws + WS_HBF); bf16_t* VMLA = (bf16_t*)(ws + WS_VMLA); bf16_t* Z = (bf16_t*)(ws + WS_Z);
    bf16_t* KMLA = (bf16_t*)(ws + WS_KMLA); bf16_t* GA = (bf16_t*)(ws + WS_GA); bf16_t* DQ = (bf16_t*)(ws + WS_DQ); bf16_t* DK = (bf16_t*)(ws + WS_DK);
    bf16_t* DV = (bf16_t*)(ws + WS_DV); bf16_t* GD = (bf16_t*)(ws + WS_GD); bf16_t* MG = (bf16_t*)(ws + WS_MG); bf16_t* QMLA = (bf16_t*)(ws + WS_QMLA);
    bf16_t* CKV = (bf16_t*)(ob + OUT_CKV); bf16_t* CQ = (bf16_t*)(ob + OUT_CQ); bf16_t* XA = (bf16_t*)(ob + OUT_XA); bf16_t* XD = (bf16_t*)(ob + OUT_XD);
    PG8_LAS unsigned char* ldsp = (PG8_LAS unsigned char*)lds;
    { volatile LAS unsigned* stz = (volatile LAS unsigned*)(lds + 160768); if (threadIdx.x < 16) stz[threadIdx.x] = 0u; }
    __syncthreads();
    const XcdBarrier xbar = xcd_barrier_post((unsigned*)(ws + WS_BAR), (volatile LAS unsigned*)(lds + 160768));

#ifndef REP1
#define REP1 1
#endif
#ifndef REP2
#define REP2 1
#endif
#ifndef REP3A
#define REP3A 0
#endif
#ifndef REP3D
#define REP3D 0
#endif
#ifndef REP4A
#define REP4A 1
#endif
#ifndef REP4B
#define REP4B 1
#endif
#ifndef PHMASK
#define PHMASK 0xfff
#endif
    if (PHMASK & (1 << 0)) {
        LANE_TID
        float* A = (float*)lds; float* red = (float*)(lds + 36864);
        for (int cb = bid; cb < 96; cb += G) {
            __syncthreads();
            for (int i = tid; i < 9 * 1024; i += 512) { const int r = i >> 10, k = i & 1023; const float v = r < 8 ? a.c[r * 1024 + k] : a.c_ctx[k]; A[i] = v * sigmoidf_(v); }
            __syncthreads();
            const int cl = tid & 31, col = cb * 32 + cl, kq = tid >> 5;
            float acc[9];
#pragma unroll
            for (int r = 0; r < 9; ++r) acc[r] = 0.f;
#pragma unroll 4
            for (int kk = 0; kk < 64; ++kk) { const int k = kq * 64 + kk; const float w = a.w_mod[(size_t)k * 3072 + col];
#pragma unroll
                for (int r = 0; r < 9; ++r) acc[r] += A[r * 1024 + k] * w; }
#pragma unroll
            for (int r = 0; r < 9; ++r) red[(kq * 9 + r) * 32 + cl] = acc[r];
            __syncthreads();
            if (tid < 288) { const int r = tid >> 5; float s = 0.f;
                for (int q = 0; q < 16; ++q) s += red[(q * 9 + r) * 32 + cl];
                MOD[r * 3072 + col] = s + a.b_mod[col]; }
        }
        __syncthreads();
        float* scr = (float*)lds + wave * (64 * 33);
        constexpr int I_IN = 16 * 168, I_UQ = 6 * 24, I_UKV = 4 * 32, I_OA = 8 * 32, I_OB = 8 * 32, I_OUT = 16 * 32;
        constexpr int NITEMS = I_IN + I_UQ + I_UKV + I_OA + I_OB + I_OUT;
        for (int it = gw; it < NITEMS; it += NGW) {
            int r = it;
            if (r < I_IN) { const int kb = r / 168, nb = r % 168, d0 = nb * 32;
                const int s0 = d0 < 256 ? 384 + d0 : d0 < 640 ? d0 - 256 : d0 < 672 ? d0 : d0 < 768 ? -1 : d0 - 96;
                tr_item(a.w_in, 1024, 5280, s0, nullptr, WIN, d0, kb * 64, scr, lane); continue; } r -= I_IN;
            if (r < I_UQ) { tr_item(a.w_uq, 384, 768, (r % 24) * 32, a.q_norm, WUQ, (r % 24) * 32, (r / 24) * 64, scr, lane); continue; } r -= I_UQ;
            if (r < I_UKV) { tr_item(a.w_ukv, 256, 1024, (r % 32) * 32, a.kv_norm, WUKV, (r % 32) * 32, (r / 32) * 64, scr, lane); continue; } r -= I_UKV;
            if (r < I_OA) { tr_item(a.w_oa, 512, 1024, (r % 32) * 32, nullptr, WOA, (r % 32) * 32, (r / 32) * 64, scr, lane); continue; } r -= I_OA;
            if (r < I_OB) { tr_item(a.w_ob, 512, 1024, (r % 32) * 32, nullptr, WOB, (r % 32) * 32, (r / 32) * 64, scr, lane); continue; } r -= I_OB;
            tr_item(a.w_out, 1024, 1024, (r % 32) * 32, nullptr, WOUT, (r % 32) * 32, (r / 32) * 64, scr, lane);
        }
        if (bid == G - 1) {
            for (int i = tid; i < 128 * 16; i += 512) { const int pos = i >> 4, f = i & 15; const float inv = powf(10000.f, -(float)f / 16.f), ang = (float)pos * inv; CS16[i] = make_float2(cosf(ang), sinf(ang)); }
            for (int i = tid; i < 128 * 8; i += 512) { const int pos = i >> 3, f = i & 7; const float inv = powf(10000.f, -(float)f / 8.f), ang = (float)pos * inv; CS8[i] = make_float2(cosf(ang), sinf(ang)); }
        }
    }
    grid.sync();

    if (PHMASK & (1 << 1)) for (int m = gw; m < MALL; m += NGW) {
        LANE_TID
        const float* src; const float* mod;
        if (m < MLAT) { src = a.x + (size_t)m * 1024; mod = MOD + (size_t)(m >> 13) * 3072; } else { src = a.ctx + (size_t)(m - MLAT) * 1024; mod = MOD + 8 * 3072; }
#pragma unroll
        for (int j = 0; j < 4; ++j) { const int c4 = lane + 64 * j;
            const f32x4 v = ((const f32x4*)src)[c4], sh = ((const f32x4*)mod)[c4], sc = ((const f32x4*)(mod + 1024))[c4];
            const f32x4 h = v * (sc + 1.f) + sh; u32x2 w; w.x = cvtpk(h[0], h[1]); w.y = cvtpk(h[2], h[3]);
            *(u32x2*)(HBF + (size_t)m * 1024 + c4 * 4) = w; }
    }
    xcd_barrier(xbar);

    if (PHMASK & (1 << 2)) for (int rep = 0; rep < REP1; ++rep) {
        pg8::Gemm g{HBF, WIN, MALL, NINP, 1024}; pg8::StaticOrder S; S.init(MALL, NINP, G, bid);
        EpiP1 E{CKV, CQ, KMLA, GA, DQ, DK, DV, GD, MG, SSKV, SSQ, CS16, CS8, rep == 0};
        pg8::gemm_phase<EpiP1, pg8::StaticOrder, true, true>(ldsp, g, S, E, wave);
    }
    xcd_barrier(xbar);

    for (int rep = 0; rep < REP2; ++rep) {
    if (PHMASK & (1 << 3)) {
        pg8::Gemm g{CQ, WUQ, MLAT, 768, 384}; pg8::StaticOrder S; S.init(MLAT, 768, G, bid);
        EpiQ E{QMLA, SSQ, CS8};
        pg8::gemm_phase<EpiQ, pg8::StaticOrder, true, true>(ldsp, g, S, E, wave);
    }
    if (PHMASK & (1 << 4)) {
        pg8::Gemm g{CKV, WUKV, MALL, 1024, 256}; pg8::StaticOrder S; S.init(MALL, 1024, G, bid);
        EpiKV E{KMLA, VMLA, SSKV};
        pg8::gemm_phase<EpiKV, pg8::StaticOrder, true, true>(ldsp, g, S, E, wave);
    }
    }
    xcd_barrier(xbar);

    if (PHMASK & (3 << 5)) {
        float lam;
        { LANE_TID
        { const float s1 = wave_sum(a.dlam[lane] * a.dlam[64 + lane]), s2 = wave_sum(a.dlam[128 + lane] * a.dlam[192 + lane]); lam = __builtin_bit_cast(float, __builtin_amdgcn_readfirstlane(__builtin_bit_cast(int, __expf(s1) - __expf(s2) + 0.2f))); } }
        int grp;
        { LANE_TID
          int* tab = (int*)(lds + 95232); const int simd = (__builtin_amdgcn_s_getreg((1 << 11) | (4 << 6) | 4)) & 3;
          __syncthreads(); if (lane == 0) tab[wave] = simd; __syncthreads();
          int cnt = 0;
#pragma unroll
          for (int w = 0; w < 8; ++w) cnt += (w < wave && tab[w] == simd) ? 1 : 0;
          grp = __builtin_amdgcn_readfirstlane(cnt > 0 ? 1 : 0); asm volatile("" : "+s"(grp)); __syncthreads(); }
        const int nrounds = (NB * 12 * 32 + G - 1) / G;
        for (int rdx = 0; rdx < nrounds + REP3A * 8 + REP3D * 4; ++rdx) {
            const int rd = rdx < nrounds ? rdx : (rdx - nrounds < REP3A * 8 ? (rdx - nrounds) & 7 : 8 + ((rdx - nrounds - REP3A * 8) & 3));
            int b, hs, qb;
            { const int idx = rd * G + bid; if (idx >= NB * 12 * 32) break; b = idx & 7; qb = (idx >> 3) & 31; hs = idx >> 8; }
            const size_t qrow0 = (size_t)b * SEQ + qb * 256, krow0 = (size_t)b * SKV;
            __syncthreads();
            if (hs < 8) { if (PHMASK & (1 << 5)) {
                f32x16 o[2];
                att::attn_core<true>(QMLA + qrow0 * 768 + hs * 96, KMLA + krow0 * 768 + hs * 96, VMLA + krow0 * 512 + hs * 64, SKV, (char*)lds, o, wave, grp);
                LANE_TID
                const int r32 = lane & 31, hi = lane >> 5;
                char* T = (char*)lds + 95232 + wave * 8192; char* tw = T + hi * 512 + r32 * 2;
#pragma unroll
                for (int r = 0; r < 16; ++r)
#pragma unroll
                    for (int d0 = 0; d0 < 2; ++d0) *(bf16_t*)(tw + ((r & 3) + 8 * (r >> 2)) * 128 + d0 * 64) = (bf16_t)cvtpk(o[d0][r], o[d0][r]);
#pragma unroll
                for (int j = 0; j < 4; ++j) { const int id = j * 64 + lane, row = id >> 3, c8 = id & 7;
                    const u32x4 t = *(const u32x4*)(T + id * 16);
                    const size_t go = (qrow0 + wave * 32 + row) * 512 + hs * 64 + c8 * 8; const u32x4 g = *(const u32x4*)(GA + go);
                    u32x4 w; w.x = cvtpk(bflo(t.x) * bflo(g.x), bfhi(t.x) * bfhi(g.x)); w.y = cvtpk(bflo(t.y) * bflo(g.y), bfhi(t.y) * bfhi(g.y));
                    w.z = cvtpk(bflo(t.z) * bflo(g.z), bfhi(t.z) * bfhi(g.z)); w.w = cvtpk(bflo(t.w) * bflo(g.w), bfhi(t.w) * bfhi(g.w));
                    *(u32x4*)(XA + go) = w; }
            } } else if (PHMASK & (1 << 6)) {
                const int h = hs - 8;
                f32x16 o[4];
                att::attn_core<false>(DQ + qrow0 * 512 + h * 128, DK + krow0 * 512 + h * 128, DV + krow0 * 512 + h * 128, SKV, (char*)lds, o, wave, grp);
                { unsigned* stash = (unsigned*)(lds + 95232 + wave * 8192) + lane_id_v();
#pragma unroll
                for (int d0 = 0; d0 < 4; ++d0)
#pragma unroll
                    for (int r = 0; r < 16; r += 2) stash[(d0 * 8 + (r >> 1)) * 64] = cvtpk(o[d0][r], o[d0][r + 1]); }
                att::attn_core<false>(DQ + qrow0 * 512 + h * 128 + 64, DK + krow0 * 512 + h * 128 + 64, DV + krow0 * 512 + h * 128, SKV, (char*)lds, o, wave, grp);
                LANE_TID
                const int r32 = lane & 31, hi = lane >> 5;
                unsigned* stash = (unsigned*)(lds + 95232 + wave * 8192) + lane;
#pragma unroll
                for (int d0 = 0; d0 < 4; ++d0)
#pragma unroll
                    for (int r = 0; r < 16; r += 2) { const unsigned w = stash[(d0 * 8 + (r >> 1)) * 64];
                        o[d0][r] = bflo(w) - lam * o[d0][r]; o[d0][r + 1] = bfhi(w) - lam * o[d0][r + 1]; }
                asm volatile("s_waitcnt lgkmcnt(0)" ::: "memory"); SBAR();
                char* T = (char*)lds + 95232 + wave * 8192; char* tw = T + hi * 1024 + r32 * 2;
#pragma unroll
                for (int r = 0; r < 16; ++r)
#pragma unroll
                    for (int d0 = 0; d0 < 4; ++d0) *(bf16_t*)(tw + ((r & 3) + 8 * (r >> 2)) * 256 + d0 * 64) = (bf16_t)cvtpk(o[d0][r], o[d0][r]);
                const int c16 = lane & 15;
                const f32x4 sw0 = *(const f32x4*)(a.subln + c16 * 8), sw1 = *(const f32x4*)(a.subln + c16 * 8 + 4);
#pragma unroll
                for (int j = 0; j < 8; ++j) { const int id = j * 64 + lane, row = id >> 4;
                    const u32x4 t = *(const u32x4*)(T + id * 16);
                    float e[8] = {bflo(t.x), bfhi(t.x), bflo(t.y), bfhi(t.y), bflo(t.z), bfhi(t.z), bflo(t.w), bfhi(t.w)};
                    float ss = 0.f;
#pragma unroll
                    for (int k = 0; k < 8; ++k) ss += e[k] * e[k];
                    ss += shflx(ss, 1); ss += shflx(ss, 2); ss += shflx(ss, 4); ss += shflx(ss, 8);
                    const float rs = 0.8f / sqrtf(ss * (1.f / 128.f) + 1e-5f);
                    const size_t go = (qrow0 + wave * 32 + row) * 512 + h * 128 + c16 * 8; const u32x4 g = *(const u32x4*)(GD + go);
                    u32x4 w; w.x = cvtpk(e[0] * rs * sw0[0] * bflo(g.x), e[1] * rs * sw0[1] * bfhi(g.x)); w.y = cvtpk(e[2] * rs * sw0[2] * bflo(g.y), e[3] * rs * sw0[3] * bfhi(g.y));
                    w.z = cvtpk(e[4] * rs * sw1[0] * bflo(g.z), e[5] * rs * sw1[1] * bfhi(g.z)); w.w = cvtpk(e[6] * rs * sw1[2] * bflo(g.w), e[7] * rs * sw1[3] * bfhi(g.w));
                    *(u32x4*)(XD + go) = w; }
            }
        }
    }
    xcd_barrier(xbar);

    for (int rep = 0; rep < REP4A; ++rep) {
    if (PHMASK & (1 << 7)) {
        pg8::Gemm g{XA, WOA, MLAT, 1024, 512}; pg8::StaticOrder S; S.init(MLAT, 1024, G, bid);
        EpiZ<false> E{Z, MG};
        pg8::gemm_phase<EpiZ<false>, pg8::StaticOrder, true, true>(ldsp, g, S, E, wave);
    }
    if (PHMASK & (1 << 8)) {
        pg8::Gemm g{XD, WOB, MLAT, 1024, 512}; pg8::StaticOrder S; S.init(MLAT, 1024, G, bid);
        EpiZ<true> E{Z, MG + 1024};
        pg8::gemm_phase<EpiZ<true>, pg8::StaticOrder, true, true>(ldsp, g, S, E, wave);
    }
    }
    xcd_barrier(xbar);

    if (PHMASK & (1 << 9)) for (int rep = 0; rep < REP4B; ++rep) {
        pg8::Gemm g{Z, WOUT, MLAT, 1024, 1024}; pg8::StaticOrder S; S.init(MLAT, 1024, G, bid);
        EpiOut E{a.out, a.x, MOD};
        pg8::gemm_phase<EpiOut, pg8::StaticOrder, true, true>(ldsp, g, S, E, wave);
    }
    xcd_barrier(xbar);

    if (PHMASK & (1 << 10)) for (int m = gw; m < MLAT; m += NGW) {
        LANE_TID
        f32x4* rowp = (f32x4*)(a.out + (size_t)m * 1024) + lane;
        f32x4 v[4]; float s = 0.f;
#pragma unroll
        for (int j = 0; j < 4; ++j) { v[j] = rowp[64 * j]; s += (v[j][0] + v[j][1]) + (v[j][2] + v[j][3]); }
        const float mean = wave_sum(s) * (1.f / 1024.f); float s2 = 0.f;
#pragma unroll
        for (int j = 0; j < 4; ++j) { v[j] = v[j] - mean; s2 += (v[j][0] * v[j][0] + v[j][1] * v[j][1]) + (v[j][2] * v[j][2] + v[j][3] * v[j][3]); }
        const float rstd = 1.f / sqrtf(wave_sum(s2) * (1.f / 1024.f) + 1e-5f);
#pragma unroll
        for (int j = 0; j < 4; ++j) { const f32x4 g = ((const f32x4*)a.ln_g)[lane + 64 * j], bb = ((const f32x4*)a.ln_b)[lane + 64 * j]; rowp[64 * j] = v[j] * rstd * g + bb; }
    }
}

extern "C" void kernel_launch(void* const* d_in, const int* in_sizes, int n_in, void* d_out, int out_size, void* d_ws, size_t ws_size, hipStream_t stream) {
    static int grid = 0;
    if (grid == 0) {
        if (n_in != 18 || in_sizes[0] != MLAT * DM || out_size != MLAT * DM || ws_size < WS_END) {
            fprintf(stderr, "kernel_launch: shape/workspace mismatch: n_in %d in0 %d out %d ws %zu (need %zu)\n", n_in, n_in > 0 ? in_sizes[0] : -1, out_size, ws_size, (size_t)WS_END); grid = -1; return; }
        int dev = 0, cus = 0, per_cu = 0;
        hipGetDevice(&dev); hipDeviceGetAttribute(&cus, hipDeviceAttributeMultiprocessorCount, dev);
        if (hipFuncSetAttribute((const void*)fwd_mega, hipFuncAttributeMaxDynamicSharedMemorySize, LDS_BYTES) != hipSuccess) { fprintf(stderr, "kernel_launch: hipFuncSetAttribute failed\n"); grid = -1; return; }
        if (hipOccupancyMaxActiveBlocksPerMultiprocessor(&per_cu, (const void*)fwd_mega, 512, LDS_BYTES) != hipSuccess || per_cu < 1) { fprintf(stderr, "kernel_launch: occupancy query gave %d\n", per_cu); per_cu = 1; }
        (void)hipGetLastError();
        grid = cus * 1;
    }
    if (grid < 0) return;
    hipMemsetAsync((char*)d_ws + WS_BAR, 0, CTL_ZERO_BYTES, stream);
    Args a{};
    a.x = (const float*)d_in[0]; a.c = (const float*)d_in[1]; a.ctx = (const float*)d_in[2]; a.c_ctx = (const float*)d_in[3]; a.w_mod = (const float*)d_in[4]; a.b_mod = (const float*)d_in[5];
    a.w_in = (const float*)d_in[6]; a.q_norm = (const float*)d_in[7]; a.kv_norm = (const float*)d_in[8]; a.w_uq = (const float*)d_in[9]; a.w_ukv = (const float*)d_in[10];
    a.dlam = (const float*)d_in[11]; a.subln = (const float*)d_in[12]; a.w_oa = (const float*)d_in[13]; a.w_ob = (const float*)d_in[14]; a.w_out = (const float*)d_in[15];
    a.ln_g = (const float*)d_in[16]; a.ln_b = (const float*)d_in[17]; a.out = (float*)d_out; a.ws = (unsigned char*)d_ws;
    void* args[] = {&a};
    hipError_t e = hipLaunchCooperativeKernel((const void*)fwd_mega, dim3(grid), dim3(512), args, LDS_BYTES, stream);
    if (e != hipSuccess) fprintf(stderr, "kernel_launch: cooperative launch failed: %s (grid %d)\n", hipGetErrorString(e), grid);
}
```

```cpp
#include <hip/hip_runtime.h>
#include <hip/hip_cooperative_groups.h>
#include <cstdio>
#include <cstdint>
namespace cg = cooperative_groups;
__device__ __forceinline__ int opq(int v) { asm volatile("" : "+v"(v)); return v; }
__device__ __forceinline__ int lane_id_v() { int l; asm volatile("v_mbcnt_lo_u32_b32 %0, -1, 0\n\tv_mbcnt_hi_u32_b32 %0, -1, %0" : "=v"(l)); return l; }
__device__ __forceinline__ float shflx(float v, int mask) { return __builtin_bit_cast(float, __builtin_amdgcn_ds_bpermute((lane_id_v() ^ mask) << 2, __builtin_bit_cast(int, v))); }
__device__ __forceinline__ float shfli(float v, int idx4) { return __builtin_bit_cast(float, __builtin_amdgcn_ds_bpermute(idx4, __builtin_bit_cast(int, v))); }
namespace pg8 {
#define PG8_LAS __attribute__((address_space(3)))
typedef unsigned short bf16_t;
typedef short bf16x8 __attribute__((ext_vector_type(8)));
typedef float f32x4 __attribute__((ext_vector_type(4)));
typedef unsigned u32x4 __attribute__((ext_vector_type(4)));
constexpr int BM = 256, BK = 64, HALF = 128, HTB = HALF * BK * 2  , STAGE_BYTES = 8 * HTB, NXCD = 8, WGM = 8;

__host__ __device__ __forceinline__ int lds_byte(int r, int c) { const int st = (r >> 4) * 2 + (c >> 5), rr = r & 15, cc = c & 31, ob = rr * 64 + cc * 2; return st * 1024 + (ob ^ (((ob >> 9) & 1) << 5)); }
__host__ __device__ __forceinline__ void stage_rc(int b, int& R, int& C) { const int st = b / 1024, sb = b % 1024, swz = sb ^ (((sb >> 9) & 1) << 5); R = (st >> 1) * 16 + swz / 64; C = (st & 1) * 32 + (swz % 64) / 2; }
__host__ __device__ __forceinline__ int perm32(int rho) { const int n = rho >> 4, i = rho & 15; return 8 * (i >> 2) + 4 * n + (i & 3); }

struct Unit { int pm, pn; };
struct Gemm { const bf16_t* A; const bf16_t* Bt; int M, N, K; };

struct StaticOrder {
    int nM, nN, nwg, G, c;
    __host__ __device__ void init(int M, int N, int G_, int c_) { nM = M / BM; nN = N / BM; nwg = nM * nN; G = G_; c = c_; }
    __host__ __device__ bool next(int i, Unit& u) const {
        const long L = (long)i * G + c; if (L >= nwg) return false;
        int wgid = (int)L; { const int q = nwg / NXCD, r = nwg % NXCD, xcd = wgid % NXCD, off = wgid / NXCD; wgid = (xcd < r ? xcd * (q + 1) : r * (q + 1) + (xcd - r) * q) + off; }
        const int nig = WGM * nN, gid = wgid / nig, fm = gid * WGM, gsz = (nM - fm) < WGM ? (nM - fm) : WGM;
        u.pm = fm + ((wgid % nig) % gsz); u.pn = (wgid % nig) / gsz; return true;
    }
    __device__ __forceinline__ void a_ready(const Unit&) const {}
    __device__ __forceinline__ void done(const Unit&) const {}
};

template <class Epi, class Sched, bool ALIGN_EPI = false, bool SP2 = false>
__device__ __forceinline__ void gemm_phase(PG8_LAS unsigned char* lds, const Gemm g, const Sched& S, const Epi& E, const int wid  ) {
    const int lane = lane_id_v(), tid = wid * 64 + lane, wr = wid >> 2, wc = wid & 3, fr = lane & 15, fq = lane >> 4;
    const int K = g.K, nt = K / BK;
    unsigned voffA[2], voffB[2];
#pragma unroll
    for (int i = 0; i < 2; ++i) { int R, C; stage_rc(tid * 16 + i * 8192, R, C); const int Rb = Epi::PERM ? ((R & ~31) + perm32(R & 31)) : R;
        voffA[i] = (unsigned)(R * K + C) * 2u; voffB[i] = (unsigned)(Rb * K + C) * 2u; }
    const size_t kstep = (size_t)(BK * 2);
    const size_t hstep = (size_t)HALF * K * 2;
    const size_t tstep = 2 * hstep;
    const unsigned ldsw = (unsigned)wid * 1024u;
    const int aoff = lds_byte(wr * 64 + fr, fq * 8), boff = lds_byte(wc * 32 + fr, fq * 8);
#define PG8_SA(b, h) (((b) * 2 + (h)) * HTB)
#define PG8_SB(b, h) ((4 + (b) * 2 + (h)) * HTB)
#define PG8_STAGE(bufoff, gbase, voff) do { _Pragma("unroll") for (int _i = 0; _i < 2; ++_i) \
        __builtin_amdgcn_global_load_lds((const unsigned*)((const char*)(gbase) + (voff)[_i]), (PG8_LAS unsigned*)(lds + (bufoff) + ldsw + _i * 8192), 16, 0, 0); } while (0)
#define PG8_LDA(dst, b, h) do { _Pragma("unroll") for (int m = 0; m < 4; ++m) _Pragma("unroll") for (int k = 0; k < 2; ++k) dst[m][k] = *(const PG8_LAS bf16x8*)(lds + PG8_SA(b, h) + aoff + m * 2048 + k * 1024); } while (0)
#define PG8_LDB(dst, b, h) do { _Pragma("unroll") for (int n = 0; n < 2; ++n) _Pragma("unroll") for (int k = 0; k < 2; ++k) dst[n][k] = *(const PG8_LAS bf16x8*)(lds + PG8_SB(b, h) + boff + n * 2048 + k * 1024); } while (0)
#define PG8_MMA(ai, bj, At, Bt) do { __builtin_amdgcn_s_setprio(1); _Pragma("unroll") for (int m = 0; m < 4; ++m) _Pragma("unroll") for (int n = 0; n < 2; ++n) _Pragma("unroll") for (int k = 0; k < 2; ++k) \
        acc[ai][bj][m][n] = __builtin_amdgcn_mfma_f32_16x16x32_bf16(Bt[n][k], At[m][k], acc[ai][bj][m][n], 0, 0, 0); __builtin_amdgcn_s_setprio(0); } while (0)
#define PG8_WAIT_V(n) asm volatile("s_waitcnt vmcnt(" #n ")" ::: "memory")
#define PG8_WAIT_L(n) asm volatile("s_waitcnt lgkmcnt(" #n ")" ::: "memory")
#define PG8_BAR __builtin_amdgcn_s_barrier()
#define PG8_SCHED __builtin_amdgcn_sched_barrier(0)
    Unit cur, nxt; int ui = 0;
    if (!S.next(0, cur)) return;
    f32x4 acc[2][2][4][2];
#pragma unroll
    for (int a = 0; a < 2; ++a)
#pragma unroll
        for (int b = 0; b < 2; ++b)
#pragma unroll
            for (int m = 0; m < 4; ++m)
#pragma unroll
                for (int n = 0; n < 2; ++n) acc[a][b][m][n] = (f32x4){0.f, 0.f, 0.f, 0.f};
    bf16x8 At[4][2], B0[2][2], B1[2][2];
    const char* cA = (const char*)g.A + (size_t)cur.pm * tstep; const char* cB = (const char*)g.Bt + (size_t)cur.pn * tstep;
    S.a_ready(cur);
    if constexpr (SP2) {
        PG8_STAGE(PG8_SB(0, 0), cB, voffB); PG8_STAGE(PG8_SB(0, 1), cB + hstep, voffB); PG8_STAGE(PG8_SA(0, 0), cA, voffA); PG8_STAGE(PG8_SA(0, 1), cA + hstep, voffA);
        if (wr == 1) PG8_BAR;
        PG8_WAIT_V(2); PG8_BAR;
        PG8_STAGE(PG8_SB(1, 0), cB + kstep, voffB); PG8_STAGE(PG8_SA(1, 0), cA + kstep, voffA); PG8_STAGE(PG8_SB(1, 1), cB + hstep + kstep, voffB);
        PG8_WAIT_V(6); PG8_BAR;
    } else {
        PG8_STAGE(PG8_SB(0, 0), cB, voffB); PG8_STAGE(PG8_SA(0, 0), cA, voffA); PG8_STAGE(PG8_SB(0, 1), cB + hstep, voffB); PG8_STAGE(PG8_SA(0, 1), cA + hstep, voffA);
        if (wr == 1) PG8_BAR;
        PG8_WAIT_V(4); PG8_BAR;
        PG8_STAGE(PG8_SB(1, 0), cB + kstep, voffB); PG8_STAGE(PG8_SA(1, 0), cA + kstep, voffA); PG8_STAGE(PG8_SB(1, 1), cB + hstep + kstep, voffB);
        PG8_WAIT_V(6); PG8_BAR;
    }
    for (;;) {
        const bool has_next = S.next(ui + 1, nxt);
        const char* nA = has_next ? (const char*)g.A + (size_t)nxt.pm * tstep : cA; const char* nB = has_next ? (const char*)g.Bt + (size_t)nxt.pn * tstep : cB;
        for (int t = 0; t < nt; t += 2) {
            const bool last = (t == nt - 2);
            const char* a1 = cA + (size_t)(t + 1) * kstep;
            const char* a2 = last ? nA : cA + (size_t)(t + 2) * kstep; const char* b2 = last ? nB : cB + (size_t)(t + 2) * kstep;
            const char* a3 = a2 + kstep; const char* b3 = b2 + kstep;
            if (last && has_next) S.a_ready(nxt);
            if constexpr (SP2) {
            PG8_LDB(B0, 0, 0); PG8_LDB(B1, 0, 1); PG8_SCHED; PG8_LDA(At, 0, 0); PG8_STAGE(PG8_SA(1, 1), a1 + hstep, voffA);
            PG8_WAIT_V(8); PG8_WAIT_L(0); PG8_BAR; PG8_MMA(0, 0, At, B0); PG8_MMA(0, 1, At, B1); PG8_BAR; PG8_SCHED;
            PG8_LDA(At, 0, 1); PG8_STAGE(PG8_SB(0, 0), b2, voffB); PG8_STAGE(PG8_SB(0, 1), b2 + hstep, voffB); PG8_STAGE(PG8_SA(0, 0), a2, voffA);
            PG8_WAIT_V(8); PG8_WAIT_L(0); PG8_BAR; PG8_MMA(1, 0, At, B0); PG8_MMA(1, 1, At, B1); PG8_BAR; PG8_SCHED;
            PG8_LDB(B0, 1, 0); PG8_LDB(B1, 1, 1); PG8_SCHED; PG8_LDA(At, 1, 0); PG8_STAGE(PG8_SA(0, 1), a2 + hstep, voffA);
            PG8_WAIT_V(8); PG8_WAIT_L(0); PG8_BAR; PG8_MMA(0, 0, At, B0); PG8_MMA(0, 1, At, B1); PG8_BAR; PG8_SCHED;
            PG8_LDA(At, 1, 1); PG8_STAGE(PG8_SB(1, 0), b3, voffB); PG8_STAGE(PG8_SB(1, 1), b3 + hstep, voffB); PG8_STAGE(PG8_SA(1, 0), a3, voffA);
            PG8_WAIT_V(8); PG8_WAIT_L(0); PG8_BAR; PG8_MMA(1, 0, At, B0); PG8_MMA(1, 1, At, B1); PG8_BAR; PG8_SCHED;
            } else {
            PG8_LDB(B0, 0, 0); PG8_SCHED; PG8_LDA(At, 0, 0); PG8_STAGE(PG8_SA(1, 1), a1 + hstep, voffA);
            PG8_WAIT_L(8); PG8_BAR; PG8_WAIT_L(0); PG8_MMA(0, 0, At, B0); PG8_BAR; PG8_SCHED;
            PG8_LDB(B1, 0, 1); PG8_STAGE(PG8_SB(0, 0), b2, voffB);
            PG8_BAR; PG8_WAIT_L(0); PG8_MMA(0, 1, At, B1); PG8_BAR;
            PG8_LDA(At, 0, 1); PG8_STAGE(PG8_SA(0, 0), a2, voffA);
            PG8_BAR; PG8_WAIT_L(0); PG8_MMA(1, 0, At, B0); PG8_BAR; PG8_SCHED;
            PG8_STAGE(PG8_SB(0, 1), b2 + hstep, voffB);
            PG8_WAIT_V(6); PG8_BAR; PG8_MMA(1, 1, At, B1); PG8_BAR;
            PG8_LDB(B0, 1, 0); PG8_SCHED; PG8_LDA(At, 1, 0); PG8_STAGE(PG8_SA(0, 1), a2 + hstep, voffA);
            PG8_WAIT_L(8); PG8_BAR; PG8_WAIT_L(0); PG8_MMA(0, 0, At, B0); PG8_BAR; PG8_SCHED;
            PG8_LDB(B1, 1, 1); PG8_STAGE(PG8_SB(1, 0), b3, voffB);
            PG8_BAR; PG8_WAIT_L(0); PG8_MMA(0, 1, At, B1); PG8_BAR;
            PG8_LDA(At, 1, 1); PG8_STAGE(PG8_SA(1, 0), a3, voffA);
            PG8_BAR; PG8_WAIT_L(0); PG8_MMA(1, 0, At, B0); PG8_BAR; PG8_SCHED;
            PG8_STAGE(PG8_SB(1, 1), b3 + hstep, voffB);
            PG8_WAIT_V(6); PG8_BAR; PG8_MMA(1, 1, At, B1); PG8_BAR;
            }
        }
        if constexpr (ALIGN_EPI) { if (wr == 0) PG8_BAR; }
        if constexpr (!Epi::AFTER_DRAIN) { E(acc, cur, wr, wc, fr, fq); S.done(cur); }
        if (!has_next) break;
#pragma unroll
        for (int a = 0; a < 2; ++a)
#pragma unroll
            for (int b = 0; b < 2; ++b)
#pragma unroll
                for (int m = 0; m < 4; ++m)
#pragma unroll
                    for (int n = 0; n < 2; ++n) acc[a][b][m][n] = (f32x4){0.f, 0.f, 0.f, 0.f};
        cur = nxt; cA = nA; cB = nB; ++ui;
        if constexpr (ALIGN_EPI) { if (wr == 1) PG8_BAR; }
    }
    PG8_WAIT_V(0);
    if constexpr (!ALIGN_EPI) { if (wr == 0) PG8_BAR; }
    PG8_BAR;
    if constexpr (Epi::AFTER_DRAIN) { E.fused(acc, cur, wr, wc, fr, fq, lds, wid, lane); S.done(cur); }
#undef PG8_SA
#undef PG8_SB
#undef PG8_STAGE
#undef PG8_LDA
#undef PG8_LDB
#undef PG8_MMA
#undef PG8_WAIT_V
#undef PG8_WAIT_L
#undef PG8_BAR
#undef PG8_SCHED
}
}
constexpr int DM = 1024, NB = 8, SEQ = 8192, CTX = 256, SKV = SEQ + CTX;
constexpr int MLAT = NB * SEQ, MALL = MLAT + NB * CTX;
constexpr int NINP = 5376;
typedef unsigned short bf16_t;
typedef short bf16x8 __attribute__((ext_vector_type(8)));
typedef short s16x4 __attribute__((ext_vector_type(4)));
typedef float f32x16 __attribute__((ext_vector_type(16)));
typedef float f32x4 __attribute__((ext_vector_type(4)));
typedef unsigned u32x4 __attribute__((ext_vector_type(4)));
typedef unsigned u32x2 __attribute__((ext_vector_type(2)));
#define LAS __attribute__((address_space(3)))
#define SBAR() __builtin_amdgcn_sched_barrier(0)
typedef float f32x2_t __attribute__((ext_vector_type(2)));
typedef __bf16 bf16x2_t __attribute__((ext_vector_type(2)));
__device__ __forceinline__ unsigned cvtpk(float lo, float hi) { f32x2_t v = {lo, hi}; bf16x2_t b = __builtin_convertvector(v, bf16x2_t); return __builtin_bit_cast(unsigned, b); }
__device__ __forceinline__ unsigned cvtpk_a(float lo, float hi) { unsigned r; asm volatile("v_cvt_pk_bf16_f32 %0, %1, %2" : "=v"(r) : "v"(lo), "v"(hi)); return r; }
__device__ __forceinline__ unsigned f2bf(float f) { unsigned u = __builtin_bit_cast(unsigned, f); return (u + 0x7fffu + ((u >> 16) & 1u)) >> 16; }
__device__ __forceinline__ float bf2f(unsigned short b) { return __builtin_bit_cast(float, (unsigned)b << 16); }
__device__ __forceinline__ float bflo(unsigned w) { return __builtin_bit_cast(float, w << 16); }
__device__ __forceinline__ float bfhi(unsigned w) { return __builtin_bit_cast(float, w & 0xffff0000u); }
__device__ __forceinline__ float sigmoidf_(float v) { return 1.f / (1.f + __expf(-v)); }
__device__ __forceinline__ float sigmoid_fast(float v) { return __builtin_amdgcn_rcpf(1.f + __builtin_amdgcn_exp2f(-1.4426950408889634f * v)); }
__device__ __forceinline__ float wave_sum(float v) {
#pragma unroll
    for (int o = 1; o < 64; o <<= 1) v += shflx(v, o);
    return v;
}

namespace att {
#ifndef PROBE_NOLOAD
#define PROBE_NOLOAD 0
#endif
template <bool MLA> struct Cfg {
    static constexpr int DQK = MLA ? 96 : 64, DV = MLA ? 64 : 128, NQ = DQK / 16, NCB = DV / 32;
    static constexpr int KROWB = MLA ? 272 : 144;
    static constexpr int LDQ = MLA ? 768 : 512, LDK = MLA ? 768 : 512, LDV = 512;
    static constexpr int SHM_V = 64 * DV * 2, SHM_K = 64 * KROWB;
};
constexpr float THR = 8.f;
__device__ __forceinline__ int crow(int r, int hi) { return (r & 3) + 8 * (r >> 2) + 4 * hi; }
template <bool MLA> __device__ __forceinline__ int kswz(int row, int colB) { return row * Cfg<MLA>::KROWB + colB; }
__device__ __forceinline__ float max3f(float a, float b, float c) { return __builtin_fmaxf(__builtin_fmaxf(a, b), c); }
__device__ __forceinline__ void rowmax_adjust(f32x16& p0, f32x16& p1, float& m2, f32x16& negm, float& alpha, const bool first) {
    constexpr float THR2 = THR * 1.4426950408889634f;
    float pmax = max3f(p0[0], p0[1], p0[2]);
#pragma unroll
    for (int r = 3; r < 15; r += 2) pmax = max3f(pmax, p0[r], p0[r + 1]);
    pmax = max3f(pmax, p0[15], p1[0]);
#pragma unroll
    for (int r = 1; r < 15; r += 2) pmax = max3f(pmax, p1[r], p1[r + 1]);
    pmax = fmaxf(pmax, p1[15]);
    { auto rr = __builtin_amdgcn_permlane32_swap(__float_as_uint(pmax), __float_as_uint(pmax), false, false);
      pmax = fmaxf(__uint_as_float(rr[0]), __uint_as_float(rr[1])); }
    if (!first && __builtin_expect(__all(pmax <= THR2), 1)) { alpha = 1.f; }
    else {
        const float delta = first ? pmax : fmaxf(pmax, 0.f);
        alpha = first ? 1.f : __builtin_amdgcn_exp2f(-delta);
        m2 += delta;
#pragma unroll
        for (int r = 0; r < 16; ++r) { p0[r] -= delta; p1[r] -= delta; }
        const float nm = -m2;
#pragma unroll
        for (int r = 0; r < 16; ++r) asm volatile("v_mov_b32 %0, %1" : "+v"(negm[r]) : "v"(nm));
    }
}
__device__ __forceinline__ float exp_pack(f32x16& p0, f32x16& p1, bf16x8& pa0, bf16x8& pa1, bf16x8& pa2, bf16x8& pa3) {
#pragma unroll
    for (int r = 0; r < 16; ++r) p0[r] = __builtin_amdgcn_exp2f(p0[r]);
#pragma unroll
    for (int r = 0; r < 16; ++r) p1[r] = __builtin_amdgcn_exp2f(p1[r]);
    SBAR(); asm volatile("s_nop 1" ::: "memory"); SBAR();
#define PK4(P, BASE, OUT) do { u32x4 w = {cvtpk_a(P[BASE + 0], P[BASE + 1]), cvtpk_a(P[BASE + 2], P[BASE + 3]), cvtpk_a(P[BASE + 4], P[BASE + 5]), cvtpk_a(P[BASE + 6], P[BASE + 7])}; \
    OUT = *reinterpret_cast<bf16x8*>(&w); } while (0)
    PK4(p0, 0, pa0); PK4(p0, 8, pa1); PK4(p1, 0, pa2); PK4(p1, 8, pa3);
#undef PK4
    float ps0 = p0[0], ps1 = p1[0];
#pragma unroll
    for (int r = 1; r < 16; ++r) { ps0 += p0[r]; ps1 += p1[r]; }
    float ps = ps0 + ps1;
    { auto rr = __builtin_amdgcn_permlane32_swap(__float_as_uint(ps), __float_as_uint(ps), false, false);
      ps = __uint_as_float(rr[0]) + __uint_as_float(rr[1]); }
    return ps;
}
template <bool MLA> __device__ __forceinline__ void qkt(f32x16& p0, f32x16& p1, const char* Ks, const bf16x8* qr, const f32x16& negm, int r32, int hi) {
    constexpr int NQ = Cfg<MLA>::NQ;
    bf16x8 kf[2 * NQ];
#pragma unroll
    for (int d0 = 0; d0 < NQ; ++d0) { const int cb = (d0 * 16 + hi * 8) * 2;
        kf[2 * d0] = *reinterpret_cast<const bf16x8*>(Ks + kswz<MLA>(r32, cb));
        kf[2 * d0 + 1] = *reinterpret_cast<const bf16x8*>(Ks + kswz<MLA>(32 + r32, cb)); }
    SBAR();
    p0 = negm; p1 = negm;
#pragma unroll
    for (int d0 = 0; d0 < NQ; ++d0) {
        p0 = __builtin_amdgcn_mfma_f32_32x32x16_bf16(kf[2 * d0], qr[d0], p0, 0, 0, 0);
        p1 = __builtin_amdgcn_mfma_f32_32x32x16_bf16(kf[2 * d0 + 1], qr[d0], p1, 0, 0, 0); }
}
template <int NCB> __device__ __forceinline__ int v_st(int k, int c) { const int kk = k;     return ((kk >> 3) * NCB + (c >> 5)) * 512 + ((kk & 7) * 32 + (c & 31)) * 2; }
__device__ __forceinline__ int v_rd_base(int lane) { return ((lane & 3) << 3) | (((lane >> 2) & 3) << 6) | (((lane >> 4) & 1) << 5) | (((lane >> 5) & 1) << 8); }
template <int NCB> constexpr int v_rd_off(int d0, int ks, int half) { return d0 * 512 + (ks * 2 + half) * NCB * 512; }
template <int OFF> __device__ __forceinline__ s16x4 tr_read(int vb) {
    s16x4 r; asm volatile("ds_read_b64_tr_b16 %0, %1 offset:%2" : "=&v"(r) : "v"(vb), "i"(OFF) : "memory"); return r;
}
template <int NCB, int D0> __device__ __forceinline__ void pv_one(f32x16& od, int vb, bf16x8 pa0, bf16x8 pa1, bf16x8 pa2, bf16x8 pa3) {
    const s16x4 l0 = tr_read<v_rd_off<NCB>(D0, 0, 0)>(vb), h0 = tr_read<v_rd_off<NCB>(D0, 0, 1)>(vb), l1 = tr_read<v_rd_off<NCB>(D0, 1, 0)>(vb), h1 = tr_read<v_rd_off<NCB>(D0, 1, 1)>(vb);
    const s16x4 l2 = tr_read<v_rd_off<NCB>(D0, 2, 0)>(vb), h2 = tr_read<v_rd_off<NCB>(D0, 2, 1)>(vb), l3 = tr_read<v_rd_off<NCB>(D0, 3, 0)>(vb), h3 = tr_read<v_rd_off<NCB>(D0, 3, 1)>(vb);
    asm volatile("s_waitcnt lgkmcnt(0)" ::: "memory"); SBAR();
#define PK(L, H) (bf16x8){L[0], L[1], L[2], L[3], H[0], H[1], H[2], H[3]}
    od = __builtin_amdgcn_mfma_f32_32x32x16_bf16(pa0, PK(l0, h0), od, 0, 0, 0);
    od = __builtin_amdgcn_mfma_f32_32x32x16_bf16(pa1, PK(l1, h1), od, 0, 0, 0);
    od = __builtin_amdgcn_mfma_f32_32x32x16_bf16(pa2, PK(l2, h2), od, 0, 0, 0);
    od = __builtin_amdgcn_mfma_f32_32x32x16_bf16(pa3, PK(l3, h3), od, 0, 0, 0);
#undef PK
}
template <int NCB> __device__ __forceinline__ void pv_all(f32x16* o, int vb, bf16x8 pa0, bf16x8 pa1, bf16x8 pa2, bf16x8 pa3) {
    pv_one<NCB, 0>(o[0], vb, pa0, pa1, pa2, pa3); pv_one<NCB, 1>(o[1], vb, pa0, pa1, pa2, pa3);
    if constexpr (NCB == 4) { pv_one<NCB, 2>(o[2], vb, pa0, pa1, pa2, pa3); pv_one<NCB, 3>(o[3], vb, pa0, pa1, pa2, pa3); }
}

template <int NCB, int D0> __device__ __forceinline__ void v_frag_read(s16x4 (&f)[8], int vb) {
    f[0] = tr_read<v_rd_off<NCB>(D0, 0, 0)>(vb); f[1] = tr_read<v_rd_off<NCB>(D0, 0, 1)>(vb); f[2] = tr_read<v_rd_off<NCB>(D0, 1, 0)>(vb); f[3] = tr_read<v_rd_off<NCB>(D0, 1, 1)>(vb);
    f[4] = tr_read<v_rd_off<NCB>(D0, 2, 0)>(vb); f[5] = tr_read<v_rd_off<NCB>(D0, 2, 1)>(vb); f[6] = tr_read<v_rd_off<NCB>(D0, 3, 0)>(vb); f[7] = tr_read<v_rd_off<NCB>(D0, 3, 1)>(vb);
}
__device__ __forceinline__ void pv_mma(f32x16& od, const s16x4 (&f)[8], bf16x8 pa0, bf16x8 pa1, bf16x8 pa2, bf16x8 pa3) {
#define PK(L, H) (bf16x8){L[0], L[1], L[2], L[3], H[0], H[1], H[2], H[3]}
    od = __builtin_amdgcn_mfma_f32_32x32x16_bf16(pa0, PK(f[0], f[1]), od, 0, 0, 0);
    od = __builtin_amdgcn_mfma_f32_32x32x16_bf16(pa1, PK(f[2], f[3]), od, 0, 0, 0);
    od = __builtin_amdgcn_mfma_f32_32x32x16_bf16(pa2, PK(f[4], f[5]), od, 0, 0, 0);
    od = __builtin_amdgcn_mfma_f32_32x32x16_bf16(pa3, PK(f[6], f[7]), od, 0, 0, 0);
#undef PK
}
__device__ __forceinline__ void pv_mma2(f32x16& oa, f32x16& ob, const s16x4 (&f)[8], const s16x4 (&h)[8], bf16x8 pa0, bf16x8 pa1, bf16x8 pa2, bf16x8 pa3) {
#define PK(L, H) (bf16x8){L[0], L[1], L[2], L[3], H[0], H[1], H[2], H[3]}
    oa = __builtin_amdgcn_mfma_f32_32x32x16_bf16(pa0, PK(f[0], f[1]), oa, 0, 0, 0); ob = __builtin_amdgcn_mfma_f32_32x32x16_bf16(pa0, PK(h[0], h[1]), ob, 0, 0, 0);
    oa = __builtin_amdgcn_mfma_f32_32x32x16_bf16(pa1, PK(f[2], f[3]), oa, 0, 0, 0); ob = __builtin_amdgcn_mfma_f32_32x32x16_bf16(pa1, PK(h[2], h[3]), ob, 0, 0, 0);
    oa = __builtin_amdgcn_mfma_f32_32x32x16_bf16(pa2, PK(f[4], f[5]), oa, 0, 0, 0); ob = __builtin_amdgcn_mfma_f32_32x32x16_bf16(pa2, PK(h[4], h[5]), ob, 0, 0, 0);
    oa = __builtin_amdgcn_mfma_f32_32x32x16_bf16(pa3, PK(f[6], f[7]), oa, 0, 0, 0); ob = __builtin_amdgcn_mfma_f32_32x32x16_bf16(pa3, PK(h[6], h[7]), ob, 0, 0, 0);
#undef PK
}
#define LWAIT0() do { SBAR(); asm volatile("s_waitcnt lgkmcnt(0)" ::: "memory"); SBAR(); } while (0)
template <bool MLA>
__device__ __forceinline__ void attn_core(const bf16_t* __restrict__ Qb, const bf16_t* __restrict__ Kh, const bf16_t* __restrict__ Vh, int seq, char* lds,
                                          f32x16 (&o)[Cfg<MLA>::NCB], const int wid  , const int g  ) {
    using CF = Cfg<MLA>;
    constexpr int NQ = CF::NQ, NCB = CF::NCB, SHM_V = CF::SHM_V, SHM_K = CF::SHM_K, LDQ = CF::LDQ, LDK = CF::LDK, LDV = CF::LDV;
    const int lane = lane_id_v(), tid = wid * 64 + lane, r32 = lane & 31, hi = lane >> 5;
    char* V_lds = lds; char* K_lds = lds + 4 * SHM_V;
    float* wsp = (float*)(lds + 93184) + wid * 64; float* li_l = wsp; float* al_l = wsp + 32;
    float m2 = 0.f, l_reg = 0.f; f32x16 negm = f32x16{}; bf16x8 qr[NQ];
#pragma unroll
    for (int d = 0; d < NCB; ++d) o[d] = f32x16{};
    const bf16_t* Qw = Qb + (long)(wid * 32 + r32) * LDQ + hi * 8;
#pragma unroll
    for (int d0 = 0; d0 < NQ; ++d0) qr[d0] = *reinterpret_cast<const bf16x8*>(Qw + d0 * 16);
    const int vr0 = MLA ? (tid >> 3) : (tid >> 4), vc0 = MLA ? (tid & 7) * 8 : (tid & 15) * 8;
    const int vst0 = v_st<NCB>(vr0, vc0), vst1 = v_st<NCB>(32 + vr0, vc0);
    const int kcA = tid, krA = MLA ? (kcA / 12) : (tid >> 3), kcolA = MLA ? (kcA % 12) * 8 : (tid & 7) * 8;
    const int kcB = 512 + (tid & 255), krB = kcB / 12, kcolB = (kcB % 12) * 8;
    const int kstA = kswz<MLA>(krA, kcolA * 2), kstB = kswz<MLA>(krB, kcolB * 2);
    const int vb0 = (int)(uintptr_t)V_lds + v_rd_base(lane);
    struct { bf16x8 a, b, c; } sr_[2];
    const unsigned goA = MLA ? (unsigned)(vr0 * LDV + vc0) * 2u : (unsigned)(vr0 * LDV + vc0) * 2u;
    const unsigned goB = MLA ? (unsigned)(krA * LDK + kcolA) * 2u : (unsigned)((32 + vr0) * LDV + vc0) * 2u;
    const unsigned goC = MLA ? (unsigned)(krB * LDK + kcolB) * 2u : (unsigned)(krA * LDK + kcolA) * 2u;
#define SLOAD(i, k0) do { const char* kt_ = (const char*)(Kh + (size_t)(k0) * LDK); const char* vt_ = (const char*)(Vh + (size_t)(k0) * LDV); \
    if constexpr (MLA) { \
        sr_[i].a = *reinterpret_cast<const bf16x8*>(vt_ + goA); sr_[i].b = *reinterpret_cast<const bf16x8*>(kt_ + goB); sr_[i].c = *reinterpret_cast<const bf16x8*>(kt_ + goC); \
    } else { \
        sr_[i].a = *reinterpret_cast<const bf16x8*>(vt_ + goA); sr_[i].b = *reinterpret_cast<const bf16x8*>(vt_ + goB); sr_[i].c = *reinterpret_cast<const bf16x8*>(kt_ + goC); } } while (0)
#define SWRITE(ko, vo, i) do { if constexpr (MLA) { \
        *(bf16x8*)(V_lds + (vo) + vst0) = sr_[i].a; \
        *(bf16x8*)(K_lds + (ko) + kstA) = sr_[i].b; \
        if (wid < 4) *(bf16x8*)(K_lds + (ko) + kstB) = sr_[i].c; \
    } else { \
        *(bf16x8*)(V_lds + (vo) + vst0) = sr_[i].a; \
        *(bf16x8*)(V_lds + (vo) + vst1) = sr_[i].b; \
        *(bf16x8*)(K_lds + (ko) + kstA) = sr_[i].c; } } while (0)
#define SWAIT() asm volatile("s_waitcnt vmcnt(3)" ::: "memory")
#define RESC(a) do { if (__any((a) < 1.f)) { if (hi == 0) al_l[r32] = (a); asm volatile("s_waitcnt lgkmcnt(0)" ::: "memory"); \
    _Pragma("unroll") for (int r = 0; r < 16; ++r) { const float al_ = al_l[crow(r, hi)]; _Pragma("unroll") for (int d = 0; d < NCB; ++d) o[d][r] *= al_; } } } while (0)
    f32x16 S0, S1; float alpha = 1.f; bf16x8 pa0, pa1, pa2, pa3; const int NT = seq / 64;
    constexpr int SE = 0, SO = 1;
#define TOUCH(x) asm volatile("" : "+v"(x))
#define MSEG(j) do { const int j_ = (j); const bool doqk = j_ < NT, dopv = j_ > 0; \
        const char* Ks_ = K_lds + (j_ % 3) * SHM_K; const int vb_ = vb0 + ((j_ - 1) & 3) * SHM_V; \
        bf16x8 kf[2 * NQ]; s16x4 fa[8], fb[8]; \
        if (doqk) { _Pragma("unroll") for (int d0 = 0; d0 < NQ; ++d0) { const int cb = (d0 * 16 + hi * 8) * 2; \
            kf[2 * d0] = *reinterpret_cast<const bf16x8*>(Ks_ + kswz<MLA>(r32, cb)); kf[2 * d0 + 1] = *reinterpret_cast<const bf16x8*>(Ks_ + kswz<MLA>(32 + r32, cb)); } \
            SBAR(); S0 = negm; S1 = negm; \
            _Pragma("unroll") for (int d0 = 0; d0 < NQ / 2; ++d0) { \
                S0 = __builtin_amdgcn_mfma_f32_32x32x16_bf16(kf[2 * d0], qr[d0], S0, 0, 0, 0); S1 = __builtin_amdgcn_mfma_f32_32x32x16_bf16(kf[2 * d0 + 1], qr[d0], S1, 0, 0, 0); SBAR(); } \
            _Pragma("unroll") for (int i_ = NQ; i_ < 2 * NQ; ++i_) asm volatile("" : "+v"(kf[i_]) : "v"(S0), "v"(S1));     \
        } \
        SBAR(); \
        if (dopv) { v_frag_read<NCB, 0>(fa, vb_); if constexpr (NCB == 2) v_frag_read<NCB, 1>(fb, vb_); }     \
        if (doqk) { _Pragma("unroll") for (int i_ = NQ; i_ < 2 * NQ; ++i_) TOUCH(kf[i_]); }     \
        SBAR(); \
        if (doqk) { _Pragma("unroll") for (int d0 = NQ / 2; d0 < NQ; ++d0) { \
            S0 = __builtin_amdgcn_mfma_f32_32x32x16_bf16(kf[2 * d0], qr[d0], S0, 0, 0, 0); S1 = __builtin_amdgcn_mfma_f32_32x32x16_bf16(kf[2 * d0 + 1], qr[d0], S1, 0, 0, 0); SBAR(); } } \
        if (dopv) { if constexpr (NCB == 4) { SBAR(); v_frag_read<NCB, 1>(fb, vb_); }     \
            LWAIT0(); \
            if constexpr (NCB == 4) { pv_mma2(o[0], o[1], fa, fb, pa0, pa1, pa2, pa3); SBAR(); v_frag_read<NCB, 2>(fa, vb_); v_frag_read<NCB, 3>(fb, vb_); \
                LWAIT0(); pv_mma2(o[2], o[NCB - 1], fa, fb, pa0, pa1, pa2, pa3); } \
            else { pv_mma2(o[0], o[1], fa, fb, pa0, pa1, pa2, pa3); } } } while (0)
#define VSEG(j) do { rowmax_adjust(S0, S1, m2, negm, alpha, (j) == 0); RESC(alpha); l_reg = l_reg * alpha + exp_pack(S0, S1, pa0, pa1, pa2, pa3); } while (0)
    __syncthreads();
    SLOAD(SE, 0); SLOAD(SO, 64); asm volatile("s_waitcnt vmcnt(0)" ::: "memory");
    SWRITE(0, 0, SE); SWRITE(SHM_K, SHM_V, SO);
    SLOAD(SE, 2 * 64); SLOAD(SO, 3 * 64);
    __syncthreads();
    { int g_ = g; asm volatile("" : "+s"(g_)); if (g_ == 1) __syncthreads(); }
    for (int j = 0; j < NT; j += 2) {
        SBAR(); MSEG(j); SBAR();
        __syncthreads();
        SBAR(); VSEG(j);
        SWAIT(); if (j + 2 < NT) SWRITE(((j + 2) % 3) * SHM_K, ((j + 2) & 3) * SHM_V, SE);
        if (!(MLA && PROBE_NOLOAD)) { const int tn = (j + 4 < NT) ? j + 4 : NT - 1; SLOAD(SE, tn * 64); } SBAR();
        __syncthreads();
        SBAR(); MSEG(j + 1); SBAR();
        __syncthreads();
        SBAR(); VSEG(j + 1);
        SWAIT(); if (j + 3 < NT) SWRITE(((j + 3) % 3) * SHM_K, ((j + 3) & 3) * SHM_V, SO);
        if (!(MLA && PROBE_NOLOAD)) { const int tn = (j + 5 < NT) ? j + 5 : NT - 1; SLOAD(SO, tn * 64); } SBAR();
        __syncthreads();
    }
    SBAR(); MSEG(NT); SBAR();
    { int g_ = g; asm volatile("" : "+s"(g_)); if (g_ == 0) __syncthreads(); }
#undef MSEG
#undef TOUCH
#undef VSEG
    asm volatile("s_waitcnt vmcnt(0)" ::: "memory");
    if (hi == 0) li_l[r32] = l_reg; asm volatile("s_waitcnt lgkmcnt(0)" ::: "memory");
#pragma unroll
    for (int r = 0; r < 16; ++r) { const float rl = __builtin_amdgcn_rcpf(li_l[crow(r, hi)]);
#pragma unroll
        for (int d = 0; d < NCB; ++d) o[d][r] *= rl; }
#undef SLOAD
#undef SWRITE
#undef SWAIT
#undef RESC
}
}
typedef float2 cs_t;
__device__ __forceinline__ void store8(bf16_t* p, f32x4 v0, f32x4 v1) {
    u32x4 w; w.x = cvtpk(v0[0], v0[1]); w.y = cvtpk(v0[2], v0[3]); w.z = cvtpk(v1[0], v1[1]); w.w = cvtpk(v1[2], v1[3]);
    *(u32x4*)p = w;
}
__device__ __forceinline__ float dot8(f32x4 v0, f32x4 v1) { return (v0[0] * v0[0] + v0[1] * v0[1]) + (v0[2] * v0[2] + v0[3] * v0[3]) + (v1[0] * v1[0] + v1[1] * v1[1]) + (v1[2] * v1[2] + v1[3] * v1[3]); }
__device__ __forceinline__ void rope64(f32x4& v0, f32x4& v1, const cs_t* __restrict__ CS16, int gr, int gc, int wc, int fq, bool apply) {
    f32x4 p0, p1; const int ix = (lane_id_v() ^ 32) << 2;
#pragma unroll
    for (int j = 0; j < 4; ++j) { p0[j] = shfli(v0[j], ix); p1[j] = shfli(v1[j], ix); }
    if (apply) {
        const int pos = (wc & 1) ? gc : gr; const cs_t* t = CS16 + pos * 16 + 8 * (fq & 1);
        const float sg = (fq < 2) ? -1.f : 1.f;
#pragma unroll
        for (int j = 0; j < 4; ++j) { const cs_t a = t[j], b = t[4 + j];
            v0[j] = v0[j] * a.x + sg * p0[j] * a.y; v1[j] = v1[j] * b.x + sg * p1[j] * b.y; }
    }
}
__device__ __forceinline__ void rope32(f32x4& v0, f32x4& v1, const cs_t* __restrict__ CS8, int gr, int gc, int g, bool apply) {
    f32x4 p0, p1; const int ix = (lane_id_v() ^ 16) << 2;
#pragma unroll
    for (int j = 0; j < 4; ++j) { p0[j] = shfli(v0[j], ix); p1[j] = shfli(v1[j], ix); }
    if (apply) {
        const int pos = (g >= 2) ? gc : gr; const cs_t* t = CS8 + pos * 8;
        const float sg = (g & 1) ? 1.f : -1.f;
#pragma unroll
        for (int j = 0; j < 4; ++j) { const cs_t a = t[j], b = t[4 + j];
            v0[j] = v0[j] * a.x + sg * p0[j] * a.y; v1[j] = v1[j] * b.x + sg * p1[j] * b.y; }
    }
}
#define EPI_ARGS const pg8::f32x4 (&acc)[2][2][4][2], const pg8::Unit& u, int wr, int wc, int fr, int fq
#define EPI_RECOMPUTE { const int l_ = lane_id_v(); fr = l_ & 15; fq = l_ >> 4; }

struct EpiP1 {
    static constexpr bool PERM = true, AFTER_DRAIN = false;
    bf16_t *CKV, *CQ, *KMLA, *GA, *DQ, *DK, *DV, *GD, *MG; float *SSKV, *SSQ; const cs_t *CS16, *CS8; bool do_stats;
    __device__ __forceinline__ void operator()(EPI_ARGS) const {
        EPI_RECOMPUTE
        const int pm = u.pm, pn = u.pn; const bool lat = pm < 256;
        if (!lat && !(pn == 0 || pn == 2 || (pn >= 7 && pn <= 10))) return;
        const int row0 = pm * 256 + wr * 64 + fr;
        const int kv0 = (lat ? (pm >> 5) * SKV + CTX + (pm & 31) * 256 : (pm - 256) * SKV) + wr * 64 + fr;
        const int lcw = wc * 32 + 8 * fq;
#pragma unroll
        for (int ai = 0; ai < 2; ++ai)
#pragma unroll
            for (int m = 0; m < 4; ++m) {
                __builtin_amdgcn_sched_barrier(0); const int row = opq(row0 + ai * 128 + m * 16), kvrow = kv0 + (row - row0);
                const int s = row & (SEQ - 1), gr = s >> 6, gc = s & 63;
                float ssq = 0.f;
#pragma unroll
                for (int bj = 0; bj < 2; ++bj) {
                    f32x4 v0 = acc[ai][bj][m][0], v1 = acc[ai][bj][m][1]; const int lc = bj * 128 + lcw;
                    if (pn == 0) { ssq += dot8(v0, v1); store8(CKV + (size_t)kvrow * 256 + lc, v0, v1); }
                    else if (pn == 1) { ssq += dot8(v0, v1); store8(CQ + (size_t)row * 384 + lc, v0, v1); }
                    else if (pn == 2) {
                        if (bj == 0) { if (lat) { ssq += dot8(v0, v1); store8(CQ + (size_t)row * 384 + 256 + lc, v0, v1); } }
                        else if (wc == 0) { rope32(v0, v1, CS8, gr, gc, fq, lat);
#pragma unroll
                            for (int h = 0; h < 8; ++h) store8(KMLA + (size_t)kvrow * 768 + h * 96 + 64 + 8 * fq, v0, v1); }
                    }
                    else if (pn <= 4 || pn == 11 || pn == 12) {
#pragma unroll
                        for (int j = 0; j < 4; ++j) { v0[j] = v0[j] * sigmoid_fast(v0[j]); v1[j] = v1[j] * sigmoid_fast(v1[j]); }
                        bf16_t* dst = (pn <= 4) ? GA + (size_t)row * 512 + (pn - 3) * 256 + lc : GD + (size_t)row * 512 + (pn - 11) * 256 + lc;
                        store8(dst, v0, v1);
                    }
                    else if (pn <= 6) { v0 = v0 * 0.18033688011112042f; v1 = v1 * 0.18033688011112042f;
                        rope64(v0, v1, CS16, gr, gc, wc, fq, true); store8(DQ + (size_t)row * 512 + (pn - 5) * 256 + lc, v0, v1); }
                    else if (pn <= 8) { rope64(v0, v1, CS16, gr, gc, wc, fq, lat); store8(DK + (size_t)kvrow * 512 + (pn - 7) * 256 + lc, v0, v1); }
                    else if (pn <= 10) { store8(DV + (size_t)kvrow * 512 + (pn - 9) * 256 + lc, v0, v1); }
                    else {
#pragma unroll
                        for (int j = 0; j < 4; ++j) { v0[j] = sigmoid_fast(v0[j]); v1[j] = sigmoid_fast(v1[j]); }
                        store8(MG + (size_t)row * 2048 + (pn - 13) * 256 + lc, v0, v1);
                    }
                }
                if (pn <= 2) {
                    ssq += shflx(ssq, 16); ssq += shflx(ssq, 32);
                    if (fq == 0) { if (pn == 0) SSKV[(size_t)kvrow * 4 + wc] = ssq; else if (lat) SSQ[(size_t)row * 8 + (pn - 1) * 4 + wc] = ssq; }
                }
            }
    }
};
struct EpiQ {
    static constexpr bool PERM = true, AFTER_DRAIN = false;
    bf16_t* QMLA; const float* SSQ; const cs_t* CS8;
    __device__ __forceinline__ void operator()(EPI_ARGS) const {
        EPI_RECOMPUTE
        const int row0 = u.pm * 256 + wr * 64 + fr;
#pragma unroll
        for (int ai = 0; ai < 2; ++ai)
#pragma unroll
            for (int m = 0; m < 4; ++m) {
                __builtin_amdgcn_sched_barrier(0); const int row = opq(row0 + ai * 128 + m * 16); const int s = row & (SEQ - 1), gr = s >> 6, gc = s & 63;
                const f32x4 sa = *(const f32x4*)(SSQ + (size_t)row * 8), sb = *(const f32x4*)(SSQ + (size_t)row * 8 + 4);
                const float rs = 0.14724445f / sqrtf((((sa[0] + sa[1]) + (sa[2] + sa[3])) + ((sb[0] + sb[1]) + (sb[2] + sb[3]))) * (1.f / 384.f) + 1e-6f);
#pragma unroll
                for (int bj = 0; bj < 2; ++bj) {
                    f32x4 v0 = acc[ai][bj][m][0] * rs, v1 = acc[ai][bj][m][1] * rs;
                    const int c0 = u.pn * 256 + bj * 128 + wc * 32 + 8 * fq, d = c0 % 96;
                    rope32(v0, v1, CS8, gr, gc, (d - 64) >> 3, d >= 64);
                    store8(QMLA + (size_t)row * 768 + c0, v0, v1);
                }
            }
    }
};
struct EpiKV {
    static constexpr bool PERM = true, AFTER_DRAIN = false;
    bf16_t *KMLA, *VMLA; const float* SSKV;
    __device__ __forceinline__ void operator()(EPI_ARGS) const {
        EPI_RECOMPUTE
        const int row0 = u.pm * 256 + wr * 64 + fr;
#pragma unroll
        for (int ai = 0; ai < 2; ++ai)
#pragma unroll
            for (int m = 0; m < 4; ++m) {
                __builtin_amdgcn_sched_barrier(0); const int row = opq(row0 + ai * 128 + m * 16);
                const f32x4 sa = *(const f32x4*)(SSKV + (size_t)row * 4);
                const float rs = 1.f / sqrtf(((sa[0] + sa[1]) + (sa[2] + sa[3])) * (1.f / 256.f) + 1e-6f);
#pragma unroll
                for (int bj = 0; bj < 2; ++bj) {
                    const f32x4 v0 = acc[ai][bj][m][0] * rs, v1 = acc[ai][bj][m][1] * rs;
                    const int h = u.pn * 2 + bj, d = wc * 32 + 8 * fq;
                    if (wc < 2) store8(KMLA + (size_t)row * 768 + h * 96 + d, v0, v1);
                    else store8(VMLA + (size_t)row * 512 + h * 64 + (d - 64), v0, v1);
                }
            }
    }
};
template <bool ACCUM> struct EpiZ {
    static constexpr bool PERM = true, AFTER_DRAIN = false;
    bf16_t* Z; const bf16_t* MG;
    __device__ __forceinline__ void operator()(EPI_ARGS) const {
        EPI_RECOMPUTE
        const int row0 = u.pm * 256 + wr * 64 + fr;
#pragma unroll
        for (int ai = 0; ai < 2; ++ai)
#pragma unroll
            for (int m = 0; m < 4; ++m) {
                __builtin_amdgcn_sched_barrier(0); const int row = opq(row0 + ai * 128 + m * 16);
#pragma unroll
                for (int bj = 0; bj < 2; ++bj) {
                    f32x4 v0 = acc[ai][bj][m][0], v1 = acc[ai][bj][m][1];
                    const int c0 = u.pn * 256 + bj * 128 + wc * 32 + 8 * fq;
                    const u32x4 g = *(const u32x4*)(MG + (size_t)row * 2048 + c0);
                    v0[0] *= bflo(g.x); v0[1] *= bfhi(g.x); v0[2] *= bflo(g.y); v0[3] *= bfhi(g.y);
                    v1[0] *= bflo(g.z); v1[1] *= bfhi(g.z); v1[2] *= bflo(g.w); v1[3] *= bfhi(g.w);
                    bf16_t* zp = Z + (size_t)row * 1024 + c0;
                    if (ACCUM) { const u32x4 z = *(const u32x4*)zp;
                        v0[0] += bflo(z.x); v0[1] += bfhi(z.x); v0[2] += bflo(z.y); v0[3] += bfhi(z.y);
                        v1[0] += bflo(z.z); v1[1] += bfhi(z.z); v1[2] += bflo(z.w); v1[3] += bfhi(z.w); }
                    store8(zp, v0, v1);
                }
            }
    }
};
struct EpiOut {
    static constexpr bool PERM = true, AFTER_DRAIN = false;
    float* OUT; const float* X; const float* MOD;
    __device__ __forceinline__ void operator()(EPI_ARGS) const {
        EPI_RECOMPUTE
        const int row0 = u.pm * 256 + wr * 64 + fr; const float ALPHA = 1.189207115002721f;
        const float* gate = MOD + (size_t)(u.pm >> 5) * 3072 + 2048;
#pragma unroll
        for (int ai = 0; ai < 2; ++ai)
#pragma unroll
            for (int m = 0; m < 4; ++m) {
                __builtin_amdgcn_sched_barrier(0); const int row = opq(row0 + ai * 128 + m * 16);
#pragma unroll
                for (int bj = 0; bj < 2; ++bj) {
                    const int c0 = u.pn * 256 + bj * 128 + wc * 32 + 8 * fq;
                    const f32x4 x0 = *(const f32x4*)(X + (size_t)row * 1024 + c0), x1 = *(const f32x4*)(X + (size_t)row * 1024 + c0 + 4);
                    const f32x4 g0 = *(const f32x4*)(gate + c0), g1 = *(const f32x4*)(gate + c0 + 4);
                    *(f32x4*)(OUT + (size_t)row * 1024 + c0) = x0 * ALPHA + g0 * acc[ai][bj][m][0];
                    *(f32x4*)(OUT + (size_t)row * 1024 + c0 + 4) = x1 * ALPHA + g1 * acc[ai][bj][m][1];
                }
            }
    }
};
constexpr size_t MiB = 1u << 20;
constexpr size_t WS_BAR = 0, CTL_ZERO_BYTES = 16384;
constexpr size_t WS_SSKV = 0, WS_SSQ = 512 * 1024;
constexpr size_t WS_MOD = 1 * MiB, WS_CS16 = 1 * MiB + 128 * 1024, WS_CS8 = 1 * MiB + 192 * 1024;
constexpr size_t WS_WIN = 2 * MiB, WS_WUQ = 13 * MiB, WS_WUKV = 14 * MiB, WS_WOA = 15 * MiB, WS_WOB = 16 * MiB, WS_WOUT = 17 * MiB;
constexpr size_t WS_HBF = 32 * MiB;
constexpr size_t WS_VMLA = WS_HBF, WS_Z = WS_HBF;
constexpr size_t WS_KMLA = 164 * MiB;
constexpr size_t WS_GA = 263 * MiB;
constexpr size_t WS_DQ = 327 * MiB;
constexpr size_t WS_DK = 391 * MiB;
constexpr size_t WS_DV = 457 * MiB;
constexpr size_t WS_GD = 523 * MiB;
constexpr size_t WS_MG = 587 * MiB;
constexpr size_t WS_QMLA = 843 * MiB;
constexpr size_t WS_SSKVP = 939 * MiB, WS_SSQP = 941 * MiB;
constexpr size_t WS_END = 944 * MiB;
constexpr size_t OUT_XA = 96 * MiB, OUT_XD = 160 * MiB;
constexpr size_t OUT_CKV = 0, OUT_CQ = 33 * MiB;
constexpr int LDS_BYTES = 160832;

struct Args {
    const float *x, *c, *ctx, *c_ctx, *w_mod, *b_mod, *w_in, *q_norm, *kv_norm, *w_uq, *w_ukv, *dlam, *subln, *w_oa, *w_ob, *w_out, *ln_g, *ln_b;
    float* out; unsigned char* ws;
};

__device__ __forceinline__ void tr_item(const float* __restrict__ W, int K, int N, int srcn0, const float* __restrict__ ksc, bf16_t* WT, int dstn0, int k0, float* scr, int lane) {
#pragma unroll 8
    for (int i = 0; i < 32; ++i) { const int kk = 2 * i + (lane >> 5);
        float v = 0.f; if (srcn0 >= 0) { v = W[(size_t)(k0 + kk) * N + srcn0 + (lane & 31)]; if (ksc) v *= ksc[k0 + kk]; }
        scr[kk * 33 + (lane & 31)] = v; }
    asm volatile("s_waitcnt lgkmcnt(0)" ::: "memory");
    const int c = lane & 7;
#pragma unroll
    for (int j = 0; j < 4; ++j) { const int n = (lane >> 3) + 8 * j; const float* s = scr + (8 * c) * 33 + n;
        u32x4 o; o.x = cvtpk(s[0 * 33], s[1 * 33]); o.y = cvtpk(s[2 * 33], s[3 * 33]); o.z = cvtpk(s[4 * 33], s[5 * 33]); o.w = cvtpk(s[6 * 33], s[7 * 33]);
        *(u32x4*)(WT + (size_t)(dstn0 + n) * K + k0 + 8 * c) = o; }
    asm volatile("s_waitcnt lgkmcnt(0)" ::: "memory");
}

#define XB_TMO      128
#define XB_XCNT(j)  (256  + 64 * (j))
#define XB_XSUB(j)  (1280 + 64 * (j))
#define XB_XGEN(j)  (2304 + 64 * (j))
#define XB_TOP      3328
#define XB_TOPGEN   3392
#define XCD_BAR_WORDS 3456
#define XB_SPIN_CAP (1u << 18)

__device__ __forceinline__ unsigned xb_ld(unsigned* p)              { return __hip_atomic_load(p, __ATOMIC_RELAXED, __HIP_MEMORY_SCOPE_AGENT); }
__device__ __forceinline__ unsigned xb_add(unsigned* p, unsigned v) { return __hip_atomic_fetch_add(p, v, __ATOMIC_RELAXED, __HIP_MEMORY_SCOPE_AGENT); }
__device__ __forceinline__ unsigned xb_xcc_id() { return (unsigned)__builtin_amdgcn_s_getreg((3 << 11) | 20) & 0xFu; }
#define XB_SPIN(cond, bar) do { unsigned _sp = 0; while (cond) { __builtin_amdgcn_s_sleep(1); \
    if ((++_sp & 255u) == 0u) { if (xb_ld(&(bar)[XB_TMO])) break; if (_sp > XB_SPIN_CAP) { atomicAdd(&(bar)[XB_TMO], 1u); break; } } } } while (0)

struct XcdBarrier {
    unsigned* bar; unsigned x;
    volatile LAS unsigned* st;
};

__device__ __forceinline__ XcdBarrier xcd_barrier_post(unsigned* bar, volatile LAS unsigned* st) {
    XcdBarrier b; b.bar = bar; b.x = xb_xcc_id(); b.st = st;
    if (threadIdx.x == 0) (void)xb_add(&bar[XB_XCNT(b.x)], 1u);
    return b;
}
__device__ __forceinline__ void xcd_barrier_complete(unsigned* bar, unsigned x, unsigned& nloc, unsigned& nx) {
    const unsigned G = gridDim.x * gridDim.y * gridDim.z;
    unsigned sum, cnt, mine, sp = 0u;
    for (;;) {
        sum = 0u; cnt = 0u; mine = 0u;
#pragma unroll
        for (unsigned j = 0; j < 16; ++j) { const unsigned c = xb_ld(&bar[XB_XCNT(j)]); sum += c; cnt += (c > 0u) ? 1u : 0u; mine = (j == x) ? c : mine; }
        if (sum == G) break;
        __builtin_amdgcn_s_sleep(1);
        if ((++sp & 255u) == 0u) { if (xb_ld(&bar[XB_TMO])) break; if (sp > XB_SPIN_CAP) { atomicAdd(&bar[XB_TMO], 1u); break; } }
    }
    nloc = mine > 0u ? mine : 1u; nx = cnt > 0u ? cnt : 1u;
}

__device__ __forceinline__ void xcd_barrier(const XcdBarrier& b) {
    asm volatile("s_waitcnt vmcnt(0)" ::: "memory");
    __syncthreads();
    if (threadIdx.x == 0) {
        unsigned* bar = b.bar;
        __builtin_amdgcn_s_waitcnt(0);
        unsigned nloc = b.st[0], nx = b.st[1];
        if (nloc == 0u) { xcd_barrier_complete(bar, b.x, nloc, nx); b.st[0] = nloc; b.st[1] = nx; }
        const unsigned old = xb_add(&bar[XB_XSUB(b.x)], 1u);
        const unsigned gen = old / nloc;
        if (old + 1u == (gen + 1u) * nloc) {
            __builtin_amdgcn_fence(__ATOMIC_RELEASE, "agent");
            asm volatile("s_waitcnt vmcnt(0)" ::: "memory");
            const unsigned og = xb_add(&bar[XB_TOP], 1u);
            const unsigned tg = og / nx;
            if (og + 1u == (tg + 1u) * nx) xb_add(&bar[XB_TOPGEN], 1u);
            else XB_SPIN(xb_ld(&bar[XB_TOPGEN]) == tg, bar);
            __builtin_amdgcn_fence(__ATOMIC_ACQUIRE, "agent");
            xb_add(&bar[XB_XGEN(b.x)], 1u);
            asm volatile("s_waitcnt vmcnt(0)" ::: "memory");
        } else {
            XB_SPIN(xb_ld(&bar[XB_XGEN(b.x)]) == gen, bar);
            __builtin_amdgcn_fence(__ATOMIC_ACQUIRE, "agent");
            asm volatile("s_waitcnt vmcnt(0)" ::: "memory");
        }
    }
    __syncthreads();
}

__global__ void __launch_bounds__(512, 2) fwd_mega(Args a) {
    extern __shared__ __attribute__((aligned(16))) unsigned char lds[];
    cg::grid_group grid = cg::this_grid();
    const int wave = __builtin_amdgcn_readfirstlane((int)threadIdx.x >> 6);
#define LANE_TID const int lane = lane_id_v(), tid = wave * 64 + lane; (void)tid; (void)lane;
    const int G = gridDim.x, bid = blockIdx.x;
    const int gw = bid * 8 + wave, NGW = G * 8;
    unsigned char* ws = a.ws; unsigned char* ob = (unsigned char*)a.out;
    float* SSKV = (float*)(ws + WS_SSKVP); float* SSQ = (float*)(ws + WS_SSQP); float* MOD = (float*)(ws + WS_MOD);
    cs_t* CS16 = (cs_t*)(ws + WS_CS16); cs_t* CS8 = (cs_t*)(ws + WS_CS8);
    bf16_t* WIN = (bf16_t*)(ws + WS_WIN); bf16_t* WUQ = (bf16_t*)(ws + WS_WUQ); bf16_t* WUKV = (bf16_t*)(ws + WS_WUKV);
    bf16_t* WOA = (bf16_t*)(ws + WS_WOA); bf16_t* WOB = (bf16_t*)(ws + WS_WOB); bf16_t* WOUT = (bf16_t*)(ws + WS_WOUT);
    bf16_t* HBF = (bf16_t*)(ws + WS_HBF); bf16_t* VMLA = (bf16_t*)(ws + WS_VMLA); bf16_t* Z = (bf16_t*)(ws + WS_Z);
    bf16_t* KMLA = (bf16_t*)(ws + WS_KMLA); bf16_t* GA = (bf16_t*)(ws + WS_GA); bf16_t* DQ = (bf16_t*)(ws + WS_DQ); bf16_t* DK = (bf16_t*)(ws + WS_DK);
    bf16_t* DV = (bf16_t*)(ws + WS_DV); bf16_t* GD = (bf16_t*)(ws + WS_GD); bf16_t* MG = (bf16_t*)(ws + WS_MG); bf16_t* QMLA = (bf16_t*)(ws + WS_QMLA);
    bf16_t* CKV = (bf16_t*)(ob + OUT_CKV); bf16_t* CQ = (bf16_t*)(ob + OUT_CQ); bf16_t* XA = (bf16_t*)(ob + OUT_XA); bf16_t* XD = (bf16_t*)(ob + OUT_XD);
    PG8_LAS unsigned char* ldsp = (PG8_LAS unsigned char*)lds;
    { volatile LAS unsigned* stz = (volatile LAS unsigned*)(lds + 160768); if (threadIdx.x < 16) stz[threadIdx.x] = 0u; }
    __syncthreads();
    const XcdBarrier xbar = xcd_barrier_post((unsigned*)(ws + WS_BAR), (volatile LAS unsigned*)(lds + 160768));

#ifndef REP1
#define REP1 1
#endif
#ifndef REP2
#define REP2 1
#endif
#ifndef REP3A
#define REP3A 0
#endif
#ifndef REP3D
#define REP3D 0
#endif
#ifndef REP4A
#define REP4A 1
#endif
#ifndef REP4B
#define REP4B 1
#endif
#ifndef PHMASK
#define PHMASK 0xfff
#endif
    if (PHMASK & (1 << 0)) {
        LANE_TID
        float* A = (float*)lds; float* red = (float*)(lds + 36864);
        for (int cb = bid; cb < 96; cb += G) {
            __syncthreads();
            for (int i = tid; i < 9 * 1024; i += 512) { const int r = i >> 10, k = i & 1023; const float v = r < 8 ? a.c[r * 1024 + k] : a.c_ctx[k]; A[i] = v * sigmoidf_(v); }
            __syncthreads();
            const int cl = tid & 31, col = cb * 32 + cl, kq = tid >> 5;
            float acc[9];
#pragma unroll
            for (int r = 0; r < 9; ++r) acc[r] = 0.f;
#pragma unroll 4
            for (int kk = 0; kk < 64; ++kk) { const int k = kq * 64 + kk; const float w = a.w_mod[(size_t)k * 3072 + col];
#pragma unroll
                for (int r = 0; r < 9; ++r) acc[r] += A[r * 1024 + k] * w; }
#pragma unroll
            for (int r = 0; r < 9; ++r) red[(kq * 9 + r) * 32 + cl] = acc[r];
            __syncthreads();
            if (tid < 288) { const int r = tid >> 5; float s = 0.f;
                for (int q = 0; q < 16; ++q) s += red[(q * 9 + r) * 32 + cl];
                MOD[r * 3072 + col] = s + a.b_mod[col]; }
        }
        __syncthreads();
        float* scr = (float*)lds + wave * (64 * 33);
        constexpr int I_IN = 16 * 168, I_UQ = 6 * 24, I_UKV = 4 * 32, I_OA = 8 * 32, I_OB = 8 * 32, I_OUT = 16 * 32;
        constexpr int NITEMS = I_IN + I_UQ + I_UKV + I_OA + I_OB + I_OUT;
        for (int it = gw; it < NITEMS; it += NGW) {
            int r = it;
            if (r < I_IN) { const int kb = r / 168, nb = r % 168, d0 = nb * 32;
                const int s0 = d0 < 256 ? 384 + d0 : d0 < 640 ? d0 - 256 : d0 < 672 ? d0 : d0 < 768 ? -1 : d0 - 96;
                tr_item(a.w_in, 1024, 5280, s0, nullptr, WIN, d0, kb * 64, scr, lane); continue; } r -= I_IN;
            if (r < I_UQ) { tr_item(a.w_uq, 384, 768, (r % 24) * 32, a.q_norm, WUQ, (r % 24) * 32, (r / 24) * 64, scr, lane); continue; } r -= I_UQ;
            if (r < I_UKV) { tr_item(a.w_ukv, 256, 1024, (r % 32) * 32, a.kv_norm, WUKV, (r % 32) * 32, (r / 32) * 64, scr, lane); continue; } r -= I_UKV;
            if (r < I_OA) { tr_item(a.w_oa, 512, 1024, (r % 32) * 32, nullptr, WOA, (r % 32) * 32, (r / 32) * 64, scr, lane); continue; } r -= I_OA;
            if (r < I_OB) { tr_item(a.w_ob, 512, 1024, (r % 32) * 32, nullptr, WOB, (r % 32) * 32, (r / 32) * 64, scr, lane); continue; } r -= I_OB;
            tr_item(a.w_out, 1024, 1024, (r % 32) * 32, nullptr, WOUT, (r % 32) * 32, (r / 32) * 64, scr, lane);
        }
        if (bid == G - 1) {
            for (int i = tid; i < 128 * 16; i += 512) { const int pos = i >> 4, f = i & 15; const float inv = powf(10000.f, -(float)f / 16.f), ang = (float)pos * inv; CS16[i] = make_float2(cosf(ang), sinf(ang)); }
            for (int i = tid; i < 128 * 8; i += 512) { const int pos = i >> 3, f = i & 7; const float inv = powf(10000.f, -(float)f / 8.f), ang = (float)pos * inv; CS8[i] = make_float2(cosf(ang), sinf(ang)); }
        }
    }
    grid.sync();

    if (PHMASK & (1 << 1)) for (int m = gw; m < MALL; m += NGW) {
        LANE_TID
        const float* src; const float* mod;
        if (m < MLAT) { src = a.x + (size_t)m * 1024; mod = MOD + (size_t)(m >> 13) * 3072; } else { src = a.ctx + (size_t)(m - MLAT) * 1024; mod = MOD + 8 * 3072; }
#pragma unroll
        for (int j = 0; j < 4; ++j) { const int c4 = lane + 64 * j;
            const f32x4 v = ((const f32x4*)src)[c4], sh = ((const f32x4*)mod)[c4], sc = ((const f32x4*)(mod + 1024))[c4];
            const f32x4 h = v * (sc + 1.f) + sh; u32x2 w; w.x = cvtpk(h[0], h[1]); w.y = cvtpk(h[2], h[3]);
            *(u32x2*)(HBF + (size_t)m * 1024 + c4 * 4) = w; }
    }
    xcd_barrier(xbar);

    if (PHMASK & (1 << 2)) for (int rep = 0; rep < REP1; ++rep) {
        pg8::Gemm g{HBF, WIN, MALL, NINP, 1024}; pg8::StaticOrder S; S.init(MALL, NINP, G, bid);
        EpiP1 E{CKV, CQ, KMLA, GA, DQ, DK, DV, GD, MG, SSKV, SSQ, CS16, CS8, rep == 0};
        pg8::gemm_phase<EpiP1, pg8::StaticOrder, true, true>(ldsp, g, S, E, wave);
    }
    xcd_barrier(xbar);

    for (int rep = 0; rep < REP2; ++rep) {
    if (PHMASK & (1 << 3)) {
        pg8::Gemm g{CQ, WUQ, MLAT, 768, 384}; pg8::StaticOrder S; S.init(MLAT, 768, G, bid);
        EpiQ E{QMLA, SSQ, CS8};
        pg8::gemm_phase<EpiQ, pg8::StaticOrder, true, true>(ldsp, g, S, E, wave);
    }
    if (PHMASK & (1 << 4)) {
        pg8::Gemm g{CKV, WUKV, MALL, 1024, 256}; pg8::StaticOrder S; S.init(MALL, 1024, G, bid);
        EpiKV E{KMLA, VMLA, SSKV};
        pg8::gemm_phase<EpiKV, pg8::StaticOrder, true, true>(ldsp, g, S, E, wave);
    }
    }
    xcd_barrier(xbar);

    if (PHMASK & (3 << 5)) {
        float lam;
        { LANE_TID
        { const float s1 = wave_sum(a.dlam[lane] * a.dlam[64 + lane]), s2 = wave_sum(a.dlam[128 + lane] * a.dlam[192 + lane]); lam = __builtin_bit_cast(float, __builtin_amdgcn_readfirstlane(__builtin_bit_cast(int, __expf(s1) - __expf(s2) + 0.2f))); } }
        int grp;
        { LANE_TID
          int* tab = (int*)(lds + 95232); const int simd = (__builtin_amdgcn_s_getreg((1 << 11) | (4 << 6) | 4)) & 3;
          __syncthreads(); if (lane == 0) tab[wave] = simd; __syncthreads();
          int cnt = 0;
#pragma unroll
          for (int w = 0; w < 8; ++w) cnt += (w < wave && tab[w] == simd) ? 1 : 0;
          grp = __builtin_amdgcn_readfirstlane(cnt > 0 ? 1 : 0); asm volatile("" : "+s"(grp)); __syncthreads(); }
        const int nrounds = (NB * 12 * 32 + G - 1) / G;
        for (int rdx = 0; rdx < nrounds + REP3A * 8 + REP3D * 4; ++rdx) {
            const int rd = rdx < nrounds ? rdx : (rdx - nrounds < REP3A * 8 ? (rdx - nrounds) & 7 : 8 + ((rdx - nrounds - REP3A * 8) & 3));
            int b, hs, qb;
            { const int idx = rd * G + bid; if (idx >= NB * 12 * 32) break; b = idx & 7; qb = (idx >> 3) & 31; hs = idx >> 8; }
            const size_t qrow0 = (size_t)b * SEQ + qb * 256, krow0 = (size_t)b * SKV;
            __syncthreads();
            if (hs < 8) { if (PHMASK & (1 << 5)) {
                f32x16 o[2];
                att::attn_core<true>(QMLA + qrow0 * 768 + hs * 96, KMLA + krow0 * 768 + hs * 96, VMLA + krow0 * 512 + hs * 64, SKV, (char*)lds, o, wave, grp);
                LANE_TID
                const int r32 = lane & 31, hi = lane >> 5;
                char* T = (char*)lds + 95232 + wave * 8192; char* tw = T + hi * 512 + r32 * 2;
#pragma unroll
                for (int r = 0; r < 16; ++r)
#pragma unroll
                    for (int d0 = 0; d0 < 2; ++d0) *(bf16_t*)(tw + ((r & 3) + 8 * (r >> 2)) * 128 + d0 * 64) = (bf16_t)cvtpk(o[d0][r], o[d0][r]);
#pragma unroll
                for (int j = 0; j < 4; ++j) { const int id = j * 64 + lane, row = id >> 3, c8 = id & 7;
                    const u32x4 t = *(const u32x4*)(T + id * 16);
                    const size_t go = (qrow0 + wave * 32 + row) * 512 + hs * 64 + c8 * 8; const u32x4 g = *(const u32x4*)(GA + go);
                    u32x4 w; w.x = cvtpk(bflo(t.x) * bflo(g.x), bfhi(t.x) * bfhi(g.x)); w.y = cvtpk(bflo(t.y) * bflo(g.y), bfhi(t.y) * bfhi(g.y));
                    w.z = cvtpk(bflo(t.z) * bflo(g.z), bfhi(t.z) * bfhi(g.z)); w.w = cvtpk(bflo(t.w) * bflo(g.w), bfhi(t.w) * bfhi(g.w));
                    *(u32x4*)(XA + go) = w; }
            } } else if (PHMASK & (1 << 6)) {
                const int h = hs - 8;
                f32x16 o[4];
                att::attn_core<false>(DQ + qrow0 * 512 + h * 128, DK + krow0 * 512 + h * 128, DV + krow0 * 512 + h * 128, SKV, (char*)lds, o, wave, grp);
                { unsigned* stash = (unsigned*)(lds + 95232 + wave * 8192) + lane_id_v();
#pragma unroll
                for (int d0 = 0; d0 < 4; ++d0)
#pragma unroll
                    for (int r = 0; r < 16; r += 2) stash[(d0 * 8 + (r >> 1)) * 64] = cvtpk(o[d0][r], o[d0][r + 1]); }
                att::attn_core<false>(DQ + qrow0 * 512 + h * 128 + 64, DK + krow0 * 512 + h * 128 + 64, DV + krow0 * 512 + h * 128, SKV, (char*)lds, o, wave, grp);
                LANE_TID
                const int r32 = lane & 31, hi = lane >> 5;
                unsigned* stash = (unsigned*)(lds + 95232 + wave * 8192) + lane;
#pragma unroll
                for (int d0 = 0; d0 < 4; ++d0)
#pragma unroll
                    for (int r = 0; r < 16; r += 2) { const unsigned w = stash[(d0 * 8 + (r >> 1)) * 64];
                        o[d0][r] = bflo(w) - lam * o[d0][r]; o[d0][r + 1] = bfhi(w) - lam * o[d0][r + 1]; }
                asm volatile("s_waitcnt lgkmcnt(0)" ::: "memory"); SBAR();
                char* T = (char*)lds + 95232 + wave * 8192; char* tw = T + hi * 1024 + r32 * 2;
#pragma unroll
                for (int r = 0; r < 16; ++r)
#pragma unroll
                    for (int d0 = 0; d0 < 4; ++d0) *(bf16_t*)(tw + ((r & 3) + 8 * (r >> 2)) * 256 + d0 * 64) = (bf16_t)cvtpk(o[d0][r], o[d0][r]);
                const int c16 = lane & 15;
                const f32x4 sw0 = *(const f32x4*)(a.subln + c16 * 8), sw1 = *(const f32x4*)(a.subln + c16 * 8 + 4);
#pragma unroll
                for (int j = 0; j < 8; ++j) { const int id = j * 64 + lane, row = id >> 4;
                    const u32x4 t = *(const u32x4*)(T + id * 16);
                    float e[8] = {bflo(t.x), bfhi(t.x), bflo(t.y), bfhi(t.y), bflo(t.z), bfhi(t.z), bflo(t.w), bfhi(t.w)};
                    float ss = 0.f;
#pragma unroll
                    for (int k = 0; k < 8; ++k) ss += e[k] * e[k];
                    ss += shflx(ss, 1); ss += shflx(ss, 2); ss += shflx(ss, 4); ss += shflx(ss, 8);
                    const float rs = 0.8f / sqrtf(ss * (1.f / 128.f) + 1e-5f);
                    const size_t go = (qrow0 + wave * 32 + row) * 512 + h * 128 + c16 * 8; const u32x4 g = *(const u32x4*)(GD + go);
                    u32x4 w; w.x = cvtpk(e[0] * rs * sw0[0] * bflo(g.x), e[1] * rs * sw0[1] * bfhi(g.x)); w.y = cvtpk(e[2] * rs * sw0[2] * bflo(g.y), e[3] * rs * sw0[3] * bfhi(g.y));
                    w.z = cvtpk(e[4] * rs * sw1[0] * bflo(g.z), e[5] * rs * sw1[1] * bfhi(g.z)); w.w = cvtpk(e[6] * rs * sw1[2] * bflo(g.w), e[7] * rs * sw1[3] * bfhi(g.w));
                    *(u32x4*)(XD + go) = w; }
            }
        }
    }
    xcd_barrier(xbar);

    for (int rep = 0; rep < REP4A; ++rep) {
    if (PHMASK & (1 << 7)) {
        pg8::Gemm g{XA, WOA, MLAT, 1024, 512}; pg8::StaticOrder S; S.init(MLAT, 1024, G, bid);
        EpiZ<false> E{Z, MG};
        pg8::gemm_phase<EpiZ<false>, pg8::StaticOrder, true, true>(ldsp, g, S, E, wave);
    }
    if (PHMASK & (1 << 8)) {
        pg8::Gemm g{XD, WOB, MLAT, 1024, 512}; pg8::StaticOrder S; S.init(MLAT, 1024, G, bid);
        EpiZ<true> E{Z, MG + 1024};
        pg8::gemm_phase<EpiZ<true>, pg8::StaticOrder, true, true>(ldsp, g, S, E, wave);
    }
    }
    xcd_barrier(xbar);

    if (PHMASK & (1 << 9)) for (int rep = 0; rep < REP4B; ++rep) {
        pg8::Gemm g{Z, WOUT, MLAT, 1024, 1024}; pg8::StaticOrder S; S.init(MLAT, 1024, G, bid);
        EpiOut E{a.out, a.x, MOD};
        pg8::gemm_phase<EpiOut, pg8::StaticOrder, true, true>(ldsp, g, S, E, wave);
    }
    xcd_barrier(xbar);

    if (PHMASK & (1 << 10)) for (int m = gw; m < MLAT; m += NGW) {
        LANE_TID
        f32x4* rowp = (f32x4*)(a.out + (size_t)m * 1024) + lane;
        f32x4 v[4]; float s = 0.f;
#pragma unroll
        for (int j = 0; j < 4; ++j) { v[j] = rowp[64 * j]; s += (v[j][0] + v[j][1]) + (v[j][2] + v[j][3]); }
        const float mean = wave_sum(s) * (1.f / 1024.f); float s2 = 0.f;
#pragma unroll
        for (int j = 0; j < 4; ++j) { v[j] = v[j] - mean; s2 += (v[j][0] * v[j][0] + v[j][1] * v[j][1]) + (v[j][2] * v[j][2] + v[j][3] * v[j][3]); }
        const float rstd = 1.f / sqrtf(wave_sum(s2) * (1.f / 1024.f) + 1e-5f);
#pragma unroll
        for (int j = 0; j < 4; ++j) { const f32x4 g = ((const f32x4*)a.ln_g)[lane + 64 * j], bb = ((const f32x4*)a.ln_b)[lane + 64 * j]; rowp[64 * j] = v[j] * rstd * g + bb; }
    }
}

extern "C" void kernel_launch(void* const* d_in, const int* in_sizes, int n_in, void* d_out, int out_size, void* d_ws, size_t ws_size, hipStream_t stream) {
    static int grid = 0;
    if (grid == 0) {
        if (n_in != 18 || in_sizes[0] != MLAT * DM || out_size != MLAT * DM || ws_size < WS_END) {
            fprintf(stderr, "kernel_launch: shape/workspace mismatch: n_in %d in0 %d out %d ws %zu (need %zu)\n", n_in, n_in > 0 ? in_sizes[0] : -1, out_size, ws_size, (size_t)WS_END); grid = -1; return; }
        int dev = 0, cus = 0, per_cu = 0;
        hipGetDevice(&dev); hipDeviceGetAttribute(&cus, hipDeviceAttributeMultiprocessorCount, dev);
        if (hipFuncSetAttribute((const void*)fwd_mega, hipFuncAttributeMaxDynamicSharedMemorySize, LDS_BYTES) != hipSuccess) { fprintf(stderr, "kernel_launch: hipFuncSetAttribute failed\n"); grid = -1; return; }
        if (hipOccupancyMaxActiveBlocksPerMultiprocessor(&per_cu, (const void*)fwd_mega, 512, LDS_BYTES) != hipSuccess || per_cu < 1) { fprintf(stderr, "kernel_launch: occupancy query gave %d\n", per_cu); per_cu = 1; }
        (void)hipGetLastError();
        grid = cus * 1;
    }
    if (grid < 0) return;
    hipMemsetAsync((char*)d_ws + WS_BAR, 0, CTL_ZERO_BYTES, stream);
    Args a{};
    a.x = (const float*)d_in[0]; a.c = (const float*)d_in[1]; a.ctx = (const float*)d_in[2]; a.c_ctx = (const float*)d_in[3]; a.w_mod = (const float*)d_in[4]; a.b_mod = (const float*)d_in[5];
    a.w_in = (const float*)d_in[6]; a.q_norm = (const float*)d_in[7]; a.kv_norm = (const float*)d_in[8]; a.w_uq = (const float*)d_in[9]; a.w_ukv = (const float*)d_in[10];
    a.dlam = (const float*)d_in[11]; a.subln = (const float*)d_in[12]; a.w_oa = (const float*)d_in[13]; a.w_ob = (const float*)d_in[14]; a.w_out = (const float*)d_in[15];
    a.ln_g = (const float*)d_in[16]; a.ln_b = (const float*)d_in[17]; a.out = (float*)d_out; a.ws = (unsigned char*)d_ws;
    void* args[] = {&a};
    hipError_t e = hipLaunchCooperativeKernel((const void*)fwd_mega, dim3(grid), dim3(512), args, LDS_BYTES, stream);
    if (e != hipSuccess) fprintf(stderr, "kernel_launch: cooperative launch failed: %s (grid %d)\n", hipGetErrorString(e), grid);
}
```

```cpp
#include <hip/hip_runtime.h>
#include <hip/hip_cooperative_groups.h>
#include <cstdio>
#include <cstdint>
namespace cg = cooperative_groups;
__device__ __forceinline__ int opq(int v) { asm volatile("" : "+v"(v)); return v; }
__device__ __forceinline__ int lane_id_v() { int l; asm volatile("v_mbcnt_lo_u32_b32 %0, -1, 0\n\tv_mbcnt_hi_u32_b32 %0, -1, %0" : "=v"(l)); return l; }
__device__ __forceinline__ float shflx(float v, int mask) { return __builtin_bit_cast(float, __builtin_amdgcn_ds_bpermute((lane_id_v() ^ mask) << 2, __builtin_bit_cast(int, v))); }
__device__ __forceinline__ float shfli(float v, int idx4) { return __builtin_bit_cast(float, __builtin_amdgcn_ds_bpermute(idx4, __builtin_bit_cast(int, v))); }
namespace pg8 {
#define PG8_LAS __attribute__((address_space(3)))
typedef unsigned short bf16_t;
typedef short bf16x8 __attribute__((ext_vector_type(8)));
typedef float f32x4 __attribute__((ext_vector_type(4)));
typedef unsigned u32x4 __attribute__((ext_vector_type(4)));
constexpr int BM = 256, BK = 64, HALF = 128, HTB = HALF * BK * 2  , STAGE_BYTES = 8 * HTB, NXCD = 8, WGM = 8;

__host__ __device__ __forceinline__ int lds_byte(int r, int c) { const int st = (r >> 4) * 2 + (c >> 5), rr = r & 15, cc = c & 31, ob = rr * 64 + cc * 2; return st * 1024 + (ob ^ (((ob >> 9) & 1) << 5)); }
__host__ __device__ __forceinline__ void stage_rc(int b, int& R, int& C) { const int st = b / 1024, sb = b % 1024, swz = sb ^ (((sb >> 9) & 1) << 5); R = (st >> 1) * 16 + swz / 64; C = (st & 1) * 32 + (swz % 64) / 2; }
__host__ __device__ __forceinline__ int perm32(int rho) { const int n = rho >> 4, i = rho & 15; return 8 * (i >> 2) + 4 * n + (i & 3); }

struct Unit { int pm, pn; };
struct Gemm { const bf16_t* A; const bf16_t* Bt; int M, N, K; };

struct StaticOrder {
    int nM, nN, nwg, G, c, wgm;
    __host__ __device__ void init(int M, int N, int G_, int c_) { nM = M / BM; nN = N / BM; nwg = nM * nN; G = G_; c = c_; wgm = WGM; }
    __host__ __device__ bool next(int i, Unit& u) const {
        const long L = (long)i * G + c; if (L >= nwg) return false;
        int wgid = (int)L; { const int q = nwg / NXCD, r = nwg % NXCD, xcd = wgid % NXCD, off = wgid / NXCD; wgid = (xcd < r ? xcd * (q + 1) : r * (q + 1) + (xcd - r) * q) + off; }
        const int nig = wgm * nN, gid = wgid / nig, fm = gid * wgm, gsz = (nM - fm) < wgm ? (nM - fm) : wgm;
        u.pm = fm + ((wgid % nig) % gsz); u.pn = (wgid % nig) / gsz; return true;
    }
    __device__ __forceinline__ void a_ready(const Unit&) const {}
    __device__ __forceinline__ void done(const Unit&) const {}
};

template <class Epi, class Sched, bool ALIGN_EPI = false, bool SP2 = false>
__device__ __forceinline__ void gemm_phase(PG8_LAS unsigned char* lds, const Gemm g, const Sched& S, const Epi& E, const int wid  ) {
    const int lane = lane_id_v(), tid = wid * 64 + lane, wr = wid >> 2, wc = wid & 3, fr = lane & 15, fq = lane >> 4;
    const int K = g.K, nt = K / BK;
    unsigned voffA[2], voffB[2];
#pragma unroll
    for (int i = 0; i < 2; ++i) { int R, C; stage_rc(tid * 16 + i * 8192, R, C); const int Rb = Epi::PERM ? ((R & ~31) + perm32(R & 31)) : R;
        voffA[i] = (unsigned)(R * K + C) * 2u; voffB[i] = (unsigned)(Rb * K + C) * 2u; }
    const size_t kstep = (size_t)(BK * 2);
    const size_t hstep = (size_t)HALF * K * 2;
    const size_t tstep = 2 * hstep;
    const unsigned ldsw = (unsigned)wid * 1024u;
    const int aoff = lds_byte(wr * 64 + fr, fq * 8), boff = lds_byte(wc * 32 + fr, fq * 8);
#define PG8_SA(b, h) (((b) * 2 + (h)) * HTB)
#define PG8_SB(b, h) ((4 + (b) * 2 + (h)) * HTB)
#define PG8_STAGE(bufoff, gbase, voff) do { _Pragma("unroll") for (int _i = 0; _i < 2; ++_i) \
        __builtin_amdgcn_global_load_lds((const unsigned*)((const char*)(gbase) + (voff)[_i]), (PG8_LAS unsigned*)(lds + (bufoff) + ldsw + _i * 8192), 16, 0, 0); } while (0)
#define PG8_LDA(dst, b, h) do { _Pragma("unroll") for (int m = 0; m < 4; ++m) _Pragma("unroll") for (int k = 0; k < 2; ++k) dst[m][k] = *(const PG8_LAS bf16x8*)(lds + PG8_SA(b, h) + aoff + m * 2048 + k * 1024); } while (0)
#define PG8_LDB(dst, b, h) do { _Pragma("unroll") for (int n = 0; n < 2; ++n) _Pragma("unroll") for (int k = 0; k < 2; ++k) dst[n][k] = *(const PG8_LAS bf16x8*)(lds + PG8_SB(b, h) + boff + n * 2048 + k * 1024); } while (0)
#define PG8_MMA(ai, bj, At, Bt) do { __builtin_amdgcn_s_setprio(1); _Pragma("unroll") for (int m = 0; m < 4; ++m) _Pragma("unroll") for (int n = 0; n < 2; ++n) _Pragma("unroll") for (int k = 0; k < 2; ++k) \
        acc[ai][bj][m][n] = __builtin_amdgcn_mfma_f32_16x16x32_bf16(Bt[n][k], At[m][k], acc[ai][bj][m][n], 0, 0, 0); __builtin_amdgcn_s_setprio(0); } while (0)
#define PG8_WAIT_V(n) asm volatile("s_waitcnt vmcnt(" #n ")" ::: "memory")
#define PG8_WAIT_L(n) asm volatile("s_waitcnt lgkmcnt(" #n ")" ::: "memory")
#define PG8_BAR __builtin_amdgcn_s_barrier()
#define PG8_SCHED __builtin_amdgcn_sched_barrier(0)
    Unit cur, nxt; int ui = 0;
    if (!S.next(0, cur)) return;
    f32x4 acc[2][2][4][2];
#pragma unroll
    for (int a = 0; a < 2; ++a)
#pragma unroll
        for (int b = 0; b < 2; ++b)
#pragma unroll
            for (int m = 0; m < 4; ++m)
#pragma unroll
                for (int n = 0; n < 2; ++n) acc[a][b][m][n] = (f32x4){0.f, 0.f, 0.f, 0.f};
    bf16x8 At[4][2], B0[2][2], B1[2][2];
    const char* cA = (const char*)g.A + (size_t)cur.pm * tstep; const char* cB = (const char*)g.Bt + (size_t)cur.pn * tstep;
    S.a_ready(cur);
    if constexpr (SP2) {
        PG8_STAGE(PG8_SB(0, 0), cB, voffB); PG8_STAGE(PG8_SB(0, 1), cB + hstep, voffB); PG8_STAGE(PG8_SA(0, 0), cA, voffA); PG8_STAGE(PG8_SA(0, 1), cA + hstep, voffA);
        if (wr == 1) PG8_BAR;
        PG8_WAIT_V(2); PG8_BAR;
        PG8_STAGE(PG8_SB(1, 0), cB + kstep, voffB); PG8_STAGE(PG8_SA(1, 0), cA + kstep, voffA); PG8_STAGE(PG8_SB(1, 1), cB + hstep + kstep, voffB);
        PG8_WAIT_V(6); PG8_BAR;
    } else {
        PG8_STAGE(PG8_SB(0, 0), cB, voffB); PG8_STAGE(PG8_SA(0, 0), cA, voffA); PG8_STAGE(PG8_SB(0, 1), cB + hstep, voffB); PG8_STAGE(PG8_SA(0, 1), cA + hstep, voffA);
        if (wr == 1) PG8_BAR;
        PG8_WAIT_V(4); PG8_BAR;
        PG8_STAGE(PG8_SB(1, 0), cB + kstep, voffB); PG8_STAGE(PG8_SA(1, 0), cA + kstep, voffA); PG8_STAGE(PG8_SB(1, 1), cB + hstep + kstep, voffB);
        PG8_WAIT_V(6); PG8_BAR;
    }
    for (;;) {
        const bool has_next = S.next(ui + 1, nxt);
        const char* nA = has_next ? (const char*)g.A + (size_t)nxt.pm * tstep : cA; const char* nB = has_next ? (const char*)g.Bt + (size_t)nxt.pn * tstep : cB;
        for (int t = 0; t < nt; t += 2) {
            const bool last = (t == nt - 2);
            const char* a1 = cA + (size_t)(t + 1) * kstep;
            const char* a2 = last ? nA : cA + (size_t)(t + 2) * kstep; const char* b2 = last ? nB : cB + (size_t)(t + 2) * kstep;
            const char* a3 = a2 + kstep; const char* b3 = b2 + kstep;
            if (last && has_next) S.a_ready(nxt);
            if constexpr (SP2) {
            PG8_LDB(B0, 0, 0); PG8_LDB(B1, 0, 1); PG8_SCHED; PG8_LDA(At, 0, 0); PG8_STAGE(PG8_SA(1, 1), a1 + hstep, voffA);
            PG8_WAIT_V(8); PG8_WAIT_L(0); PG8_BAR; PG8_MMA(0, 0, At, B0); PG8_MMA(0, 1, At, B1); PG8_BAR; PG8_SCHED;
            PG8_LDA(At, 0, 1); PG8_STAGE(PG8_SB(0, 0), b2, voffB); PG8_STAGE(PG8_SB(0, 1), b2 + hstep, voffB); PG8_STAGE(PG8_SA(0, 0), a2, voffA);
            PG8_WAIT_V(8); PG8_WAIT_L(0); PG8_BAR; PG8_MMA(1, 0, At, B0); PG8_MMA(1, 1, At, B1); PG8_BAR; PG8_SCHED;
            PG8_LDB(B0, 1, 0); PG8_LDB(B1, 1, 1); PG8_SCHED; PG8_LDA(At, 1, 0); PG8_STAGE(PG8_SA(0, 1), a2 + hstep, voffA);
            PG8_WAIT_V(8); PG8_WAIT_L(0); PG8_BAR; PG8_MMA(0, 0, At, B0); PG8_MMA(0, 1, At, B1); PG8_BAR; PG8_SCHED;
            PG8_LDA(At, 1, 1); PG8_STAGE(PG8_SB(1, 0), b3, voffB); PG8_STAGE(PG8_SB(1, 1), b3 + hstep, voffB); PG8_STAGE(PG8_SA(1, 0), a3, voffA);
            PG8_WAIT_V(8); PG8_WAIT_L(0); PG8_BAR; PG8_MMA(1, 0, At, B0); PG8_MMA(1, 1, At, B1); PG8_BAR; PG8_SCHED;
            } else {
            PG8_LDB(B0, 0, 0); PG8_SCHED; PG8_LDA(At, 0, 0); PG8_STAGE(PG8_SA(1, 1), a1 + hstep, voffA);
            PG8_WAIT_L(8); PG8_BAR; PG8_WAIT_L(0); PG8_MMA(0, 0, At, B0); PG8_BAR; PG8_SCHED;
            PG8_LDB(B1, 0, 1); PG8_STAGE(PG8_SB(0, 0), b2, voffB);
            PG8_BAR; PG8_WAIT_L(0); PG8_MMA(0, 1, At, B1); PG8_BAR;
            PG8_LDA(At, 0, 1); PG8_STAGE(PG8_SA(0, 0), a2, voffA);
            PG8_BAR; PG8_WAIT_L(0); PG8_MMA(1, 0, At, B0); PG8_BAR; PG8_SCHED;
            PG8_STAGE(PG8_SB(0, 1), b2 + hstep, voffB);
            PG8_WAIT_V(6); PG8_BAR; PG8_MMA(1, 1, At, B1); PG8_BAR;
            PG8_LDB(B0, 1, 0); PG8_SCHED; PG8_LDA(At, 1, 0); PG8_STAGE(PG8_SA(0, 1), a2 + hstep, voffA);
            PG8_WAIT_L(8); PG8_BAR; PG8_WAIT_L(0); PG8_MMA(0, 0, At, B0); PG8_BAR; PG8_SCHED;
            PG8_LDB(B1, 1, 1); PG8_STAGE(PG8_SB(1, 0), b3, voffB);
            PG8_BAR; PG8_WAIT_L(0); PG8_MMA(0, 1, At, B1); PG8_BAR;
            PG8_LDA(At, 1, 1); PG8_STAGE(PG8_SA(1, 0), a3, voffA);
            PG8_BAR; PG8_WAIT_L(0); PG8_MMA(1, 0, At, B0); PG8_BAR; PG8_SCHED;
            PG8_STAGE(PG8_SB(1, 1), b3 + hstep, voffB);
            PG8_WAIT_V(6); PG8_BAR; PG8_MMA(1, 1, At, B1); PG8_BAR;
            }
        }
        if constexpr (ALIGN_EPI) { if (wr == 0) PG8_BAR; }
        if constexpr (!Epi::AFTER_DRAIN) { E(acc, cur, wr, wc, fr, fq); S.done(cur); }
        if (!has_next) break;
#pragma unroll
        for (int a = 0; a < 2; ++a)
#pragma unroll
            for (int b = 0; b < 2; ++b)
#pragma unroll
                for (int m = 0; m < 4; ++m)
#pragma unroll
                    for (int n = 0; n < 2; ++n) acc[a][b][m][n] = (f32x4){0.f, 0.f, 0.f, 0.f};
        cur = nxt; cA = nA; cB = nB; ++ui;
        if constexpr (ALIGN_EPI) { if (wr == 1) PG8_BAR; }
    }
    PG8_WAIT_V(0);
    if constexpr (!ALIGN_EPI) { if (wr == 0) PG8_BAR; }
    PG8_BAR;
    if constexpr (Epi::AFTER_DRAIN) { E.fused(acc, cur, wr, wc, fr, fq, lds, wid, lane); S.done(cur); }
#undef PG8_SA
#undef PG8_SB
#undef PG8_STAGE
#undef PG8_LDA
#undef PG8_LDB
#undef PG8_MMA
#undef PG8_WAIT_V
#undef PG8_WAIT_L
#undef PG8_BAR
#undef PG8_SCHED
}
}
constexpr int DM = 1024, NB = 8, SEQ = 8192, CTX = 256, SKV = SEQ + CTX;
constexpr int MLAT = NB * SEQ, MALL = MLAT + NB * CTX;
constexpr int NINP = 5376;
typedef unsigned short bf16_t;
typedef short bf16x8 __attribute__((ext_vector_type(8)));
typedef short s16x4 __attribute__((ext_vector_type(4)));
typedef float f32x16 __attribute__((ext_vector_type(16)));
typedef float f32x4 __attribute__((ext_vector_type(4)));
typedef unsigned u32x4 __attribute__((ext_vector_type(4)));
typedef unsigned u32x2 __attribute__((ext_vector_type(2)));
#define LAS __attribute__((address_space(3)))
#define SBAR() __builtin_amdgcn_sched_barrier(0)
typedef float f32x2_t __attribute__((ext_vector_type(2)));
typedef __bf16 bf16x2_t __attribute__((ext_vector_type(2)));
__device__ __forceinline__ unsigned cvtpk(float lo, float hi) { f32x2_t v = {lo, hi}; bf16x2_t b = __builtin_convertvector(v, bf16x2_t); return __builtin_bit_cast(unsigned, b); }
__device__ __forceinline__ unsigned cvtpk_a(float lo, float hi) { unsigned r; asm volatile("v_cvt_pk_bf16_f32 %0, %1, %2" : "=v"(r) : "v"(lo), "v"(hi)); return r; }
__device__ __forceinline__ unsigned f2bf(float f) { unsigned u = __builtin_bit_cast(unsigned, f); return (u + 0x7fffu + ((u >> 16) & 1u)) >> 16; }
__device__ __forceinline__ float bf2f(unsigned short b) { return __builtin_bit_cast(float, (unsigned)b << 16); }
__device__ __forceinline__ float bflo(unsigned w) { return __builtin_bit_cast(float, w << 16); }
__device__ __forceinline__ float bfhi(unsigned w) { return __builtin_bit_cast(float, w & 0xffff0000u); }
__device__ __forceinline__ float sigmoidf_(float v) { return 1.f / (1.f + __expf(-v)); }
__device__ __forceinline__ float sigmoid_fast(float v) { return __builtin_amdgcn_rcpf(1.f + __builtin_amdgcn_exp2f(-1.4426950408889634f * v)); }
__device__ __forceinline__ float wave_sum(float v) {
#pragma unroll
    for (int o = 1; o < 64; o <<= 1) v += shflx(v, o);
    return v;
}

namespace att {
#ifndef PROBE_NOLOAD
#define PROBE_NOLOAD 0
#endif
template <bool MLA> struct Cfg {
    static constexpr int DQK = MLA ? 96 : 64, DV = MLA ? 64 : 128, NQ = DQK / 16, NCB = DV / 32;
    static constexpr int KROWB = MLA ? 272 : 144;
    static constexpr int LDQ = MLA ? 768 : 512, LDK = MLA ? 768 : 512, LDV = 512;
    static constexpr int SHM_V = 64 * DV * 2, SHM_K = 64 * KROWB;
};
constexpr float THR = 8.f;
__device__ __forceinline__ int crow(int r, int hi) { return (r & 3) + 8 * (r >> 2) + 4 * hi; }
template <bool MLA> __device__ __forceinline__ int kswz(int row, int colB) { return row * Cfg<MLA>::KROWB + colB; }
__device__ __forceinline__ float max3f(float a, float b, float c) { return __builtin_fmaxf(__builtin_fmaxf(a, b), c); }
__device__ __forceinline__ void rowmax_adjust(f32x16& p0, f32x16& p1, float& m2, f32x16& negm, float& alpha, const bool first) {
    constexpr float THR2 = THR * 1.4426950408889634f;
    float pmax = max3f(p0[0], p0[1], p0[2]);
#pragma unroll
    for (int r = 3; r < 15; r += 2) pmax = max3f(pmax, p0[r], p0[r + 1]);
    pmax = max3f(pmax, p0[15], p1[0]);
#pragma unroll
    for (int r = 1; r < 15; r += 2) pmax = max3f(pmax, p1[r], p1[r + 1]);
    pmax = fmaxf(pmax, p1[15]);
    { auto rr = __builtin_amdgcn_permlane32_swap(__float_as_uint(pmax), __float_as_uint(pmax), false, false);
      pmax = fmaxf(__uint_as_float(rr[0]), __uint_as_float(rr[1])); }
    if (!first && __builtin_expect(__all(pmax <= THR2), 1)) { alpha = 1.f; }
    else {
        const float delta = first ? pmax : fmaxf(pmax, 0.f);
        alpha = first ? 1.f : __builtin_amdgcn_exp2f(-delta);
        m2 += delta;
#pragma unroll
        for (int r = 0; r < 16; ++r) { p0[r] -= delta; p1[r] -= delta; }
        const float nm = -m2;
#pragma unroll
        for (int r = 0; r < 16; ++r) asm volatile("v_mov_b32 %0, %1" : "+v"(negm[r]) : "v"(nm));
    }
}
__device__ __forceinline__ float exp_pack(f32x16& p0, f32x16& p1, bf16x8& pa0, bf16x8& pa1, bf16x8& pa2, bf16x8& pa3) {
#pragma unroll
    for (int r = 0; r < 16; ++r) p0[r] = __builtin_amdgcn_exp2f(p0[r]);
#pragma unroll
    for (int r = 0; r < 16; ++r) p1[r] = __builtin_amdgcn_exp2f(p1[r]);
    SBAR(); asm volatile("s_nop 1" ::: "memory"); SBAR();
#define PK4(P, BASE, OUT) do { u32x4 w = {cvtpk_a(P[BASE + 0], P[BASE + 1]), cvtpk_a(P[BASE + 2], P[BASE + 3]), cvtpk_a(P[BASE + 4], P[BASE + 5]), cvtpk_a(P[BASE + 6], P[BASE + 7])}; \
    OUT = *reinterpret_cast<bf16x8*>(&w); } while (0)
    PK4(p0, 0, pa0); PK4(p0, 8, pa1); PK4(p1, 0, pa2); PK4(p1, 8, pa3);
#undef PK4
    float ps0 = p0[0], ps1 = p1[0];
#pragma unroll
    for (int r = 1; r < 16; ++r) { ps0 += p0[r]; ps1 += p1[r]; }
    float ps = ps0 + ps1;
    { auto rr = __builtin_amdgcn_permlane32_swap(__float_as_uint(ps), __float_as_uint(ps), false, false);
      ps = __uint_as_float(rr[0]) + __uint_as_float(rr[1]); }
    return ps;
}
template <bool MLA> __device__ __forceinline__ void qkt(f32x16& p0, f32x16& p1, const char* Ks, const bf16x8* qr, const f32x16& negm, int r32, int hi) {
    constexpr int NQ = Cfg<MLA>::NQ;
    bf16x8 kf[2 * NQ];
#pragma unroll
    for (int d0 = 0; d0 < NQ; ++d0) { const int cb = (d0 * 16 + hi * 8) * 2;
        kf[2 * d0] = *reinterpret_cast<const bf16x8*>(Ks + kswz<MLA>(r32, cb));
        kf[2 * d0 + 1] = *reinterpret_cast<const bf16x8*>(Ks + kswz<MLA>(32 + r32, cb)); }
    SBAR();
    p0 = negm; p1 = negm;
#pragma unroll
    for (int d0 = 0; d0 < NQ; ++d0) {
        p0 = __builtin_amdgcn_mfma_f32_32x32x16_bf16(kf[2 * d0], qr[d0], p0, 0, 0, 0);
        p1 = __builtin_amdgcn_mfma_f32_32x32x16_bf16(kf[2 * d0 + 1], qr[d0], p1, 0, 0, 0); }
}
template <int NCB> __device__ __forceinline__ int v_st(int k, int c) { const int kk = k;     return ((kk >> 3) * NCB + (c >> 5)) * 512 + ((kk & 7) * 32 + (c & 31)) * 2; }
__device__ __forceinline__ int v_rd_base(int lane) { return ((lane & 3) << 3) | (((lane >> 2) & 3) << 6) | (((lane >> 4) & 1) << 5) | (((lane >> 5) & 1) << 8); }
template <int NCB> constexpr int v_rd_off(int d0, int ks, int half) { return d0 * 512 + (ks * 2 + half) * NCB * 512; }
template <int OFF> __device__ __forceinline__ s16x4 tr_read(int vb) {
    s16x4 r; asm volatile("ds_read_b64_tr_b16 %0, %1 offset:%2" : "=&v"(r) : "v"(vb), "i"(OFF) : "memory"); return r;
}
template <int NCB, int D0> __device__ __forceinline__ void pv_one(f32x16& od, int vb, bf16x8 pa0, bf16x8 pa1, bf16x8 pa2, bf16x8 pa3) {
    const s16x4 l0 = tr_read<v_rd_off<NCB>(D0, 0, 0)>(vb), h0 = tr_read<v_rd_off<NCB>(D0, 0, 1)>(vb), l1 = tr_read<v_rd_off<NCB>(D0, 1, 0)>(vb), h1 = tr_read<v_rd_off<NCB>(D0, 1, 1)>(vb);
    const s16x4 l2 = tr_read<v_rd_off<NCB>(D0, 2, 0)>(vb), h2 = tr_read<v_rd_off<NCB>(D0, 2, 1)>(vb), l3 = tr_read<v_rd_off<NCB>(D0, 3, 0)>(vb), h3 = tr_read<v_rd_off<NCB>(D0, 3, 1)>(vb);
    asm volatile("s_waitcnt lgkmcnt(0)" ::: "memory"); SBAR();
#define PK(L, H) (bf16x8){L[0], L[1], L[2], L[3], H[0], H[1], H[2], H[3]}
    od = __builtin_amdgcn_mfma_f32_32x32x16_bf16(pa0, PK(l0, h0), od, 0, 0, 0);
    od = __builtin_amdgcn_mfma_f32_32x32x16_bf16(pa1, PK(l1, h1), od, 0, 0, 0);
    od = __builtin_amdgcn_mfma_f32_32x32x16_bf16(pa2, PK(l2, h2), od, 0, 0, 0);
    od = __builtin_amdgcn_mfma_f32_32x32x16_bf16(pa3, PK(l3, h3), od, 0, 0, 0);
#undef PK
}
template <int NCB> __device__ __forceinline__ void pv_all(f32x16* o, int vb, bf16x8 pa0, bf16x8 pa1, bf16x8 pa2, bf16x8 pa3) {
    pv_one<NCB, 0>(o[0], vb, pa0, pa1, pa2, pa3); pv_one<NCB, 1>(o[1], vb, pa0, pa1, pa2, pa3);
    if constexpr (NCB == 4) { pv_one<NCB, 2>(o[2], vb, pa0, pa1, pa2, pa3); pv_one<NCB, 3>(o[3], vb, pa0, pa1, pa2, pa3); }
}

template <int NCB, int D0> __device__ __forceinline__ void v_frag_read(s16x4 (&f)[8], int vb) {
    f[0] = tr_read<v_rd_off<NCB>(D0, 0, 0)>(vb); f[1] = tr_read<v_rd_off<NCB>(D0, 0, 1)>(vb); f[2] = tr_read<v_rd_off<NCB>(D0, 1, 0)>(vb); f[3] = tr_read<v_rd_off<NCB>(D0, 1, 1)>(vb);
    f[4] = tr_read<v_rd_off<NCB>(D0, 2, 0)>(vb); f[5] = tr_read<v_rd_off<NCB>(D0, 2, 1)>(vb); f[6] = tr_read<v_rd_off<NCB>(D0, 3, 0)>(vb); f[7] = tr_read<v_rd_off<NCB>(D0, 3, 1)>(vb);
}
__device__ __forceinline__ void pv_mma(f32x16& od, const s16x4 (&f)[8], bf16x8 pa0, bf16x8 pa1, bf16x8 pa2, bf16x8 pa3) {
#define PK(L, H) (bf16x8){L[0], L[1], L[2], L[3], H[0], H[1], H[2], H[3]}
    od = __builtin_amdgcn_mfma_f32_32x32x16_bf16(pa0, PK(f[0], f[1]), od, 0, 0, 0);
    od = __builtin_amdgcn_mfma_f32_32x32x16_bf16(pa1, PK(f[2], f[3]), od, 0, 0, 0);
    od = __builtin_amdgcn_mfma_f32_32x32x16_bf16(pa2, PK(f[4], f[5]), od, 0, 0, 0);
    od = __builtin_amdgcn_mfma_f32_32x32x16_bf16(pa3, PK(f[6], f[7]), od, 0, 0, 0);
#undef PK
}
__device__ __forceinline__ void pv_mma2(f32x16& oa, f32x16& ob, const s16x4 (&f)[8], const s16x4 (&h)[8], bf16x8 pa0, bf16x8 pa1, bf16x8 pa2, bf16x8 pa3) {
#define PK(L, H) (bf16x8){L[0], L[1], L[2], L[3], H[0], H[1], H[2], H[3]}
    oa = __builtin_amdgcn_mfma_f32_32x32x16_bf16(pa0, PK(f[0], f[1]), oa, 0, 0, 0); ob = __builtin_amdgcn_mfma_f32_32x32x16_bf16(pa0, PK(h[0], h[1]), ob, 0, 0, 0);
    oa = __builtin_amdgcn_mfma_f32_32x32x16_bf16(pa1, PK(f[2], f[3]), oa, 0, 0, 0); ob = __builtin_amdgcn_mfma_f32_32x32x16_bf16(pa1, PK(h[2], h[3]), ob, 0, 0, 0);
    oa = __builtin_amdgcn_mfma_f32_32x32x16_bf16(pa2, PK(f[4], f[5]), oa, 0, 0, 0); ob = __builtin_amdgcn_mfma_f32_32x32x16_bf16(pa2, PK(h[4], h[5]), ob, 0, 0, 0);
    oa = __builtin_amdgcn_mfma_f32_32x32x16_bf16(pa3, PK(f[6], f[7]), oa, 0, 0, 0); ob = __builtin_amdgcn_mfma_f32_32x32x16_bf16(pa3, PK(h[6], h[7]), ob, 0, 0, 0);
#undef PK
}
#define LWAIT0() do { SBAR(); asm volatile("s_waitcnt lgkmcnt(0)" ::: "memory"); SBAR(); } while (0)
template <bool MLA>
__device__ __forceinline__ void attn_core(const bf16_t* __restrict__ Qb, const bf16_t* __restrict__ Kh, const bf16_t* __restrict__ Vh, int seq, char* lds,
                                          f32x16 (&o)[Cfg<MLA>::NCB], const int wid  , const int g  ) {
    using CF = Cfg<MLA>;
    constexpr int NQ = CF::NQ, NCB = CF::NCB, SHM_V = CF::SHM_V, SHM_K = CF::SHM_K, LDQ = CF::LDQ, LDK = CF::LDK, LDV = CF::LDV;
    const int lane = lane_id_v(), tid = wid * 64 + lane, r32 = lane & 31, hi = lane >> 5;
    char* V_lds = lds; char* K_lds = lds + 4 * SHM_V;
    float* wsp = (float*)(lds + 93184) + wid * 64; float* li_l = wsp; float* al_l = wsp + 32;
    float m2 = 0.f, l_reg = 0.f; f32x16 negm = f32x16{}; bf16x8 qr[NQ];
#pragma unroll
    for (int d = 0; d < NCB; ++d) o[d] = f32x16{};
    const bf16_t* Qw = Qb + (long)(wid * 32 + r32) * LDQ + hi * 8;
#pragma unroll
    for (int d0 = 0; d0 < NQ; ++d0) qr[d0] = *reinterpret_cast<const bf16x8*>(Qw + d0 * 16);
    const int vr0 = MLA ? (tid >> 3) : (tid >> 4), vc0 = MLA ? (tid & 7) * 8 : (tid & 15) * 8;
    const int vst0 = v_st<NCB>(vr0, vc0), vst1 = v_st<NCB>(32 + vr0, vc0);
    const int kcA = tid, krA = MLA ? (kcA / 12) : (tid >> 3), kcolA = MLA ? (kcA % 12) * 8 : (tid & 7) * 8;
    const int kcB = 512 + (tid & 255), krB = kcB / 12, kcolB = (kcB % 12) * 8;
    const int kstA = kswz<MLA>(krA, kcolA * 2), kstB = kswz<MLA>(krB, kcolB * 2);
    const int vb0 = (int)(uintptr_t)V_lds + v_rd_base(lane);
    struct { bf16x8 a, b, c; } sr_[2];
    const unsigned goA = MLA ? (unsigned)(vr0 * LDV + vc0) * 2u : (unsigned)(vr0 * LDV + vc0) * 2u;
    const unsigned goB = MLA ? (unsigned)(krA * LDK + kcolA) * 2u : (unsigned)((32 + vr0) * LDV + vc0) * 2u;
    const unsigned goC = MLA ? (unsigned)(krB * LDK + kcolB) * 2u : (unsigned)(krA * LDK + kcolA) * 2u;
#define SLOAD(i, k0) do { const char* kt_ = (const char*)(Kh + (size_t)(k0) * LDK); const char* vt_ = (const char*)(Vh + (size_t)(k0) * LDV); \
    if constexpr (MLA) { \
        sr_[i].a = *reinterpret_cast<const bf16x8*>(vt_ + goA); sr_[i].b = *reinterpret_cast<const bf16x8*>(kt_ + goB); sr_[i].c = *reinterpret_cast<const bf16x8*>(kt_ + goC); \
    } else { \
        sr_[i].a = *reinterpret_cast<const bf16x8*>(vt_ + goA); sr_[i].b = *reinterpret_cast<const bf16x8*>(vt_ + goB); sr_[i].c = *reinterpret_cast<const bf16x8*>(kt_ + goC); } } while (0)
#define SWRITE(ko, vo, i) do { if constexpr (MLA) { \
        *(bf16x8*)(V_lds + (vo) + vst0) = sr_[i].a; \
        *(bf16x8*)(K_lds + (ko) + kstA) = sr_[i].b; \
        if (wid < 4) *(bf16x8*)(K_lds + (ko) + kstB) = sr_[i].c; \
    } else { \
        *(bf16x8*)(V_lds + (vo) + vst0) = sr_[i].a; \
        *(bf16x8*)(V_lds + (vo) + vst1) = sr_[i].b; \
        *(bf16x8*)(K_lds + (ko) + kstA) = sr_[i].c; } } while (0)
#define SWAIT() asm volatile("s_waitcnt vmcnt(3)" ::: "memory")
#define RESC(a) do { if (__any((a) < 1.f)) { if (hi == 0) al_l[r32] = (a); asm volatile("s_waitcnt lgkmcnt(0)" ::: "memory"); \
    _Pragma("unroll") for (int r = 0; r < 16; ++r) { const float al_ = al_l[crow(r, hi)]; _Pragma("unroll") for (int d = 0; d < NCB; ++d) o[d][r] *= al_; } } } while (0)
    f32x16 S0, S1; float alpha = 1.f; bf16x8 pa0, pa1, pa2, pa3; const int NT = seq / 64;
    constexpr int SE = 0, SO = 1;
#define TOUCH(x) asm volatile("" : "+v"(x))
#define MSEG(j) do { const int j_ = (j); const bool doqk = j_ < NT, dopv = j_ > 0; \
        const char* Ks_ = K_lds + (j_ % 3) * SHM_K; const int vb_ = vb0 + ((j_ - 1) & 3) * SHM_V; \
        bf16x8 kf[2 * NQ]; s16x4 fa[8], fb[8]; \
        if (doqk) { _Pragma("unroll") for (int d0 = 0; d0 < NQ; ++d0) { const int cb = (d0 * 16 + hi * 8) * 2; \
            kf[2 * d0] = *reinterpret_cast<const bf16x8*>(Ks_ + kswz<MLA>(r32, cb)); kf[2 * d0 + 1] = *reinterpret_cast<const bf16x8*>(Ks_ + kswz<MLA>(32 + r32, cb)); } \
            SBAR(); S0 = negm; S1 = negm; \
            _Pragma("unroll") for (int d0 = 0; d0 < NQ / 2; ++d0) { \
                S0 = __builtin_amdgcn_mfma_f32_32x32x16_bf16(kf[2 * d0], qr[d0], S0, 0, 0, 0); S1 = __builtin_amdgcn_mfma_f32_32x32x16_bf16(kf[2 * d0 + 1], qr[d0], S1, 0, 0, 0); SBAR(); } \
            _Pragma("unroll") for (int i_ = NQ; i_ < 2 * NQ; ++i_) asm volatile("" : "+v"(kf[i_]) : "v"(S0), "v"(S1));     \
        } \
        SBAR(); \
        if (dopv) { v_frag_read<NCB, 0>(fa, vb_); if constexpr (NCB == 2) v_frag_read<NCB, 1>(fb, vb_); }     \
        if (doqk) { _Pragma("unroll") for (int i_ = NQ; i_ < 2 * NQ; ++i_) TOUCH(kf[i_]); }     \
        SBAR(); \
        if (doqk) { _Pragma("unroll") for (int d0 = NQ / 2; d0 < NQ; ++d0) { \
            S0 = __builtin_amdgcn_mfma_f32_32x32x16_bf16(kf[2 * d0], qr[d0], S0, 0, 0, 0); S1 = __builtin_amdgcn_mfma_f32_32x32x16_bf16(kf[2 * d0 + 1], qr[d0], S1, 0, 0, 0); SBAR(); } } \
        if (dopv) { if constexpr (NCB == 4) { SBAR(); v_frag_read<NCB, 1>(fb, vb_); }     \
            LWAIT0(); \
            if constexpr (NCB == 4) { pv_mma2(o[0], o[1], fa, fb, pa0, pa1, pa2, pa3); SBAR(); v_frag_read<NCB, 2>(fa, vb_); v_frag_read<NCB, 3>(fb, vb_); \
                LWAIT0(); pv_mma2(o[2], o[NCB - 1], fa, fb, pa0, pa1, pa2, pa3); } \
            else { pv_mma2(o[0], o[1], fa, fb, pa0, pa1, pa2, pa3); } } } while (0)
#define VSEG(j) do { rowmax_adjust(S0, S1, m2, negm, alpha, (j) == 0); RESC(alpha); l_reg = l_reg * alpha + exp_pack(S0, S1, pa0, pa1, pa2, pa3); } while (0)
    __syncthreads();
    SLOAD(SE, 0); SLOAD(SO, 64); asm volatile("s_waitcnt vmcnt(0)" ::: "memory");
    SWRITE(0, 0, SE); SWRITE(SHM_K, SHM_V, SO);
    SLOAD(SE, 2 * 64); SLOAD(SO, 3 * 64);
    __syncthreads();
    { int g_ = g; asm volatile("" : "+s"(g_)); if (g_ == 1) __syncthreads(); }
    for (int j = 0; j < NT; j += 2) {
        SBAR(); MSEG(j); SBAR();
        __syncthreads();
        SBAR(); VSEG(j);
        SWAIT(); if (j + 2 < NT) SWRITE(((j + 2) % 3) * SHM_K, ((j + 2) & 3) * SHM_V, SE);
        if (!(MLA && PROBE_NOLOAD)) { const int tn = (j + 4 < NT) ? j + 4 : NT - 1; SLOAD(SE, tn * 64); } SBAR();
        __syncthreads();
        SBAR(); MSEG(j + 1); SBAR();
        __syncthreads();
        SBAR(); VSEG(j + 1);
        SWAIT(); if (j + 3 < NT) SWRITE(((j + 3) % 3) * SHM_K, ((j + 3) & 3) * SHM_V, SO);
        if (!(MLA && PROBE_NOLOAD)) { const int tn = (j + 5 < NT) ? j + 5 : NT - 1; SLOAD(SO, tn * 64); } SBAR();
        __syncthreads();
    }
    SBAR(); MSEG(NT); SBAR();
    { int g_ = g; asm volatile("" : "+s"(g_)); if (g_ == 0) __syncthreads(); }
#undef MSEG
#undef TOUCH
#undef VSEG
    asm volatile("s_waitcnt vmcnt(0)" ::: "memory");
    if (hi == 0) li_l[r32] = l_reg; asm volatile("s_waitcnt lgkmcnt(0)" ::: "memory");
#pragma unroll
    for (int r = 0; r < 16; ++r) { const float rl = __builtin_amdgcn_rcpf(li_l[crow(r, hi)]);
#pragma unroll
        for (int d = 0; d < NCB; ++d) o[d][r] *= rl; }
#undef SLOAD
#undef SWRITE
#undef SWAIT
#undef RESC
}
}
typedef float2 cs_t;
__device__ __forceinline__ void store8(bf16_t* p, f32x4 v0, f32x4 v1) {
    u32x4 w; w.x = cvtpk(v0[0], v0[1]); w.y = cvtpk(v0[2], v0[3]); w.z = cvtpk(v1[0], v1[1]); w.w = cvtpk(v1[2], v1[3]);
    *(u32x4*)p = w;
}
__device__ __forceinline__ float dot8(f32x4 v0, f32x4 v1) { return (v0[0] * v0[0] + v0[1] * v0[1]) + (v0[2] * v0[2] + v0[3] * v0[3]) + (v1[0] * v1[0] + v1[1] * v1[1]) + (v1[2] * v1[2] + v1[3] * v1[3]); }
__device__ __forceinline__ void rope64(f32x4& v0, f32x4& v1, const cs_t* __restrict__ CS16, int gr, int gc, int wc, int fq, bool apply) {
    f32x4 p0, p1; const int ix = (lane_id_v() ^ 32) << 2;
#pragma unroll
    for (int j = 0; j < 4; ++j) { p0[j] = shfli(v0[j], ix); p1[j] = shfli(v1[j], ix); }
    if (apply) {
        const int pos = (wc & 1) ? gc : gr; const cs_t* t = CS16 + pos * 16 + 8 * (fq & 1);
        const float sg = (fq < 2) ? -1.f : 1.f;
#pragma unroll
        for (int j = 0; j < 4; ++j) { const cs_t a = t[j], b = t[4 + j];
            v0[j] = v0[j] * a.x + sg * p0[j] * a.y; v1[j] = v1[j] * b.x + sg * p1[j] * b.y; }
    }
}
__device__ __forceinline__ void rope32(f32x4& v0, f32x4& v1, const cs_t* __restrict__ CS8, int gr, int gc, int g, bool apply) {
    f32x4 p0, p1; const int ix = (lane_id_v() ^ 16) << 2;
#pragma unroll
    for (int j = 0; j < 4; ++j) { p0[j] = shfli(v0[j], ix); p1[j] = shfli(v1[j], ix); }
    if (apply) {
        const int pos = (g >= 2) ? gc : gr; const cs_t* t = CS8 + pos * 8;
        const float sg = (g & 1) ? 1.f : -1.f;
#pragma unroll
        for (int j = 0; j < 4; ++j) { const cs_t a = t[j], b = t[4 + j];
            v0[j] = v0[j] * a.x + sg * p0[j] * a.y; v1[j] = v1[j] * b.x + sg * p1[j] * b.y; }
    }
}
#define EPI_ARGS const pg8::f32x4 (&acc)[2][2][4][2], const pg8::Unit& u, int wr, int wc, int fr, int fq
#define EPI_RECOMPUTE { const int l_ = lane_id_v(); fr = l_ & 15; fq = l_ >> 4; }

struct EpiP1 {
    static constexpr bool PERM = true, AFTER_DRAIN = false;
    bf16_t *CKV, *CQ, *KMLA, *GA, *DQ, *DK, *DV, *GD, *MG; float *SSKV, *SSQ; const cs_t *CS16, *CS8; bool do_stats;
    __device__ __forceinline__ void operator()(EPI_ARGS) const {
        EPI_RECOMPUTE
        const int pm = u.pm, pn = u.pn; const bool lat = pm < 256;
        if (!lat && !(pn == 0 || pn == 2 || (pn >= 7 && pn <= 10))) return;
        const int row0 = pm * 256 + wr * 64 + fr;
        const int kv0 = (lat ? (pm >> 5) * SKV + CTX + (pm & 31) * 256 : (pm - 256) * SKV) + wr * 64 + fr;
        const int lcw = wc * 32 + 8 * fq;
#pragma unroll
        for (int ai = 0; ai < 2; ++ai)
#pragma unroll
            for (int m = 0; m < 4; ++m) {
                __builtin_amdgcn_sched_barrier(0); const int row = opq(row0 + ai * 128 + m * 16), kvrow = kv0 + (row - row0);
                const int s = row & (SEQ - 1), gr = s >> 6, gc = s & 63;
                float ssq = 0.f;
#pragma unroll
                for (int bj = 0; bj < 2; ++bj) {
                    f32x4 v0 = acc[ai][bj][m][0], v1 = acc[ai][bj][m][1]; const int lc = bj * 128 + lcw;
                    if (pn == 0) { ssq += dot8(v0, v1); store8(CKV + (size_t)kvrow * 256 + lc, v0, v1); }
                    else if (pn == 1) { ssq += dot8(v0, v1); store8(CQ + (size_t)row * 384 + lc, v0, v1); }
                    else if (pn == 2) {
                        if (bj == 0) { if (lat) { ssq += dot8(v0, v1); store8(CQ + (size_t)row * 384 + 256 + lc, v0, v1); } }
                        else if (wc == 0) { rope32(v0, v1, CS8, gr, gc, fq, lat);
#pragma unroll
                            for (int h = 0; h < 8; ++h) store8(KMLA + (size_t)kvrow * 768 + h * 96 + 64 + 8 * fq, v0, v1); }
                    }
                    else if (pn <= 4 || pn == 11 || pn == 12) {
#pragma unroll
                        for (int j = 0; j < 4; ++j) { v0[j] = v0[j] * sigmoid_fast(v0[j]); v1[j] = v1[j] * sigmoid_fast(v1[j]); }
                        bf16_t* dst = (pn <= 4) ? GA + (size_t)row * 512 + (pn - 3) * 256 + lc : GD + (size_t)row * 512 + (pn - 11) * 256 + lc;
                        store8(dst, v0, v1);
                    }
                    else if (pn <= 6) { v0 = v0 * 0.18033688011112042f; v1 = v1 * 0.18033688011112042f;
                        rope64(v0, v1, CS16, gr, gc, wc, fq, true); store8(DQ + (size_t)row * 512 + (pn - 5) * 256 + lc, v0, v1); }
                    else if (pn <= 8) { rope64(v0, v1, CS16, gr, gc, wc, fq, lat); store8(DK + (size_t)kvrow * 512 + (pn - 7) * 256 + lc, v0, v1); }
                    else if (pn <= 10) { store8(DV + (size_t)kvrow * 512 + (pn - 9) * 256 + lc, v0, v1); }
                    else {
#pragma unroll
                        for (int j = 0; j < 4; ++j) { v0[j] = sigmoid_fast(v0[j]); v1[j] = sigmoid_fast(v1[j]); }
                        store8(MG + (size_t)row * 2048 + (pn - 13) * 256 + lc, v0, v1);
                    }
                }
                if (pn <= 2) {
                    ssq += shflx(ssq, 16); ssq += shflx(ssq, 32);
                    if (fq == 0) { if (pn == 0) SSKV[(size_t)kvrow * 4 + wc] = ssq; else if (lat) SSQ[(size_t)row * 8 + (pn - 1) * 4 + wc] = ssq; }
                }
            }
    }
};
struct EpiQ {
    static constexpr bool PERM = true, AFTER_DRAIN = false;
    bf16_t* QMLA; const float* SSQ; const cs_t* CS8;
    __device__ __forceinline__ void operator()(EPI_ARGS) const {
        EPI_RECOMPUTE
        const int row0 = u.pm * 256 + wr * 64 + fr;
#pragma unroll
        for (int ai = 0; ai < 2; ++ai)
#pragma unroll
            for (int m = 0; m < 4; ++m) {
                __builtin_amdgcn_sched_barrier(0); const int row = opq(row0 + ai * 128 + m * 16); const int s = row & (SEQ - 1), gr = s >> 6, gc = s & 63;
                const f32x4 sa = *(const f32x4*)(SSQ + (size_t)row * 8), sb = *(const f32x4*)(SSQ + (size_t)row * 8 + 4);
                const float rs = 0.14724445f / sqrtf((((sa[0] + sa[1]) + (sa[2] + sa[3])) + ((sb[0] + sb[1]) + (sb[2] + sb[3]))) * (1.f / 384.f) + 1e-6f);
#pragma unroll
                for (int bj = 0; bj < 2; ++bj) {
                    f32x4 v0 = acc[ai][bj][m][0] * rs, v1 = acc[ai][bj][m][1] * rs;
                    const int c0 = u.pn * 256 + bj * 128 + wc * 32 + 8 * fq, d = c0 % 96;
                    rope32(v0, v1, CS8, gr, gc, (d - 64) >> 3, d >= 64);
                    store8(QMLA + (size_t)row * 768 + c0, v0, v1);
                }
            }
    }
};
struct EpiKV {
    static constexpr bool PERM = true, AFTER_DRAIN = false;
    bf16_t *KMLA, *VMLA; const float* SSKV;
    __device__ __forceinline__ void operator()(EPI_ARGS) const {
        EPI_RECOMPUTE
        const int row0 = u.pm * 256 + wr * 64 + fr;
#pragma unroll
        for (int ai = 0; ai < 2; ++ai)
#pragma unroll
            for (int m = 0; m < 4; ++m) {
                __builtin_amdgcn_sched_barrier(0); const int row = opq(row0 + ai * 128 + m * 16);
                const f32x4 sa = *(const f32x4*)(SSKV + (size_t)row * 4);
                const float rs = 1.f / sqrtf(((sa[0] + sa[1]) + (sa[2] + sa[3])) * (1.f / 256.f) + 1e-6f);
#pragma unroll
                for (int bj = 0; bj < 2; ++bj) {
                    const f32x4 v0 = acc[ai][bj][m][0] * rs, v1 = acc[ai][bj][m][1] * rs;
                    const int h = u.pn * 2 + bj, d = wc * 32 + 8 * fq;
                    if (wc < 2) store8(KMLA + (size_t)row * 768 + h * 96 + d, v0, v1);
                    else store8(VMLA + (size_t)row * 512 + h * 64 + (d - 64), v0, v1);
                }
            }
    }
};
template <bool ACCUM> struct EpiZ {
    static constexpr bool PERM = true, AFTER_DRAIN = false;
    bf16_t* Z; const bf16_t* MG;
    __device__ __forceinline__ void operator()(EPI_ARGS) const {
        EPI_RECOMPUTE
        const int row0 = u.pm * 256 + wr * 64 + fr;
#pragma unroll
        for (int ai = 0; ai < 2; ++ai)
#pragma unroll
            for (int m = 0; m < 4; ++m) {
                __builtin_amdgcn_sched_barrier(0); const int row = opq(row0 + ai * 128 + m * 16);
#pragma unroll
                for (int bj = 0; bj < 2; ++bj) {
                    f32x4 v0 = acc[ai][bj][m][0], v1 = acc[ai][bj][m][1];
                    const int c0 = u.pn * 256 + bj * 128 + wc * 32 + 8 * fq;
                    const u32x4 g = *(const u32x4*)(MG + (size_t)row * 2048 + c0);
                    v0[0] *= bflo(g.x); v0[1] *= bfhi(g.x); v0[2] *= bflo(g.y); v0[3] *= bfhi(g.y);
                    v1[0] *= bflo(g.z); v1[1] *= bfhi(g.z); v1[2] *= bflo(g.w); v1[3] *= bfhi(g.w);
                    bf16_t* zp = Z + (size_t)row * 1024 + c0;
                    if (ACCUM) { const u32x4 z = *(const u32x4*)zp;
                        v0[0] += bflo(z.x); v0[1] += bfhi(z.x); v0[2] += bflo(z.y); v0[3] += bfhi(z.y);
                        v1[0] += bflo(z.z); v1[1] += bfhi(z.z); v1[2] += bflo(z.w); v1[3] += bfhi(z.w); }
                    store8(zp, v0, v1);
                }
            }
    }
};
struct EpiOut {
    static constexpr bool PERM = true, AFTER_DRAIN = false;
    float* OUT; const float* X; const float* MOD;
    __device__ __forceinline__ void operator()(EPI_ARGS) const {
        EPI_RECOMPUTE
        const int row0 = u.pm * 256 + wr * 64 + fr; const float ALPHA = 1.189207115002721f;
        const float* gate = MOD + (size_t)(u.pm >> 5) * 3072 + 2048;
#pragma unroll
        for (int ai = 0; ai < 2; ++ai)
#pragma unroll
            for (int m = 0; m < 4; ++m) {
                __builtin_amdgcn_sched_barrier(0); const int row = opq(row0 + ai * 128 + m * 16);
#pragma unroll
                for (int bj = 0; bj < 2; ++bj) {
                    const int c0 = u.pn * 256 + bj * 128 + wc * 32 + 8 * fq;
                    const f32x4 x0 = *(const f32x4*)(X + (size_t)row * 1024 + c0), x1 = *(const f32x4*)(X + (size_t)row * 1024 + c0 + 4);
                    const f32x4 g0 = *(const f32x4*)(gate + c0), g1 = *(const f32x4*)(gate + c0 + 4);
                    *(f32x4*)(OUT + (size_t)row * 1024 + c0) = x0 * ALPHA + g0 * acc[ai][bj][m][0];
                    *(f32x4*)(OUT + (size_t)row * 1024 + c0 + 4) = x1 * ALPHA + g1 * acc[ai][bj][m][1];
                }
            }
    }
};
constexpr size_t MiB = 1u << 20;
constexpr size_t WS_BAR = 0, CTL_ZERO_BYTES = 16384;
constexpr size_t WS_SSKV = 0, WS_SSQ = 512 * 1024;
constexpr size_t WS_MOD = 1 * MiB, WS_CS16 = 1 * MiB + 128 * 1024, WS_CS8 = 1 * MiB + 192 * 1024;
constexpr size_t WS_WIN = 2 * MiB, WS_WUQ = 13 * MiB, WS_WUKV = 14 * MiB, WS_WOA = 15 * MiB, WS_WOB = 16 * MiB, WS_WOUT = 17 * MiB;
constexpr size_t WS_HBF = 32 * MiB;
constexpr size_t WS_VMLA = WS_HBF, WS_Z = WS_HBF;
constexpr size_t WS_KMLA = 164 * MiB;
constexpr size_t WS_GA = 263 * MiB;
constexpr size_t WS_DQ = 327 * MiB;
constexpr size_t WS_DK = 391 * MiB;
constexpr size_t WS_DV = 457 * MiB;
constexpr size_t WS_GD = 523 * MiB;
constexpr size_t WS_MG = 587 * MiB;
constexpr size_t WS_QMLA = 843 * MiB;
constexpr size_t WS_SSKVP = 939 * MiB, WS_SSQP = 941 * MiB;
constexpr size_t WS_END = 944 * MiB;
constexpr size_t OUT_XA = 96 * MiB, OUT_XD = 160 * MiB;
constexpr size_t OUT_CKV = 0, OUT_CQ = 33 * MiB;
constexpr int LDS_BYTES = 160832;

struct Args {
    const float *x, *c, *ctx, *c_ctx, *w_mod, *b_mod, *w_in, *q_norm, *kv_norm, *w_uq, *w_ukv, *dlam, *subln, *w_oa, *w_ob, *w_out, *ln_g, *ln_b;
    float* out; unsigned char* ws;
};

__device__ __forceinline__ void tr_item(const float* __restrict__ W, int K, int N, int srcn0, const float* __restrict__ ksc, bf16_t* WT, int dstn0, int k0, float* scr, int lane) {
#pragma unroll 8
    for (int i = 0; i < 32; ++i) { const int kk = 2 * i + (lane >> 5);
        float v = 0.f; if (srcn0 >= 0) { v = W[(size_t)(k0 + kk) * N + srcn0 + (lane & 31)]; if (ksc) v *= ksc[k0 + kk]; }
        scr[kk * 33 + (lane & 31)] = v; }
    asm volatile("s_waitcnt lgkmcnt(0)" ::: "memory");
    const int c = lane & 7;
#pragma unroll
    for (int j = 0; j < 4; ++j) { const int n = (lane >> 3) + 8 * j; const float* s = scr + (8 * c) * 33 + n;
        u32x4 o; o.x = cvtpk(s[0 * 33], s[1 * 33]); o.y = cvtpk(s[2 * 33], s[3 * 33]); o.z = cvtpk(s[4 * 33], s[5 * 33]); o.w = cvtpk(s[6 * 33], s[7 * 33]);
        *(u32x4*)(WT + (size_t)(dstn0 + n) * K + k0 + 8 * c) = o; }
    asm volatile("s_waitcnt lgkmcnt(0)" ::: "memory");
}

#define XB_TMO      128
#define XB_XCNT(j)  (256  + 64 * (j))
#define XB_XSUB(j)  (1280 + 64 * (j))
#define XB_XGEN(j)  (2304 + 64 * (j))
#define XB_TOP      3328
#define XB_TOPGEN   3392
#define XCD_BAR_WORDS 3456
#define XB_SPIN_CAP (1u << 18)

__device__ __forceinline__ unsigned xb_ld(unsigned* p)              { return __hip_atomic_load(p, __ATOMIC_RELAXED, __HIP_MEMORY_SCOPE_AGENT); }
__device__ __forceinline__ unsigned xb_add(unsigned* p, unsigned v) { return __hip_atomic_fetch_add(p, v, __ATOMIC_RELAXED, __HIP_MEMORY_SCOPE_AGENT); }
__device__ __forceinline__ unsigned xb_xcc_id() { return (unsigned)__builtin_amdgcn_s_getreg((3 << 11) | 20) & 0xFu; }
#define XB_SPIN(cond, bar) do { unsigned _sp = 0; while (cond) { __builtin_amdgcn_s_sleep(1); \
    if ((++_sp & 255u) == 0u) { if (xb_ld(&(bar)[XB_TMO])) break; if (_sp > XB_SPIN_CAP) { atomicAdd(&(bar)[XB_TMO], 1u); break; } } } } while (0)

struct XcdBarrier {
    unsigned* bar; unsigned x;
    volatile LAS unsigned* st;
};

__device__ __forceinline__ XcdBarrier xcd_barrier_post(unsigned* bar, volatile LAS unsigned* st) {
    XcdBarrier b; b.bar = bar; b.x = xb_xcc_id(); b.st = st;
    if (threadIdx.x == 0) (void)xb_add(&bar[XB_XCNT(b.x)], 1u);
    return b;
}
__device__ __forceinline__ void xcd_barrier_complete(unsigned* bar, unsigned x, unsigned& nloc, unsigned& nx) {
    const unsigned G = gridDim.x * gridDim.y * gridDim.z;
    unsigned sum, cnt, mine, sp = 0u;
    for (;;) {
        sum = 0u; cnt = 0u; mine = 0u;
#pragma unroll
        for (unsigned j = 0; j < 16; ++j) { const unsigned c = xb_ld(&bar[XB_XCNT(j)]); sum += c; cnt += (c > 0u) ? 1u : 0u; mine = (j == x) ? c : mine; }
        if (sum == G) break;
        __builtin_amdgcn_s_sleep(1);
        if ((++sp & 255u) == 0u) { if (xb_ld(&bar[XB_TMO])) break; if (sp > XB_SPIN_CAP) { atomicAdd(&bar[XB_TMO], 1u); break; } }
    }
    nloc = mine > 0u ? mine : 1u; nx = cnt > 0u ? cnt : 1u;
}

__device__ __forceinline__ void xcd_barrier(const XcdBarrier& b) {
    asm volatile("s_waitcnt vmcnt(0)" ::: "memory");
    __syncthreads();
    if (threadIdx.x == 0) {
        unsigned* bar = b.bar;
        __builtin_amdgcn_s_waitcnt(0);
        unsigned nloc = b.st[0], nx = b.st[1];
        if (nloc == 0u) { xcd_barrier_complete(bar, b.x, nloc, nx); b.st[0] = nloc; b.st[1] = nx; }
        const unsigned old = xb_add(&bar[XB_XSUB(b.x)], 1u);
        const unsigned gen = old / nloc;
        if (old + 1u == (gen + 1u) * nloc) {
            __builtin_amdgcn_fence(__ATOMIC_RELEASE, "agent");
            asm volatile("s_waitcnt vmcnt(0)" ::: "memory");
            const unsigned og = xb_add(&bar[XB_TOP], 1u);
            const unsigned tg = og / nx;
            if (og + 1u == (tg + 1u) * nx) xb_add(&bar[XB_TOPGEN], 1u);
            else XB_SPIN(xb_ld(&bar[XB_TOPGEN]) == tg, bar);
            __builtin_amdgcn_fence(__ATOMIC_ACQUIRE, "agent");
            xb_add(&bar[XB_XGEN(b.x)], 1u);
            asm volatile("s_waitcnt vmcnt(0)" ::: "memory");
        } else {
            XB_SPIN(xb_ld(&bar[XB_XGEN(b.x)]) == gen, bar);
            __builtin_amdgcn_fence(__ATOMIC_ACQUIRE, "agent");
            asm volatile("s_waitcnt vmcnt(0)" ::: "memory");
        }
    }
    __syncthreads();
}

__global__ void __launch_bounds__(512, 2) fwd_mega(Args a) {
    extern __shared__ __attribute__((aligned(16))) unsigned char lds[];
    cg::grid_group grid = cg::this_grid();
    const int wave = __builtin_amdgcn_readfirstlane((int)threadIdx.x >> 6);
#define LANE_TID const int lane = lane_id_v(), tid = wave * 64 + lane; (void)tid; (void)lane;
    const int G = gridDim.x, bid = blockIdx.x;
    const int gw = bid * 8 + wave, NGW = G * 8;
    unsigned char* ws = a.ws; unsigned char* ob = (unsigned char*)a.out;
    float* SSKV = (float*)(ws + WS_SSKVP); float* SSQ = (float*)(ws + WS_SSQP); float* MOD = (float*)(ws + WS_MOD);
    cs_t* CS16 = (cs_t*)(ws + WS_CS16); cs_t* CS8 = (cs_t*)(ws + WS_CS8);
    bf16_t* WIN = (bf16_t*)(ws + WS_WIN); bf16_t* WUQ = (bf16_t*)(ws + WS_WUQ); bf16_t* WUKV = (bf16_t*)(ws + WS_WUKV);
    bf16_t* WOA = (bf16_t*)(ws + WS_WOA); bf16_t* WOB = (bf16_t*)(ws + WS_WOB); bf16_t* WOUT = (bf16_t*)(ws + WS_WOUT);
    bf16_t* HBF = (bf16_t*)(ws + WS_HBF); bf16_t* VMLA = (bf16_t*)(ws + WS_VMLA); bf16_t* Z = (bf16_t*)(ws + WS_Z);
    bf16_t* KMLA = (bf16_t*)(ws + WS_KMLA); bf16_t* GA = (bf16_t*)(ws + WS_GA); bf16_t* DQ = (bf16_t*)(ws + WS_DQ); bf16_t* DK = (bf16_t*)(ws + WS_DK);
    bf16_t* DV = (bf16_t*)(ws + WS_DV); bf16_t* GD = (bf16_t*)(ws + WS_GD); bf16_t* MG = (bf16_t*)(ws + WS_MG); bf16_t* QMLA = (bf16_t*)(ws + WS_QMLA);
    bf16_t* CKV = (bf16_t*)(ob + OUT_CKV); bf16_t* CQ = (bf16_t*)(ob + OUT_CQ); bf16_t* XA = (bf16_t*)(ob + OUT_XA); bf16_t* XD = (bf16_t*)(ob + OUT_XD);
    PG8_LAS unsigned char* ldsp = (PG8_LAS unsigned char*)lds;
    { volatile LAS unsigned* stz = (volatile LAS unsigned*)(lds + 160768); if (threadIdx.x < 16) stz[threadIdx.x] = 0u; }
    __syncthreads();
    const XcdBarrier xbar = xcd_barrier_post((unsigned*)(ws + WS_BAR), (volatile LAS unsigned*)(lds + 160768));

#ifndef REP1
#define REP1 1
#endif
#ifndef REP2
#define REP2 1
#endif
#ifndef REP3A
#define REP3A 0
#endif
#ifndef REP3D
#define REP3D 0
#endif
#ifndef REP4A
#define REP4A 1
#endif
#ifndef REP4B
#define REP4B 1
#endif
#ifndef PHMASK
#define PHMASK 0xfff
#endif
    if (PHMASK & (1 << 0)) {
        LANE_TID
        float* A = (float*)lds; float* red = (float*)(lds + 36864);
        for (int cb = bid; cb < 96; cb += G) {
            __syncthreads();
            for (int i = tid; i < 9 * 1024; i += 512) { const int r = i >> 10, k = i & 1023; const float v = r < 8 ? a.c[r * 1024 + k] : a.c_ctx[k]; A[i] = v * sigmoidf_(v); }
            __syncthreads();
            const int cl = tid & 31, col = cb * 32 + cl, kq = tid >> 5;
            float acc[9];
#pragma unroll
            for (int r = 0; r < 9; ++r) acc[r] = 0.f;
#pragma unroll 4
            for (int kk = 0; kk < 64; ++kk) { const int k = kq * 64 + kk; const float w = a.w_mod[(size_t)k * 3072 + col];
#pragma unroll
                for (int r = 0; r < 9; ++r) acc[r] += A[r * 1024 + k] * w; }
#pragma unroll
            for (int r = 0; r < 9; ++r) red[(kq * 9 + r) * 32 + cl] = acc[r];
            __syncthreads();
            if (tid < 288) { const int r = tid >> 5; float s = 0.f;
                for (int q = 0; q < 16; ++q) s += red[(q * 9 + r) * 32 + cl];
                MOD[r * 3072 + col] = s + a.b_mod[col]; }
        }
        __syncthreads();
        float* scr = (float*)lds + wave * (64 * 33);
        constexpr int I_IN = 16 * 168, I_UQ = 6 * 24, I_UKV = 4 * 32, I_OA = 8 * 32, I_OB = 8 * 32, I_OUT = 16 * 32;
        constexpr int NITEMS = I_IN + I_UQ + I_UKV + I_OA + I_OB + I_OUT;
        for (int it = gw; it < NITEMS; it += NGW) {
            int r = it;
            if (r < I_IN) { const int kb = r / 168, nb = r % 168, d0 = nb * 32;
                const int s0 = d0 < 256 ? 384 + d0 : d0 < 640 ? d0 - 256 : d0 < 672 ? d0 : d0 < 768 ? -1 : d0 - 96;
                tr_item(a.w_in, 1024, 5280, s0, nullptr, WIN, d0, kb * 64, scr, lane); continue; } r -= I_IN;
            if (r < I_UQ) { tr_item(a.w_uq, 384, 768, (r % 24) * 32, a.q_norm, WUQ, (r % 24) * 32, (r / 24) * 64, scr, lane); continue; } r -= I_UQ;
            if (r < I_UKV) { tr_item(a.w_ukv, 256, 1024, (r % 32) * 32, a.kv_norm, WUKV, (r % 32) * 32, (r / 32) * 64, scr, lane); continue; } r -= I_UKV;
            if (r < I_OA) { tr_item(a.w_oa, 512, 1024, (r % 32) * 32, nullptr, WOA, (r % 32) * 32, (r / 32) * 64, scr, lane); continue; } r -= I_OA;
            if (r < I_OB) { tr_item(a.w_ob, 512, 1024, (r % 32) * 32, nullptr, WOB, (r % 32) * 32, (r / 32) * 64, scr, lane); continue; } r -= I_OB;
            tr_item(a.w_out, 1024, 1024, (r % 32) * 32, nullptr, WOUT, (r % 32) * 32, (r / 32) * 64, scr, lane);
        }
        if (bid == G - 1) {
            for (int i = tid; i < 128 * 16; i += 512) { const int pos = i >> 4, f = i & 15; const float inv = powf(10000.f, -(float)f / 16.f), ang = (float)pos * inv; CS16[i] = make_float2(cosf(ang), sinf(ang)); }
            for (int i = tid; i < 128 * 8; i += 512) { const int pos = i >> 3, f = i & 7; const float inv = powf(10000.f, -(float)f / 8.f), ang = (float)pos * inv; CS8[i] = make_float2(cosf(ang), sinf(ang)); }
        }
    }
    grid.sync();

    if (PHMASK & (1 << 1)) for (int m = gw; m < MALL; m += NGW) {
        LANE_TID
        const float* src; const float* mod;
        if (m < MLAT) { src = a.x + (size_t)m * 1024; mod = MOD + (size_t)(m >> 13) * 3072; } else { src = a.ctx + (size_t)(m - MLAT) * 1024; mod = MOD + 8 * 3072; }
#pragma unroll
        for (int j = 0; j < 4; ++j) { const int c4 = lane + 64 * j;
            const f32x4 v = ((const f32x4*)src)[c4], sh = ((const f32x4*)mod)[c4], sc = ((const f32x4*)(mod + 1024))[c4];
            const f32x4 h = v * (sc + 1.f) + sh; u32x2 w; w.x = cvtpk(h[0], h[1]); w.y = cvtpk(h[2], h[3]);
            *(u32x2*)(HBF + (size_t)m * 1024 + c4 * 4) = w; }
    }
    xcd_barrier(xbar);

    if (PHMASK & (1 << 2)) for (int rep = 0; rep < REP1; ++rep) {
        pg8::Gemm g{HBF, WIN, MALL, NINP, 1024}; pg8::StaticOrder S; S.init(MALL, NINP, G, bid); S.wgm = 4;
        EpiP1 E{CKV, CQ, KMLA, GA, DQ, DK, DV, GD, MG, SSKV, SSQ, CS16, CS8, rep == 0};
        pg8::gemm_phase<EpiP1, pg8::StaticOrder, true, true>(ldsp, g, S, E, wave);
    }
    xcd_barrier(xbar);

    for (int rep = 0; rep < REP2; ++rep) {
    if (PHMASK & (1 << 3)) {
        pg8::Gemm g{CQ, WUQ, MLAT, 768, 384}; pg8::StaticOrder S; S.init(MLAT, 768, G, bid);
        EpiQ E{QMLA, SSQ, CS8};
        pg8::gemm_phase<EpiQ, pg8::StaticOrder, true, true>(ldsp, g, S, E, wave);
    }
    if (PHMASK & (1 << 4)) {
        pg8::Gemm g{CKV, WUKV, MALL, 1024, 256}; pg8::StaticOrder S; S.init(MALL, 1024, G, bid);
        EpiKV E{KMLA, VMLA, SSKV};
        pg8::gemm_phase<EpiKV, pg8::StaticOrder, true, true>(ldsp, g, S, E, wave);
    }
    }
    xcd_barrier(xbar);

    if (PHMASK & (3 << 5)) {
        float lam;
        { LANE_TID
        { const float s1 = wave_sum(a.dlam[lane] * a.dlam[64 + lane]), s2 = wave_sum(a.dlam[128 + lane] * a.dlam[192 + lane]); lam = __builtin_bit_cast(float, __builtin_amdgcn_readfirstlane(__builtin_bit_cast(int, __expf(s1) - __expf(s2) + 0.2f))); } }
        int grp;
        { LANE_TID
          int* tab = (int*)(lds + 95232); const int simd = (__builtin_amdgcn_s_getreg((1 << 11) | (4 << 6) | 4)) & 3;
          __syncthreads(); if (lane == 0) tab[wave] = simd; __syncthreads();
          int cnt = 0;
#pragma unroll
          for (int w = 0; w < 8; ++w) cnt += (w < wave && tab[w] == simd) ? 1 : 0;
          grp = __builtin_amdgcn_readfirstlane(cnt > 0 ? 1 : 0); asm volatile("" : "+s"(grp)); __syncthreads(); }
        const int nrounds = (NB * 12 * 32 + G - 1) / G;
        for (int rdx = 0; rdx < nrounds + REP3A * 8 + REP3D * 4; ++rdx) {
            const int rd = rdx < nrounds ? rdx : (rdx - nrounds < REP3A * 8 ? (rdx - nrounds) & 7 : 8 + ((rdx - nrounds - REP3A * 8) & 3));
            int b, hs, qb;
            { const int idx = rd * G + bid; if (idx >= NB * 12 * 32) break; b = idx & 7; qb = (idx >> 3) & 31; hs = idx >> 8; }
            const size_t qrow0 = (size_t)b * SEQ + qb * 256, krow0 = (size_t)b * SKV;
            __syncthreads();
            if (hs < 8) { if (PHMASK & (1 << 5)) {
                f32x16 o[2];
                att::attn_core<true>(QMLA + qrow0 * 768 + hs * 96, KMLA + krow0 * 768 + hs * 96, VMLA + krow0 * 512 + hs * 64, SKV, (char*)lds, o, wave, grp);
                LANE_TID
                const int r32 = lane & 31, hi = lane >> 5;
                char* T = (char*)lds + 95232 + wave * 8192; char* tw = T + hi * 512 + r32 * 2;
#pragma unroll
                for (int r = 0; r < 16; ++r)
#pragma unroll
                    for (int d0 = 0; d0 < 2; ++d0) *(bf16_t*)(tw + ((r & 3) + 8 * (r >> 2)) * 128 + d0 * 64) = (bf16_t)cvtpk(o[d0][r], o[d0][r]);
#pragma unroll
                for (int j = 0; j < 4; ++j) { const int id = j * 64 + lane, row = id >> 3, c8 = id & 7;
                    const u32x4 t = *(const u32x4*)(T + id * 16);
                    const size_t go = (qrow0 + wave * 32 + row) * 512 + hs * 64 + c8 * 8; const u32x4 g = *(const u32x4*)(GA + go);
                    u32x4 w; w.x = cvtpk(bflo(t.x) * bflo(g.x), bfhi(t.x) * bfhi(g.x)); w.y = cvtpk(bflo(t.y) * bflo(g.y), bfhi(t.y) * bfhi(g.y));
                    w.z = cvtpk(bflo(t.z) * bflo(g.z), bfhi(t.z) * bfhi(g.z)); w.w = cvtpk(bflo(t.w) * bflo(g.w), bfhi(t.w) * bfhi(g.w));
                    *(u32x4*)(XA + go) = w; }
            } } else if (PHMASK & (1 << 6)) {
                const int h = hs - 8;
                f32x16 o[4];
                att::attn_core<false>(DQ + qrow0 * 512 + h * 128, DK + krow0 * 512 + h * 128, DV + krow0 * 512 + h * 128, SKV, (char*)lds, o, wave, grp);
                { unsigned* stash = (unsigned*)(lds + 95232 + wave * 8192) + lane_id_v();
#pragma unroll
                for (int d0 = 0; d0 < 4; ++d0)
#pragma unroll
                    for (int r = 0; r < 16; r += 2) stash[(d0 * 8 + (r >> 1)) * 64] = cvtpk(o[d0][r], o[d0][r + 1]); }
                att::attn_core<false>(DQ + qrow0 * 512 + h * 128 + 64, DK + krow0 * 512 + h * 128 + 64, DV + krow0 * 512 + h * 128, SKV, (char*)lds, o, wave, grp);
                LANE_TID
                const int r32 = lane & 31, hi = lane >> 5;
                unsigned* stash = (unsigned*)(lds + 95232 + wave * 8192) + lane;
#pragma unroll
                for (int d0 = 0; d0 < 4; ++d0)
#pragma unroll
                    for (int r = 0; r < 16; r += 2) { const unsigned w = stash[(d0 * 8 + (r >> 1)) * 64];
                        o[d0][r] = bflo(w) - lam * o[d0][r]; o[d0][r + 1] = bfhi(w) - lam * o[d0][r + 1]; }
                asm volatile("s_waitcnt lgkmcnt(0)" ::: "memory"); SBAR();
                char* T = (char*)lds + 95232 + wave * 8192; char* tw = T + hi * 1024 + r32 * 2;
#pragma unroll
                for (int r = 0; r < 16; ++r)
#pragma unroll
                    for (int d0 = 0; d0 < 4; ++d0) *(bf16_t*)(tw + ((r & 3) + 8 * (r >> 2)) * 256 + d0 * 64) = (bf16_t)cvtpk(o[d0][r], o[d0][r]);
                const int c16 = lane & 15;
                const f32x4 sw0 = *(const f32x4*)(a.subln + c16 * 8), sw1 = *(const f32x4*)(a.subln + c16 * 8 + 4);
#pragma unroll
                for (int j = 0; j < 8; ++j) { const int id = j * 64 + lane, row = id >> 4;
                    const u32x4 t = *(const u32x4*)(T + id * 16);
                    float e[8] = {bflo(t.x), bfhi(t.x), bflo(t.y), bfhi(t.y), bflo(t.z), bfhi(t.z), bflo(t.w), bfhi(t.w)};
                    float ss = 0.f;
#pragma unroll
                    for (int k = 0; k < 8; ++k) ss += e[k] * e[k];
                    ss += shflx(ss, 1); ss += shflx(ss, 2); ss += shflx(ss, 4); ss += shflx(ss, 8);
                    const float rs = 0.8f / sqrtf(ss * (1.f / 128.f) + 1e-5f);
                    const size_t go = (qrow0 + wave * 32 + row) * 512 + h * 128 + c16 * 8; const u32x4 g = *(const u32x4*)(GD + go);
                    u32x4 w; w.x = cvtpk(e[0] * rs * sw0[0] * bflo(g.x), e[1] * rs * sw0[1] * bfhi(g.x)); w.y = cvtpk(e[2] * rs * sw0[2] * bflo(g.y), e[3] * rs * sw0[3] * bfhi(g.y));
                    w.z = cvtpk(e[4] * rs * sw1[0] * bflo(g.z), e[5] * rs * sw1[1] * bfhi(g.z)); w.w = cvtpk(e[6] * rs * sw1[2] * bflo(g.w), e[7] * rs * sw1[3] * bfhi(g.w));
                    *(u32x4*)(XD + go) = w; }
            }
        }
    }
    xcd_barrier(xbar);

    for (int rep = 0; rep < REP4A; ++rep) {
    if (PHMASK & (1 << 7)) {
        pg8::Gemm g{XA, WOA, MLAT, 1024, 512}; pg8::StaticOrder S; S.init(MLAT, 1024, G, bid);
        EpiZ<false> E{Z, MG};
        pg8::gemm_phase<EpiZ<false>, pg8::StaticOrder, true, true>(ldsp, g, S, E, wave);
    }
    if (PHMASK & (1 << 8)) {
        pg8::Gemm g{XD, WOB, MLAT, 1024, 512}; pg8::StaticOrder S; S.init(MLAT, 1024, G, bid);
        EpiZ<true> E{Z, MG + 1024};
        pg8::gemm_phase<EpiZ<true>, pg8::StaticOrder, true, true>(ldsp, g, S, E, wave);
    }
    }
    xcd_barrier(xbar);

    if (PHMASK & (1 << 9)) for (int rep = 0; rep < REP4B; ++rep) {
        pg8::Gemm g{Z, WOUT, MLAT, 1024, 1024}; pg8::StaticOrder S; S.init(MLAT, 1024, G, bid);
        EpiOut E{a.out, a.x, MOD};
        pg8::gemm_phase<EpiOut, pg8::StaticOrder, true, true>(ldsp, g, S, E, wave);
    }
    xcd_barrier(xbar);

    if (PHMASK & (1 << 10)) for (int m = gw; m < MLAT; m += NGW) {
        LANE_TID
        f32x4* rowp = (f32x4*)(a.out + (size_t)m * 1024) + lane;
        f32x4 v[4]; float s = 0.f;
#pragma unroll
        for (int j = 0; j < 4; ++j) { v[j] = rowp[64 * j]; s += (v[j][0] + v[j][1]) + (v[j][2] + v[j][3]); }
        const float mean = wave_sum(s) * (1.f / 1024.f); float s2 = 0.f;
#pragma unroll
        for (int j = 0; j < 4; ++j) { v[j] = v[j] - mean; s2 += (v[j][0] * v[j][0] + v[j][1] * v[j][1]) + (v[j][2] * v[j][2] + v[j][3] * v[j][3]); }
        const float rstd = 1.f / sqrtf(wave_sum(s2) * (1.f / 1024.f) + 1e-5f);
#pragma unroll
        for (int j = 0; j < 4; ++j) { const f32x4 g = ((const f32x4*)a.ln_g)[lane + 64 * j], bb = ((const f32x4*)a.ln_b)[lane + 64 * j]; rowp[64 * j] = v[j] * rstd * g + bb; }
    }
}

extern "C" void kernel_launch(void* const* d_in, const int* in_sizes, int n_in, void* d_out, int out_size, void* d_ws, size_t ws_size, hipStream_t stream) {
    static int grid = 0;
    if (grid == 0) {
        if (n_in != 18 || in_sizes[0] != MLAT * DM || out_size != MLAT * DM || ws_size < WS_END) {
            fprintf(stderr, "kernel_launch: shape/workspace mismatch: n_in %d in0 %d out %d ws %zu (need %zu)\n", n_in, n_in > 0 ? in_sizes[0] : -1, out_size, ws_size, (size_t)WS_END); grid = -1; return; }
        int dev = 0, cus = 0, per_cu = 0;
        hipGetDevice(&dev); hipDeviceGetAttribute(&cus, hipDeviceAttributeMultiprocessorCount, dev);
        if (hipFuncSetAttribute((const void*)fwd_mega, hipFuncAttributeMaxDynamicSharedMemorySize, LDS_BYTES) != hipSuccess) { fprintf(stderr, "kernel_launch: hipFuncSetAttribute failed\n"); grid = -1; return; }
        if (hipOccupancyMaxActiveBlocksPerMultiprocessor(&per_cu, (const void*)fwd_mega, 512, LDS_BYTES) != hipSuccess || per_cu < 1) { fprintf(stderr, "kernel_launch: occupancy query gave %d\n", per_cu); per_cu = 1; }
        (void)hipGetLastError();
        grid = cus * 1;
    }
    if (grid < 0) return;
    hipMemsetAsync((char*)d_ws + WS_BAR, 0, CTL_ZERO_BYTES, stream);
    Args a{};
    a.x = (const float*)d_in[0]; a.c = (const float*)d_in[1]; a.ctx = (const float*)d_in[2]; a.c_ctx = (const float*)d_in[3]; a.w_mod = (const float*)d_in[4]; a.b_mod = (const float*)d_in[5];
    a.w_in = (const float*)d_in[6]; a.q_norm = (const float*)d_in[7]; a.kv_norm = (const float*)d_in[8]; a.w_uq = (const float*)d_in[9]; a.w_ukv = (const float*)d_in[10];
    a.dlam = (const float*)d_in[11]; a.subln = (const float*)d_in[12]; a.w_oa = (const float*)d_in[13]; a.w_ob = (const float*)d_in[14]; a.w_out = (const float*)d_in[15];
    a.ln_g = (const float*)d_in[16]; a.ln_b = (const float*)d_in[17]; a.out = (float*)d_out; a.ws = (unsigned char*)d_ws;
    void* args[] = {&a};
    hipError_t e = hipLaunchCooperativeKernel((const void*)fwd_mega, dim3(grid), dim3(512), args, LDS_BYTES, stream);
    if (e != hipSuccess) fprintf(stderr, "kernel_launch: cooperative launch failed: %s (grid %d)\n", hipGetErrorString(e), grid);
}
```
